# Optimizing an MI355X kernel written in HIP

```python
import jax, jax.numpy as jnp
from jax import lax
import numpy as np

D_MODEL = 1024
BATCH = 2
SEQ = 8192
DEPTH = 4

N_MIXERS = 2
N_HGRN_LAYERS = (DEPTH + 1) // 2
N_MLA_LAYERS = DEPTH // 2
RMS_EPS = 1e-6

HGRN_EXPAND = 128
HGRN_HEADS = D_MODEL // HGRN_EXPAND
HGRN_VDIM = D_MODEL // HGRN_HEADS
HGRN_CHUNK = 64

MLA_HEADS = D_MODEL // 128
MLA_NOPE = 128
MLA_ROPE = 64
MLA_QK_HEAD = MLA_NOPE + MLA_ROPE
MLA_V_HEAD = 128
MLA_Q_LORA = D_MODEL // 4
MLA_KV_LORA = D_MODEL // 4
ROPE_THETA = 10000.0
Q_BLOCK = 128

D_FF = 2816
FFN_CONV = 3

kernel_name = "hybrid_hgrn2_mla_convffn_trunk"


def _rmsnorm(x, gain):
    xf = x.astype(jnp.float32)
    y = xf * lax.rsqrt(jnp.mean(xf * xf, axis=-1, keepdims=True) + RMS_EPS)
    return (y * gain.astype(jnp.float32)).astype(x.dtype)


def _chunk_gated_recurrence(q, k, v, log_f):
    B, S, H, Dk = q.shape
    Dv = v.shape[-1]
    C = HGRN_CHUNK
    N = S // C

    def to_chunks(t):
        return t.astype(jnp.float32).reshape(B, N, C, H, t.shape[-1]).transpose(1, 0, 3, 2, 4)

    causal = jnp.tril(jnp.ones((C, C), dtype=bool))[:, :, None]

    def step(state, inp):
        qc, kc, vc, gc = inp
        G = jnp.cumsum(gc, axis=2)
        o_inter = jnp.einsum("bhtd,bhde->bhte", qc * jnp.exp(G), state)
        diff = G[:, :, :, None, :] - G[:, :, None, :, :]
        decay = jnp.where(causal, jnp.exp(jnp.where(causal, diff, 0.0)), 0.0)
        scores = jnp.einsum("bhtd,bhsd,bhtsd->bhts", qc, kc, decay)
        o_intra = jnp.einsum("bhts,bhse->bhte", scores, vc)
        G_last = G[:, :, -1:, :]
        new_state = state * jnp.exp(G_last[:, :, 0, :, None]) + jnp.einsum(
            "bhsd,bhse->bhde", kc * jnp.exp(G_last - G), vc)
        return new_state, o_inter + o_intra

    state0 = jnp.zeros((B, H, Dk, Dv), jnp.float32)
    _, o = lax.scan(step, state0, (to_chunks(q), to_chunks(k), to_chunks(v), to_chunks(log_f)))
    return o.transpose(1, 0, 3, 2, 4).reshape(B, S, H, Dv)


def _hgrn2_mixer(h, w_in, lower_bound, out_norm, w_out):
    B, S, _ = h.shape
    q, f, i, g = jnp.split(h @ w_in, 4, axis=-1)

    def heads(t):
        return t.reshape(B, S, HGRN_HEADS, -1)

    lb = lower_bound.astype(jnp.float32)
    forget = lb + (1.0 - lb) * jax.nn.sigmoid(f.astype(jnp.float32))
    key_in = 1.0 - forget
    log_f = jnp.log(forget)
    o = _chunk_gated_recurrence(heads(jax.nn.silu(q)), heads(key_in), heads(i), heads(log_f))
    o = _rmsnorm(o, out_norm) * jax.nn.silu(heads(g.astype(jnp.float32)))
    return o.reshape(B, S, D_MODEL).astype(h.dtype) @ w_out


def _rope_tail(x, cos, sin):
    x_nope, x1, x2 = jnp.split(x, [MLA_NOPE, MLA_NOPE + MLA_ROPE // 2], axis=-1)
    xf1 = x1.astype(jnp.float32)
    xf2 = x2.astype(jnp.float32)
    rot = jnp.concatenate([xf1 * cos - xf2 * sin, xf2 * cos + xf1 * sin], axis=-1).astype(x.dtype)
    return jnp.concatenate([x_nope, rot], axis=-1)


def _causal_block_attention(q, k, v):
    B, S, H, Dqk = q.shape
    nb = S // Q_BLOCK
    scale = Dqk ** -0.5
    q_blocks = q.reshape(B, nb, Q_BLOCK, H, Dqk).transpose(1, 0, 3, 2, 4)
    k_t = k.transpose(0, 2, 1, 3)
    v_t = v.transpose(0, 2, 1, 3)
    key_pos = jnp.arange(S)

    def attend(args):
        q_blk, blk = args
        s = jnp.einsum("bhqd,bhkd->bhqk", q_blk, k_t).astype(jnp.float32) * scale
        q_pos = blk * Q_BLOCK + jnp.arange(Q_BLOCK)
        s = jnp.where(key_pos[None, :] <= q_pos[:, None], s, -jnp.inf)
        p = jax.nn.softmax(s, axis=-1).astype(v_t.dtype)
        return jnp.einsum("bhqk,bhkv->bhqv", p, v_t)

    o = lax.map(attend, (q_blocks, jnp.arange(nb)))
    return o.transpose(1, 0, 3, 2, 4).reshape(B, S, H, -1)


def _mla_mixer(h, cos, sin, w_in, q_a_norm, w_q_up, kv_a_norm, w_kv_up, q_norm, k_norm, w_out):
    B, S, _ = h.shape
    c_q, c_kv, k_rope = jnp.split(h @ w_in, [MLA_Q_LORA, MLA_Q_LORA + MLA_KV_LORA], axis=-1)
    q = (_rmsnorm(c_q, q_a_norm) @ w_q_up).reshape(B, S, MLA_HEADS, MLA_QK_HEAD)
    kv = (_rmsnorm(c_kv, kv_a_norm) @ w_kv_up).reshape(B, S, MLA_HEADS, MLA_NOPE + MLA_V_HEAD)
    k_nope, v = jnp.split(kv, [MLA_NOPE], axis=-1)
    k = jnp.concatenate(
        [k_nope, jnp.broadcast_to(k_rope[:, :, None, :], (B, S, MLA_HEADS, MLA_ROPE))], axis=-1)
    q = _rope_tail(_rmsnorm(q, q_norm), cos, sin)
    k = _rope_tail(_rmsnorm(k, k_norm), cos, sin)
    o = _causal_block_attention(q, k, v)
    return o.reshape(B, S, MLA_HEADS * MLA_V_HEAD) @ w_out


def _conv_ffn(h, w_up, conv_w, conv_b, w_down):
    S = h.shape[1]
    u = h @ w_up
    u_pad = jnp.pad(u, ((0, 0), (FFN_CONV - 1, 0), (0, 0)))
    y = conv_b.astype(u.dtype)
    for j in range(FFN_CONV):
        y = y + u_pad[:, j:j + S, :] * conv_w[j]
    gate, up = jnp.split(y, 2, axis=-1)
    return (jax.nn.silu(gate) * up) @ w_down


def setup_inputs(seed: int = 0) -> dict:
    key = jax.random.key(seed)
    ks = iter(jax.random.split(key, 32))

    def nrm(shape, scale):
        return jax.random.normal(next(ks), shape, jnp.float32) * scale

    def gain(shape):
        return 1.0 + 0.02 * jax.random.normal(next(ks), shape, jnp.float32)

    D = D_MODEL
    x = jax.random.normal(next(ks), (BATCH, SEQ, D), jnp.float32)
    offsets = jax.random.randint(next(ks), (BATCH, 1), 0, 4096, dtype=jnp.int32)
    positions = offsets + jnp.arange(SEQ, dtype=jnp.int32)[None, :]
    return {
        "x": x,
        "positions": positions,
        "norm_mix": gain((DEPTH, D)),
        "norm_ffn": gain((DEPTH, D)),
        "hgrn_w_in": nrm((N_HGRN_LAYERS, D, 4 * D), D ** -0.5),
        "hgrn_lower_bounds": nrm((N_HGRN_LAYERS, HGRN_HEADS * HGRN_EXPAND), 0.1),
        "hgrn_out_norm": gain((N_HGRN_LAYERS, HGRN_VDIM)),
        "hgrn_w_out": nrm((N_HGRN_LAYERS, D, D), D ** -0.5),
        "mla_w_in": nrm((N_MLA_LAYERS, D, MLA_Q_LORA + MLA_KV_LORA + MLA_ROPE), D ** -0.5),
        "mla_q_a_norm": gain((N_MLA_LAYERS, MLA_Q_LORA)),
        "mla_w_q_up": nrm((N_MLA_LAYERS, MLA_Q_LORA, MLA_HEADS * MLA_QK_HEAD), MLA_Q_LORA ** -0.5),
        "mla_kv_a_norm": gain((N_MLA_LAYERS, MLA_KV_LORA)),
        "mla_w_kv_up": nrm((N_MLA_LAYERS, MLA_KV_LORA, MLA_HEADS * (MLA_NOPE + MLA_V_HEAD)), MLA_KV_LORA ** -0.5),
        "mla_q_norm": gain((N_MLA_LAYERS, MLA_QK_HEAD)),
        "mla_k_norm": gain((N_MLA_LAYERS, MLA_QK_HEAD)),
        "mla_w_out": nrm((N_MLA_LAYERS, MLA_HEADS * MLA_V_HEAD, D), (MLA_HEADS * MLA_V_HEAD) ** -0.5),
        "ffn_w_up": nrm((DEPTH, D, 2 * D_FF), D ** -0.5),
        "ffn_conv_w": nrm((DEPTH, FFN_CONV, 2 * D_FF), FFN_CONV ** -0.5),
        "ffn_conv_b": nrm((DEPTH, 2 * D_FF), 0.01),
        "ffn_w_down": nrm((DEPTH, D_FF, D), D_FF ** -0.5),
    }


def reference(x, positions, norm_mix, norm_ffn, hgrn_w_in, hgrn_lower_bounds, hgrn_out_norm, hgrn_w_out,
              mla_w_in, mla_q_a_norm, mla_w_q_up, mla_kv_a_norm, mla_w_kv_up, mla_q_norm, mla_k_norm,
              mla_w_out, ffn_w_up, ffn_conv_w, ffn_conv_b, ffn_w_down):
    lb_soft = jax.nn.softmax(hgrn_lower_bounds.astype(jnp.float32), axis=0)
    lower_bounds = jnp.cumsum(lb_soft, axis=0) - lb_soft[0:1]
    inv_freq = ROPE_THETA ** (-jnp.arange(0, MLA_ROPE, 2, dtype=jnp.float32) / MLA_ROPE)
    ang = positions.astype(jnp.float32)[..., None] * inv_freq
    cos = jnp.cos(ang)[:, :, None, :]
    sin = jnp.sin(ang)[:, :, None, :]

    for layer in range(DEPTH):
        h = _rmsnorm(x, norm_mix[layer])
        j = layer // N_MIXERS
        if layer % N_MIXERS == 0:
            y = _hgrn2_mixer(h, hgrn_w_in[j], lower_bounds[j], hgrn_out_norm[j], hgrn_w_out[j])
        else:
            y = _mla_mixer(h, cos, sin, mla_w_in[j], mla_q_a_norm[j], mla_w_q_up[j], mla_kv_a_norm[j],
                           mla_w_kv_up[j], mla_q_norm[j], mla_k_norm[j], mla_w_out[j])
        x = x + y
        h = _rmsnorm(x, norm_ffn[layer])
        x = x + _conv_ffn(h, ffn_w_up[layer], ffn_conv_w[layer], ffn_conv_b[layer], ffn_w_down[layer])
    return x
```

```cpp
#include <hip/hip_runtime.h>
#include <hip/hip_cooperative_groups.h>
#include <cstdio>
#include <cstdint>
namespace cg = cooperative_groups;
namespace pg8 {
#define PG8_LAS __attribute__((address_space(3)))
typedef unsigned short bf16_t;
typedef short bf16x8 __attribute__((ext_vector_type(8)));
typedef float f32x4 __attribute__((ext_vector_type(4)));
typedef unsigned u32x4 __attribute__((ext_vector_type(4)));
constexpr int BM = 256, BK = 64, HALF = 128, HTB = HALF * BK * 2  , STAGE_BYTES = 8 * HTB, NXCD = 8, WGM = 8;

__host__ __device__ __forceinline__ int lds_byte(int r, int c) { const int st = (r >> 4) * 2 + (c >> 5), rr = r & 15, cc = c & 31, ob = rr * 64 + cc * 2; return st * 1024 + (ob ^ (((ob >> 9) & 1) << 5)); }
__host__ __device__ __forceinline__ void stage_rc(int b, int& R, int& C) { const int st = b / 1024, sb = b % 1024, swz = sb ^ (((sb >> 9) & 1) << 5); R = (st >> 1) * 16 + swz / 64; C = (st & 1) * 32 + (swz % 64) / 2; }
__host__ __device__ __forceinline__ int perm32(int rho) { const int n = rho >> 4, i = rho & 15; return 8 * (i >> 2) + 4 * n + (i & 3); }

struct Unit { int pm, pn; };
struct Gemm { const bf16_t* A; const bf16_t* Bt; int M, N, K; int arows; };

struct StaticOrder {
    int nM, nN, nwg, G, c;
    __host__ __device__ void init(int M, int N, int G_, int c_) { nM = M / BM; nN = N / BM; nwg = nM * nN; G = G_; c = c_; }
    __host__ __device__ void init2(int nM_, int nN_, int G_, int c_) { nM = nM_; nN = nN_; nwg = nM * nN; G = G_; c = c_; }
    __host__ __device__ bool next(int i, Unit& u) const {
        const long L = (long)i * G + c; if (L >= nwg) return false;
        int wgid = (int)L; { const int q = nwg / NXCD, r = nwg % NXCD, xcd = wgid % NXCD, off = wgid / NXCD; wgid = (xcd < r ? xcd * (q + 1) : r * (q + 1) + (xcd - r) * q) + off; }
        const int nig = WGM * nN, gid = wgid / nig, fm = gid * WGM, gsz = (nM - fm) < WGM ? (nM - fm) : WGM;
        u.pm = fm + ((wgid % nig) % gsz); u.pn = (wgid % nig) / gsz; return true;
    }
    __device__ __forceinline__ void a_ready(const Unit&) const {}
    __device__ __forceinline__ void done(const Unit&) const {}
};

__device__ __forceinline__ unsigned cvt_pk_bf16(float lo, float hi) { unsigned r; asm volatile("v_cvt_pk_bf16_f32 %0, %1, %2" : "=v"(r) : "v"(lo), "v"(hi)); return r; }
typedef float f32x2 __attribute__((ext_vector_type(2)));
__device__ __forceinline__ f32x2 gelu_pk(f32x2 v) {
    const f32x2 av = __builtin_elementwise_abs(v), d = av * 0.2316418882f + 1.0f;
    f32x2 t; t.x = __builtin_amdgcn_rcpf(d.x); t.y = __builtin_amdgcn_rcpf(d.y);
    f32x2 q = t * 0.5307027145f + (-0.7265760135f); q = q * t + 0.7107068705f; q = q * t + (-0.142248368f); q = q * t + 0.127414796f; q = q * t;
    const f32x2 s = (v * v) * (-0.72134752044f);
    f32x2 e; e.x = __builtin_amdgcn_exp2f(s.x); e.y = __builtin_amdgcn_exp2f(s.y);
    const f32x2 m = v * (q * e), r = v - m;
    f32x2 o; o.x = v.x < 0.f ? m.x : r.x; o.y = v.y < 0.f ? m.y : r.y; return o;
}

template <int ACT  > struct EpiBf16 {
    static constexpr bool PERM = true, AFTER_DRAIN = false; static_assert(ACT == 0 || ACT == 1, "EpiBf16: ACT is 0 (none) or 1 (gelu_pk)");
    bf16_t* O; int ldc; const float* bias; int split_cols; size_t split_stride; float scale0;
    __device__ __forceinline__ void operator()(const f32x4 (&acc)[2][2][4][2], const Unit& u, int wr, int wc, int fr, int fq) const {
        const int row0 = u.pm * BM + wr * 64 + fr; int colt = u.pn * BM; bf16_t* base = O;
        float sc = 1.f; if (split_cols) { const int t = colt / split_cols; base += (size_t)t * split_stride; colt -= t * split_cols; if (t == 0) sc = scale0; }
        const int col0 = colt + wc * 32 + 8 * fq, bcol0 = u.pn * BM + wc * 32 + 8 * fq;
        f32x4 bv[2][2];
#pragma unroll
        for (int bj = 0; bj < 2; ++bj)
#pragma unroll
            for (int n = 0; n < 2; ++n) bv[bj][n] = bias ? *(const f32x4*)(bias + bcol0 + bj * HALF + 4 * n) : (f32x4){0.f, 0.f, 0.f, 0.f};
#pragma unroll
        for (int ai = 0; ai < 2; ++ai)
#pragma unroll
            for (int m = 0; m < 4; ++m) { bf16_t* rowp = base + (size_t)(row0 + ai * HALF + m * 16) * ldc + col0;
#pragma unroll
                for (int bj = 0; bj < 2; ++bj) { f32x4 v0 = acc[ai][bj][m][0] + bv[bj][0], v1 = acc[ai][bj][m][1] + bv[bj][1];
                    if (ACT == 1) { f32x2 a = gelu_pk((f32x2){v0[0], v0[1]}), b = gelu_pk((f32x2){v0[2], v0[3]}), c = gelu_pk((f32x2){v1[0], v1[1]}), d = gelu_pk((f32x2){v1[2], v1[3]});
                        v0 = (f32x4){a.x, a.y, b.x, b.y}; v1 = (f32x4){c.x, c.y, d.x, d.y}; }
                    v0 = v0 * sc; v1 = v1 * sc; u32x4 w; w.x = cvt_pk_bf16(v0[0], v0[1]); w.y = cvt_pk_bf16(v0[2], v0[3]); w.z = cvt_pk_bf16(v1[0], v1[1]); w.w = cvt_pk_bf16(v1[2], v1[3]);
                    *(u32x4*)(rowp + bj * HALF) = w; } }
    }
};

struct PanelStats {
    unsigned* xbuf;
    unsigned* cnt;
    unsigned* tmo;
    int ntn; float eps;
    unsigned code;
    __device__ __forceinline__ bool run(const f32x4 (&v)[2][2][4][2], const Unit& u, int wr, int wc, int fr, int fq, PG8_LAS unsigned char* lds, int wid, int lane) const {
        typedef float f32x2v __attribute__((ext_vector_type(2)));
        PG8_LAS f32x2v* P = (PG8_LAS f32x2v*)lds;
        PG8_LAS f32x2v* S = (PG8_LAS f32x2v*)(lds + 8192);
        PG8_LAS unsigned* flag = (PG8_LAS unsigned*)(lds + 8192 + 2048);
#pragma unroll
        for (int ai = 0; ai < 2; ++ai)
#pragma unroll
            for (int m = 0; m < 4; ++m) {
                float s = 0.f;
#pragma unroll
                for (int bj = 0; bj < 2; ++bj)
#pragma unroll
                    for (int n = 0; n < 2; ++n) { const f32x4 x = v[ai][bj][m][n]; s += (x[0] + x[1]) + (x[2] + x[3]); }
                s += __shfl_xor(s, 16); s += __shfl_xor(s, 32);
                const float mw = s * (1.0f / 64.0f); float q = 0.f;
#pragma unroll
                for (int bj = 0; bj < 2; ++bj)
#pragma unroll
                    for (int n = 0; n < 2; ++n) { const f32x4 d = v[ai][bj][m][n] - mw; q += (d[0] * d[0] + d[1] * d[1]) + (d[2] * d[2] + d[3] * d[3]); }
                q += __shfl_xor(q, 16); q += __shfl_xor(q, 32);
                if (fq == 0) P[(ai * HALF + wr * 64 + m * 16 + fr) * 4 + wc] = (f32x2v){mw, q};
            }
        asm volatile("s_waitcnt lgkmcnt(0)" ::: "memory"); __builtin_amdgcn_s_barrier(); asm volatile("" ::: "memory");
#if defined(BROKEN_EXCHANGE_NO_WAIT)
#warning BROKEN CONTROL BUILD: the row-statistics exchange does not wait; results are wrong by design
        if (blockIdx.x >= 64) { const long long t0_ = clock64(); while (clock64() - t0_ < 60000) __builtin_amdgcn_s_sleep(8); }
#endif
        const int row = wid * 32 + (lane & 31);
        if (lane < 32) {
            const f32x2v a = P[row * 4 + 0], b = P[row * 4 + 1], c = P[row * 4 + 2], d = P[row * 4 + 3];
            const float mt = (a.x + b.x + c.x + d.x) * 0.25f;
            const float da = a.x - mt, db = b.x - mt, dc = c.x - mt, dd = d.x - mt;
            const float m2 = (a.y + b.y) + (c.y + d.y) + 64.0f * ((da * da + db * db) + (dc * dc + dd * dd));
            unsigned long long* slot = (unsigned long long*)xbuf + ((size_t)(u.pm * BM + row) * 4 + u.pn);
            __hip_atomic_store(slot, ((unsigned long long)__float_as_uint(m2) << 32) | __float_as_uint(mt), __ATOMIC_RELAXED, __HIP_MEMORY_SCOPE_AGENT);
        }
        asm volatile("s_waitcnt vmcnt(0)" ::: "memory");
        if (lane == 0) __hip_atomic_fetch_add(cnt + 64 * u.pm, 1u, __ATOMIC_RELAXED, __HIP_MEMORY_SCOPE_AGENT);
        if (wid == 0) {
            bool dead = false; const unsigned long long t0 = __builtin_amdgcn_s_memrealtime(); const unsigned want = 8u * (unsigned)ntn;
            for (;;) {
#if defined(BROKEN_EXCHANGE_NO_WAIT)
                break;
#endif
                if ((unsigned)__builtin_amdgcn_readfirstlane(__hip_atomic_load(cnt + 64 * u.pm, __ATOMIC_RELAXED, __HIP_MEMORY_SCOPE_AGENT)) >= want) break;
                if (__builtin_amdgcn_s_memrealtime() - t0 > 2000000ull) {
                    if (lane == 0) { unsigned expect = 0u; __hip_atomic_compare_exchange_strong(tmo + 1, &expect, code | (unsigned)(u.pm & 0xff), __ATOMIC_RELAXED, __ATOMIC_RELAXED, __HIP_MEMORY_SCOPE_AGENT);
                                     __hip_atomic_store(tmo, 1u, __ATOMIC_RELAXED, __HIP_MEMORY_SCOPE_AGENT); }
                    dead = true; break; }
                __builtin_amdgcn_s_sleep(2);
            }
            __builtin_amdgcn_fence(__ATOMIC_ACQUIRE, "agent");
            if (lane == 0) flag[0] = dead ? 1u : 0u;
        }
        asm volatile("s_waitcnt vmcnt(0) lgkmcnt(0)" ::: "memory"); __builtin_amdgcn_s_barrier(); asm volatile("" ::: "memory");
        const bool bad = flag[0] != 0u;
        if (lane < 32) {
            const unsigned long long* slot = (const unsigned long long*)xbuf + (size_t)(u.pm * BM + row) * 4; float mt[4], m2[4]; float ms = 0.f;
#pragma unroll
            for (int t = 0; t < 4; ++t) { if (t < ntn) { const unsigned long long w = __hip_atomic_load(slot + t, __ATOMIC_RELAXED, __HIP_MEMORY_SCOPE_AGENT); mt[t] = __uint_as_float((unsigned)w); m2[t] = __uint_as_float((unsigned)(w >> 32)); } else { mt[t] = 0.f; m2[t] = 0.f; } ms += mt[t]; }
            const float mean = ms / (float)ntn; float q = 0.f;
#pragma unroll
            for (int t = 0; t < 4; ++t) if (t < ntn) { const float dm = mt[t] - mean; q += m2[t] + 256.0f * dm * dm; }
            S[row] = (f32x2v){mean, 1.0f / sqrtf(q / (256.0f * (float)ntn) + eps)};
        }
        asm volatile("s_waitcnt lgkmcnt(0)" ::: "memory"); __builtin_amdgcn_s_barrier(); asm volatile("" ::: "memory");
        return bad;
    }
};
struct EpiLnRes {
    static constexpr bool PERM = false, AFTER_DRAIN = true;
    const float* base; float* out; int ldc; const float* bias; PanelStats st; unsigned poison;
    __device__ __forceinline__ void fused(f32x4 (&acc)[2][2][4][2], const Unit& u, int wr, int wc, int fr, int fq, PG8_LAS unsigned char* lds, int wid, int lane) const {
        typedef float f32x2v __attribute__((ext_vector_type(2)));
        const PG8_LAS f32x2v* S = (const PG8_LAS f32x2v*)(lds + 8192);
        const int col0 = u.pn * BM + wc * 32 + 4 * fq;
#pragma unroll
        for (int bj = 0; bj < 2; ++bj)
#pragma unroll
            for (int n = 0; n < 2; ++n) { const f32x4 bv = bias ? *(const f32x4*)(bias + col0 + bj * HALF + n * 16) : (f32x4){0.f, 0.f, 0.f, 0.f};
#pragma unroll
                for (int ai = 0; ai < 2; ++ai)
#pragma unroll
                    for (int m = 0; m < 4; ++m) acc[ai][bj][m][n] += bv; }
        f32x4 pre[4][2][2];
#pragma unroll
        for (int m = 0; m < 4; ++m) { const size_t off = (size_t)(u.pm * BM + wr * 64 + m * 16 + fr) * ldc + col0;
#pragma unroll
            for (int bj = 0; bj < 2; ++bj)
#pragma unroll
                for (int n = 0; n < 2; ++n) pre[m][bj][n] = *(const f32x4*)(base + off + bj * HALF + n * 16); }
        const bool bad = st.run(acc, u, wr, wc, fr, fq, lds, wid, lane) || poison != 0u;
        const float qnan = __builtin_nanf("");
#pragma unroll
        for (int ai = 0; ai < 2; ++ai)
#pragma unroll
            for (int m = 0; m < 4; ++m) { const int r = ai * HALF + wr * 64 + m * 16 + fr; const f32x2v sr = S[r]; const size_t off = (size_t)(u.pm * BM + r) * ldc + col0;
#pragma unroll
                for (int bj = 0; bj < 2; ++bj)
#pragma unroll
                    for (int n = 0; n < 2; ++n) { const f32x4 bs = ai == 0 ? pre[m][bj][n] : *(const f32x4*)(base + off + bj * HALF + n * 16); f32x4 o = bs + (acc[ai][bj][m][n] - sr.x) * sr.y;
                        if (bad) o = (f32x4){qnan, qnan, qnan, qnan}; *(f32x4*)(out + off + bj * HALF + n * 16) = o; }
                if (m & 1) asm volatile("" ::: "memory"); }
    }
};
struct EpiLnResLn {
    static constexpr bool PERM = false, AFTER_DRAIN = true;
    const float* base; float* out; bf16_t* xn; int ldc; const float* bias; PanelStats st1, st2; unsigned poison;
    __device__ __forceinline__ void fused(f32x4 (&acc)[2][2][4][2], const Unit& u, int wr, int wc, int fr, int fq, PG8_LAS unsigned char* lds, int wid, int lane) const {
        typedef float f32x2v __attribute__((ext_vector_type(2))); typedef unsigned u32x2v __attribute__((ext_vector_type(2)));
        const PG8_LAS f32x2v* S = (const PG8_LAS f32x2v*)(lds + 8192);
        const int col0 = u.pn * BM + wc * 32 + 4 * fq;
#pragma unroll
        for (int bj = 0; bj < 2; ++bj)
#pragma unroll
            for (int n = 0; n < 2; ++n) { const f32x4 bv = bias ? *(const f32x4*)(bias + col0 + bj * HALF + n * 16) : (f32x4){0.f, 0.f, 0.f, 0.f};
#pragma unroll
                for (int ai = 0; ai < 2; ++ai)
#pragma unroll
                    for (int m = 0; m < 4; ++m) acc[ai][bj][m][n] += bv; }
        bool bad = st1.run(acc, u, wr, wc, fr, fq, lds, wid, lane) || poison != 0u;
        const float qnan = __builtin_nanf("");
#pragma unroll
        for (int ai = 0; ai < 2; ++ai)
#pragma unroll
            for (int m = 0; m < 4; ++m) { const int r = ai * HALF + wr * 64 + m * 16 + fr; const f32x2v sr = S[r]; const size_t off = (size_t)(u.pm * BM + r) * ldc + col0;
#pragma unroll
                for (int bj = 0; bj < 2; ++bj)
#pragma unroll
                    for (int n = 0; n < 2; ++n) { const f32x4 bs = *(const f32x4*)(base + off + bj * HALF + n * 16); acc[ai][bj][m][n] = bs + (acc[ai][bj][m][n] - sr.x) * sr.y; }
                asm volatile("" : "+v"(acc[ai][0][m][0]), "+v"(acc[ai][0][m][1]), "+v"(acc[ai][1][m][0]), "+v"(acc[ai][1][m][1]));
                if (m & 1) asm volatile("" ::: "memory"); }
        const bool bad1 = bad;
        bad = st2.run(acc, u, wr, wc, fr, fq, lds, wid, lane) || bad;
#pragma unroll
        for (int ai = 0; ai < 2; ++ai)
#pragma unroll
            for (int m = 0; m < 4; ++m) { const int r = ai * HALF + wr * 64 + m * 16 + fr; const f32x2v sr = S[r]; const size_t off = (size_t)(u.pm * BM + r) * ldc + col0;
#pragma unroll
                for (int bj = 0; bj < 2; ++bj)
#pragma unroll
                    for (int n = 0; n < 2; ++n) { const f32x4 x1 = acc[ai][bj][m][n]; *(f32x4*)(out + off + bj * HALF + n * 16) = bad1 ? (f32x4){qnan, qnan, qnan, qnan} : x1;
                        const f32x4 o = (x1 - sr.x) * sr.y; u32x2v w; w.x = cvt_pk_bf16(o[0], o[1]); w.y = cvt_pk_bf16(o[2], o[3]);
                        if (bad) { w.x = 0x7fc07fc0u; w.y = 0x7fc07fc0u; } *(u32x2v*)(xn + off + bj * HALF + n * 16) = w; }
                asm volatile("" ::: "memory"); }
    }
};

template <class Epi, class Sched, bool ALIGN_EPI = false, bool SP2 = false>
__device__ __forceinline__ void gemm_phase(PG8_LAS unsigned char* lds, const Gemm g, const Sched& S, const Epi& E) {
    int tid = threadIdx.x; asm volatile("" : "+v"(tid));
    const int wid = __builtin_amdgcn_readfirstlane(tid >> 6), lane = tid & 63, wr = wid >> 2, wc = wid & 3, fr = lane & 15, fq = lane >> 4;
    const int K = g.K, nt = K / BK;
    unsigned voffA[2], voffB[2];
#pragma unroll
    for (int i = 0; i < 2; ++i) { int R, C; stage_rc(tid * 16 + i * 8192, R, C); const int Rb = Epi::PERM ? ((R & ~31) + perm32(R & 31)) : R;
        voffA[i] = (unsigned)(R * K + C) * 2u; voffB[i] = (unsigned)(Rb * K + C) * 2u; }
    const size_t kstep = (size_t)(BK * 2);
    const size_t hstep = (size_t)HALF * K * 2;
    const size_t tstep = 2 * hstep;
    const size_t tstepA = (size_t)g.arows * K * 2;
    const unsigned lds_u32 = (unsigned)(__UINTPTR_TYPE__)lds;
    const unsigned ldsw = (unsigned)wid * 1024u;
    const int aoff = lds_byte(wr * 64 + fr, fq * 8), boff = lds_byte(wc * 32 + fr, fq * 8);
#define PG8_SA(b, h) (((b) * 2 + (h)) * HTB)
#define PG8_SB(b, h) ((4 + (b) * 2 + (h)) * HTB)
#define PG8_STAGE(bufoff, gbase, voff) do { _Pragma("unroll") for (int _i = 0; _i < 2; ++_i) { \
        const unsigned _m0 = lds_u32 + (unsigned)(bufoff) + ldsw + (unsigned)_i * 8192u; const char* _gb = (const char*)(gbase); \
        unsigned _keep; asm volatile("s_nop 4\n\ts_mov_b32 %0, m0\n\ts_mov_b32 m0, %1\n\ts_nop 0\n\tglobal_load_lds_dwordx4 %2, %3\n\ts_mov_b32 m0, %0" : "=&s"(_keep) : "s"(_m0), "v"((voff)[_i]), "s"(_gb) : "memory"); } } while (0)
#define PG8_LDA(dst, b, h) do { _Pragma("unroll") for (int m = 0; m < 4; ++m) _Pragma("unroll") for (int k = 0; k < 2; ++k) dst[m][k] = *(const PG8_LAS bf16x8*)(lds + PG8_SA(b, h) + aoff + m * 2048 + k * 1024); } while (0)
#define PG8_LDB(dst, b, h) do { _Pragma("unroll") for (int n = 0; n < 2; ++n) _Pragma("unroll") for (int k = 0; k < 2; ++k) dst[n][k] = *(const PG8_LAS bf16x8*)(lds + PG8_SB(b, h) + boff + n * 2048 + k * 1024); } while (0)
#define PG8_MMA(ai, bj, At, Bt) do { __builtin_amdgcn_s_setprio(1); _Pragma("unroll") for (int m = 0; m < 4; ++m) _Pragma("unroll") for (int n = 0; n < 2; ++n) _Pragma("unroll") for (int k = 0; k < 2; ++k) \
        acc[ai][bj][m][n] = __builtin_amdgcn_mfma_f32_16x16x32_bf16(Bt[n][k], At[m][k], acc[ai][bj][m][n], 0, 0, 0); __builtin_amdgcn_s_setprio(0); } while (0)
#define PG8_WAIT_V(n) asm volatile("s_waitcnt vmcnt(" #n ")" ::: "memory")
#define PG8_WAIT_L(n) asm volatile("s_waitcnt lgkmcnt(" #n ")" ::: "memory")
#define PG8_BAR __builtin_amdgcn_s_barrier()
#define PG8_SCHED __builtin_amdgcn_sched_barrier(0)
    Unit cur, nxt; int ui = 0;
    if (!S.next(0, cur)) return;
    f32x4 acc[2][2][4][2];
#pragma unroll
    for (int a = 0; a < 2; ++a)
#pragma unroll
        for (int b = 0; b < 2; ++b)
#pragma unroll
            for (int m = 0; m < 4; ++m)
#pragma unroll
                for (int n = 0; n < 2; ++n) acc[a][b][m][n] = (f32x4){0.f, 0.f, 0.f, 0.f};
    bf16x8 At[4][2], B0[2][2], B1[2][2];
    const char* cA = (const char*)g.A + (size_t)cur.pm * tstepA; const char* cB = (const char*)g.Bt + (size_t)cur.pn * tstep;
    S.a_ready(cur);
    if constexpr (SP2) {
        PG8_STAGE(PG8_SB(0, 0), cB, voffB); PG8_STAGE(PG8_SB(0, 1), cB + hstep, voffB); PG8_STAGE(PG8_SA(0, 0), cA, voffA); PG8_STAGE(PG8_SA(0, 1), cA + hstep, voffA);
        if (wr == 1) PG8_BAR;
        PG8_WAIT_V(2); PG8_BAR;
        PG8_STAGE(PG8_SB(1, 0), cB + kstep, voffB); PG8_STAGE(PG8_SA(1, 0), cA + kstep, voffA); PG8_STAGE(PG8_SB(1, 1), cB + hstep + kstep, voffB);
        PG8_WAIT_V(6); PG8_BAR;
    } else {
        PG8_STAGE(PG8_SB(0, 0), cB, voffB); PG8_STAGE(PG8_SA(0, 0), cA, voffA); PG8_STAGE(PG8_SB(0, 1), cB + hstep, voffB); PG8_STAGE(PG8_SA(0, 1), cA + hstep, voffA);
        if (wr == 1) PG8_BAR;
        PG8_WAIT_V(4); PG8_BAR;
        PG8_STAGE(PG8_SB(1, 0), cB + kstep, voffB); PG8_STAGE(PG8_SA(1, 0), cA + kstep, voffA); PG8_STAGE(PG8_SB(1, 1), cB + hstep + kstep, voffB);
        PG8_WAIT_V(6); PG8_BAR;
    }
    for (;;) {
        const bool has_next = S.next(ui + 1, nxt);
        const char* nA = has_next ? (const char*)g.A + (size_t)nxt.pm * tstepA : cA; const char* nB = has_next ? (const char*)g.Bt + (size_t)nxt.pn * tstep : cB;
        _Pragma("nounroll") for (int t = 0; t < nt; t += 2) {
            const bool last = (t == nt - 2);
            const char* a1 = cA + (size_t)(t + 1) * kstep;
            const char* a2 = last ? nA : cA + (size_t)(t + 2) * kstep; const char* b2 = last ? nB : cB + (size_t)(t + 2) * kstep;
            const char* a3 = a2 + kstep; const char* b3 = b2 + kstep;
            if (last && has_next) S.a_ready(nxt);
            if constexpr (SP2) {
            PG8_LDB(B0, 0, 0); PG8_LDB(B1, 0, 1); PG8_SCHED; PG8_LDA(At, 0, 0); PG8_STAGE(PG8_SA(1, 1), a1 + hstep, voffA);
            PG8_WAIT_V(8); PG8_WAIT_L(0); PG8_BAR; PG8_MMA(0, 0, At, B0); PG8_MMA(0, 1, At, B1); PG8_BAR; PG8_SCHED;
            PG8_LDA(At, 0, 1); PG8_STAGE(PG8_SB(0, 0), b2, voffB); PG8_STAGE(PG8_SB(0, 1), b2 + hstep, voffB); PG8_STAGE(PG8_SA(0, 0), a2, voffA);
            PG8_WAIT_V(8); PG8_WAIT_L(0); PG8_BAR; PG8_MMA(1, 0, At, B0); PG8_MMA(1, 1, At, B1); PG8_BAR; PG8_SCHED;
            PG8_LDB(B0, 1, 0); PG8_LDB(B1, 1, 1); PG8_SCHED; PG8_LDA(At, 1, 0); PG8_STAGE(PG8_SA(0, 1), a2 + hstep, voffA);
            PG8_WAIT_V(8); PG8_WAIT_L(0); PG8_BAR; PG8_MMA(0, 0, At, B0); PG8_MMA(0, 1, At, B1); PG8_BAR; PG8_SCHED;
            PG8_LDA(At, 1, 1); PG8_STAGE(PG8_SB(1, 0), b3, voffB); PG8_STAGE(PG8_SB(1, 1), b3 + hstep, voffB); PG8_STAGE(PG8_SA(1, 0), a3, voffA);
            PG8_WAIT_V(8); PG8_WAIT_L(0); PG8_BAR; PG8_MMA(1, 0, At, B0); PG8_MMA(1, 1, At, B1); PG8_BAR; PG8_SCHED;
            } else {
            PG8_LDB(B0, 0, 0); PG8_SCHED; PG8_LDA(At, 0, 0); PG8_STAGE(PG8_SA(1, 1), a1 + hstep, voffA);
            PG8_WAIT_L(8); PG8_BAR; PG8_WAIT_L(0); PG8_MMA(0, 0, At, B0); PG8_BAR; PG8_SCHED;
            PG8_LDB(B1, 0, 1); PG8_STAGE(PG8_SB(0, 0), b2, voffB);
            PG8_BAR; PG8_WAIT_L(0); PG8_MMA(0, 1, At, B1); PG8_BAR;
            PG8_LDA(At, 0, 1); PG8_STAGE(PG8_SA(0, 0), a2, voffA);
            PG8_BAR; PG8_WAIT_L(0); PG8_MMA(1, 0, At, B0); PG8_BAR; PG8_SCHED;
            PG8_STAGE(PG8_SB(0, 1), b2 + hstep, voffB);
            PG8_WAIT_V(6); PG8_BAR; PG8_MMA(1, 1, At, B1); PG8_BAR;
            PG8_LDB(B0, 1, 0); PG8_SCHED; PG8_LDA(At, 1, 0); PG8_STAGE(PG8_SA(0, 1), a2 + hstep, voffA);
            PG8_WAIT_L(8); PG8_BAR; PG8_WAIT_L(0); PG8_MMA(0, 0, At, B0); PG8_BAR; PG8_SCHED;
            PG8_LDB(B1, 1, 1); PG8_STAGE(PG8_SB(1, 0), b3, voffB);
            PG8_BAR; PG8_WAIT_L(0); PG8_MMA(0, 1, At, B1); PG8_BAR;
            PG8_LDA(At, 1, 1); PG8_STAGE(PG8_SA(1, 0), a3, voffA);
            PG8_BAR; PG8_WAIT_L(0); PG8_MMA(1, 0, At, B0); PG8_BAR; PG8_SCHED;
            PG8_STAGE(PG8_SB(1, 1), b3 + hstep, voffB);
            PG8_WAIT_V(6); PG8_BAR; PG8_MMA(1, 1, At, B1); PG8_BAR;
            }
        }
        if constexpr (ALIGN_EPI) { if (wr == 0) PG8_BAR; }
        if constexpr (!Epi::AFTER_DRAIN) { E(acc, cur, wr, wc, fr, fq); S.done(cur); }
        if (!has_next) break;
#pragma unroll
        for (int a = 0; a < 2; ++a)
#pragma unroll
            for (int b = 0; b < 2; ++b)
#pragma unroll
                for (int m = 0; m < 4; ++m)
#pragma unroll
                    for (int n = 0; n < 2; ++n) acc[a][b][m][n] = (f32x4){0.f, 0.f, 0.f, 0.f};
        cur = nxt; cA = nA; cB = nB; ++ui;
        if constexpr (ALIGN_EPI) { if (wr == 1) PG8_BAR; }
    }
    PG8_WAIT_V(0);
    if constexpr (!ALIGN_EPI) { if (wr == 0) PG8_BAR; }
    PG8_BAR;
    if constexpr (Epi::AFTER_DRAIN) { E.fused(acc, cur, wr, wc, fr, fq, lds, wid, lane); S.done(cur); }
#undef PG8_SA
#undef PG8_SB
#undef PG8_STAGE
#undef PG8_LDA
#undef PG8_LDB
#undef PG8_MMA
#undef PG8_WAIT_V
#undef PG8_WAIT_L
#undef PG8_BAR
#undef PG8_SCHED
}
}

#define LAS __attribute__((address_space(3)))
using pg8::bf16_t; using pg8::f32x4; using pg8::u32x4; using pg8::bf16x8; using pg8::Unit;
typedef float f32x16 __attribute__((ext_vector_type(16)));
typedef unsigned u32x2 __attribute__((ext_vector_type(2)));

constexpr int M = 16384, SEQ = 8192, DM = 1024, DFF = 2816, DFF2 = 5632;
constexpr float EPS = 1e-6f;
constexpr int NTHREADS = 512, NWAVES = 8;
constexpr int LDS_BYTES = 147456;
constexpr int HALO_OFF = 131072;
constexpr float QSCALE = 0.07216878364870323f * 1.4426950408889634f;

constexpr size_t MiB = 1u << 20;
constexpr size_t WS_LBT = 0;
constexpr size_t WS_INVF = 16384;
constexpr size_t WS_WHIN = 2 * MiB;
constexpr size_t WS_WHOUT = 18 * MiB;
constexpr size_t WS_WMIN = 22 * MiB;
constexpr size_t WS_WQ = 25 * MiB;
constexpr size_t WS_WKN = 27 * MiB;
constexpr size_t WS_WV = 28 * MiB;
constexpr size_t WS_WMOUT = 29 * MiB;
constexpr size_t WS_WUP = 33 * MiB;
constexpr size_t WS_WDN = 44 * MiB;
constexpr size_t WS_XB = 50 * MiB + 65536;
constexpr size_t WS_R = 83 * MiB;
constexpr size_t WS_QH = WS_R, WS_VH = WS_R + 32 * MiB, WS_GH = WS_R + 64 * MiB, WS_LF = WS_R + 96 * MiB, WS_ST = WS_R + 160 * MiB, WS_DL = WS_R + 224 * MiB;
constexpr size_t WS_CQ = WS_R, WS_CKV = WS_R + 8 * MiB, WS_KR = WS_R + 16 * MiB, WS_QF = WS_R + 20 * MiB, WS_KN = WS_R + 68 * MiB, WS_VT = WS_R + 100 * MiB, WS_KF = WS_R + 132 * MiB;
constexpr size_t WS_HF = WS_R;
constexpr size_t WS_SSQ = WS_R + 226 * MiB;
constexpr size_t WS_SSQCQ = WS_SSQ + 9 * 16 * (size_t)M * 4;
constexpr size_t WS_SSQCKV = WS_SSQCQ + 2 * 4 * (size_t)M * 4;
constexpr size_t WS_NEED = WS_R + 238 * MiB;
static_assert(WS_SSQCKV + 2 * 4 * (size_t)M * 4 <= WS_NEED, "ws map");

struct Args { const void* in[20]; float* out; unsigned char* ws; };

__device__ __forceinline__ float bf2f(unsigned v) { return __uint_as_float(v << 16); }
__device__ __forceinline__ float bflo(unsigned w) { return __uint_as_float(w << 16); }
__device__ __forceinline__ float bfhi(unsigned w) { return __uint_as_float(w & 0xffff0000u); }
typedef float f32x2_t __attribute__((ext_vector_type(2))); typedef __bf16 bf16x2_t __attribute__((ext_vector_type(2)));
__device__ __forceinline__ unsigned pk2c(float lo, float hi) { f32x2_t v = {lo, hi}; bf16x2_t b = __builtin_convertvector(v, bf16x2_t); return __builtin_bit_cast(unsigned, b); }
__device__ __forceinline__ unsigned pk2(float lo, float hi) { return pg8::cvt_pk_bf16(lo, hi); }
__device__ __forceinline__ u32x4 pack8(const f32x4& a, const f32x4& b) { u32x4 w; w.x = pk2(a[0], a[1]); w.y = pk2(a[2], a[3]); w.z = pk2(b[0], b[1]); w.w = pk2(b[2], b[3]); return w; }
__device__ __forceinline__ float silu_f(float x) { return x / (1.f + __expf(-x)); }
__device__ __forceinline__ float wave_sum(float v) {
#pragma unroll
    for (int o = 1; o < 64; o <<= 1) v += __shfl_xor(v, o);
    return v;
}
#define LDS_WAIT() asm volatile("s_waitcnt lgkmcnt(0)" ::: "memory")
template <int NS> __device__ __forceinline__ float ssq_sum(const float* p, int r) {
    float s = 0.f;
#pragma unroll
    for (int k = 0; k < NS; ++k) s += p[(size_t)k * M + r];
    return s;
}

namespace epi {
using namespace pg8;

__device__ __forceinline__ void wg_row_ssq(LAS float* part, const float (&ss)[2][4], int wr, int wc, int fr, int fq, float* dst, int rowbase) {
    if (fq == 0) {
#pragma unroll
        for (int ai = 0; ai < 2; ++ai)
#pragma unroll
            for (int m = 0; m < 4; ++m) part[(ai * 128 + wr * 64 + m * 16 + fr) * 4 + wc] = ss[ai][m];
    }
    asm volatile("s_waitcnt lgkmcnt(0)" ::: "memory"); __builtin_amdgcn_s_barrier(); asm volatile("" ::: "memory");
    if (wc == 0 && fq == 0) {
#pragma unroll
        for (int ai = 0; ai < 2; ++ai)
#pragma unroll
            for (int m = 0; m < 4; ++m) { const int row = ai * 128 + wr * 64 + m * 16 + fr; const f32x4 v = *(const LAS f32x4*)(part + row * 4); dst[rowbase + row] = (v[0] + v[1]) + (v[2] + v[3]); }
    }
}

struct EpiResid {
    static constexpr bool PERM = true, AFTER_DRAIN = false;
    const float* xin; float* xout; bf16_t* xb; float* ssq; LAS float* part;
    __device__ __forceinline__ void operator()(f32x4 (&acc)[2][2][4][2], const Unit& u, int wr, int wc, int fr, int fq) const {
        int row0 = u.pm * 256 + wr * 64 + fr, col0 = u.pn * 256 + wc * 32 + 8 * fq;
        asm volatile("" : "+v"(row0), "+v"(col0));
        float ssv[2][4];
#pragma unroll
        for (int ai = 0; ai < 2; ++ai)
#pragma unroll
            for (int m = 0; m < 4; ++m) {
                const int r = row0 + ai * 128 + m * 16; float ss = 0.f;
#pragma unroll
                for (int bj = 0; bj < 2; ++bj) {
                    const size_t off = (size_t)r * 1024 + col0 + bj * 128;
                    f32x4 a = *(const f32x4*)(xin + off), b = *(const f32x4*)(xin + off + 4);
                    a += acc[ai][bj][m][0]; b += acc[ai][bj][m][1];
                    *(f32x4*)(xout + off) = a; *(f32x4*)(xout + off + 4) = b;
                    ss += ((a[0] * a[0] + a[1] * a[1]) + (a[2] * a[2] + a[3] * a[3])) + ((b[0] * b[0] + b[1] * b[1]) + (b[2] * b[2] + b[3] * b[3]));
                    if (xb) *(u32x4*)(xb + off) = pack8(a, b);
                }
                ss += __shfl_xor(ss, 16); ss += __shfl_xor(ss, 32); ssv[ai][m] = ss;
                asm volatile("" ::: "memory");
            }
        if (ssq) wg_row_ssq(part, ssv, wr, wc, fr, fq, ssq + (size_t)u.pn * M, u.pm * 256);
    }
};

struct EpiHgrnIn {
    static constexpr bool PERM = true, AFTER_DRAIN = false;
    const float* ssq; const float* lb; bf16_t* Q; bf16_t* V; bf16_t* G; float* LF;
    __device__ __forceinline__ void operator()(f32x4 (&acc)[2][2][4][2], const Unit& u, int wr, int wc, int fr, int fq) const {
        const int sec = u.pn >> 2;
        int row0 = u.pm * 256 + wr * 64 + fr, c0 = (u.pn & 3) * 256 + wc * 32 + 8 * fq;
        asm volatile("" : "+v"(row0), "+v"(c0));
        f32x4 l0[2], l1[2];
#pragma unroll
        for (int bj = 0; bj < 2; ++bj) { l0[bj] = *(const f32x4*)(lb + c0 + bj * 128); l1[bj] = *(const f32x4*)(lb + c0 + bj * 128 + 4); }
#pragma unroll
        for (int ai = 0; ai < 2; ++ai)
#pragma unroll
            for (int m = 0; m < 4; ++m) {
                const int r = row0 + ai * 128 + m * 16; const float rs = rsqrtf(ssq_sum<4>(ssq, r) * (1.f / 1024.f) + EPS);
#pragma unroll
                for (int bj = 0; bj < 2; ++bj) {
                    const size_t off = (size_t)r * 1024 + c0 + bj * 128;
                    f32x4 a = acc[ai][bj][m][0] * rs, b = acc[ai][bj][m][1] * rs;
                    if (sec == 1) {
#pragma unroll
                        for (int j = 0; j < 4; ++j) {
                            const float sa = 1.f / (1.f + __expf(-a[j])), sb = 1.f / (1.f + __expf(-b[j]));
                            a[j] = __logf(l0[bj][j] + (1.f - l0[bj][j]) * sa); b[j] = __logf(l1[bj][j] + (1.f - l1[bj][j]) * sb);
                        }
                        *(f32x4*)(LF + off) = a; *(f32x4*)(LF + off + 4) = b;
                    } else if (sec == 2) {
                        *(u32x4*)(V + off) = pack8(a, b);
                    } else {
#pragma unroll
                        for (int j = 0; j < 4; ++j) { a[j] = silu_f(a[j]); b[j] = silu_f(b[j]); }
                        *(u32x4*)((sec == 0 ? Q : G) + off) = pack8(a, b);
                    }
                }
            }
    }
};

struct EpiMlaIn {
    static constexpr bool PERM = true, AFTER_DRAIN = false;
    const float* ssq; bf16_t* CQ; bf16_t* CKV; float* KR; float* ssq_cq; float* ssq_ckv; LAS float* part;
    __device__ __forceinline__ void operator()(f32x4 (&acc)[2][2][4][2], const Unit& u, int wr, int wc, int fr, int fq) const {
        int row0 = u.pm * 256 + wr * 64 + fr, cl = wc * 32 + 8 * fq;
        asm volatile("" : "+v"(row0), "+v"(cl));
        float ssv[2][4];
#pragma unroll
        for (int ai = 0; ai < 2; ++ai)
#pragma unroll
            for (int m = 0; m < 4; ++m) {
                const int r = row0 + ai * 128 + m * 16; const float rs = rsqrtf(ssq_sum<4>(ssq, r) * (1.f / 1024.f) + EPS);
                ssv[ai][m] = 0.f;
                if (u.pn < 2) {
                    bf16_t* dst = u.pn == 0 ? CQ : CKV; float ss = 0.f;
#pragma unroll
                    for (int bj = 0; bj < 2; ++bj) {
                        const f32x4 a = acc[ai][bj][m][0] * rs, b = acc[ai][bj][m][1] * rs;
                        ss += ((a[0] * a[0] + a[1] * a[1]) + (a[2] * a[2] + a[3] * a[3])) + ((b[0] * b[0] + b[1] * b[1]) + (b[2] * b[2] + b[3] * b[3]));
                        *(u32x4*)(dst + (size_t)r * 256 + cl + bj * 128) = pack8(a, b);
                    }
                    ss += __shfl_xor(ss, 16); ss += __shfl_xor(ss, 32); ssv[ai][m] = ss;
                } else if (cl < 64) {
                    const f32x4 a = acc[ai][0][m][0] * rs, b = acc[ai][0][m][1] * rs;
                    *(f32x4*)(KR + (size_t)r * 64 + cl) = a; *(f32x4*)(KR + (size_t)r * 64 + cl + 4) = b;
                }
            }
        if (u.pn < 2) wg_row_ssq(part, ssv, wr, wc, fr, fq, u.pn == 0 ? ssq_cq : ssq_ckv, u.pm * 256);
    }
};

template <bool ROW> struct EpiScale {
    static constexpr bool PERM = true, AFTER_DRAIN = false;
    const float* ssq; float inv_n; bf16_t* O; int ldc;
    __device__ __forceinline__ void operator()(f32x4 (&acc)[2][2][4][2], const Unit& u, int wr, int wc, int fr, int fq) const {
        int row0 = u.pm * 256 + wr * 64 + fr, col0 = u.pn * 256 + wc * 32 + 8 * fq;
        asm volatile("" : "+v"(row0), "+v"(col0));
        f32x4 c0[2], c1[2];
#pragma unroll
        for (int bj = 0; bj < 2; ++bj) {
            if (!ROW) {
                const f32x4 s0 = *(const f32x4*)(ssq + col0 + bj * 128), s1 = *(const f32x4*)(ssq + col0 + bj * 128 + 4);
#pragma unroll
                for (int j = 0; j < 4; ++j) { c0[bj][j] = rsqrtf(s0[j] * inv_n + EPS); c1[bj][j] = rsqrtf(s1[j] * inv_n + EPS); }
            } else { c0[bj] = (f32x4){1.f, 1.f, 1.f, 1.f}; c1[bj] = c0[bj]; }
        }
#pragma unroll
        for (int ai = 0; ai < 2; ++ai)
#pragma unroll
            for (int m = 0; m < 4; ++m) {
                const int r = row0 + ai * 128 + m * 16; const float rs = ROW ? rsqrtf(ssq[r] * inv_n + EPS) : 1.f;
#pragma unroll
                for (int bj = 0; bj < 2; ++bj) {
                    const f32x4 a = acc[ai][bj][m][0] * rs * c0[bj], b = acc[ai][bj][m][1] * rs * c1[bj];
                    *(u32x4*)(O + (size_t)r * ldc + col0 + bj * 128) = pack8(a, b);
                }
            }
    }
};

template <int CTRL> __device__ __forceinline__ float dpp_mov(float old, float src) {
    return __builtin_bit_cast(float, __builtin_amdgcn_update_dpp(__builtin_bit_cast(int, old), __builtin_bit_cast(int, src), CTRL, 0xf, 0xf, false));
}

struct EpiFfnUp {
    static constexpr bool PERM = true, AFTER_DRAIN = false;
    const float* ssq; const float* cw; const float* cb; bf16_t* HF; LAS float* halo;
    __device__ __forceinline__ void operator()(f32x4 (&acc)[2][2][4][2], const Unit& u, int wr, int wc, int fr, int fq) const {
        int gr0 = u.pm * 254 - 2 + wr * 64 + fr;
        int cl = wc * 32 + 8 * fq;
        asm volatile("" : "+v"(gr0), "+v"(cl));
#pragma unroll
        for (int ai = 0; ai < 2; ++ai)
#pragma unroll
            for (int m = 0; m < 4; ++m) {
                const int gr = gr0 + ai * 128 + m * 16;
                const bool vr = (gr >= 0 && gr < M);
                const float rs = rsqrtf(ssq_sum<4>(ssq, vr ? gr : 0) * (1.f / 1024.f) + EPS);
#pragma unroll
                for (int bj = 0; bj < 2; ++bj)
#pragma unroll
                    for (int n = 0; n < 2; ++n) acc[ai][bj][m][n] = vr ? acc[ai][bj][m][n] * rs : (f32x4){0.f, 0.f, 0.f, 0.f};
                asm volatile("" ::: "memory");
            }
        if (fr >= 14) {
#pragma unroll
            for (int ai = 0; ai < 2; ++ai)
#pragma unroll
                for (int bj = 0; bj < 2; ++bj)
#pragma unroll
                    for (int n = 0; n < 2; ++n) *(LAS f32x4*)(halo + (((2 * ai + wr) * 2 + (fr - 14)) * 256 + bj * 128 + cl + 4 * n)) = acc[ai][bj][3][n];
        }
        asm volatile("s_waitcnt lgkmcnt(0)" ::: "memory"); __builtin_amdgcn_s_barrier(); asm volatile("" ::: "memory");
        const int ch = u.pn * 128 + cl;
#pragma unroll
        for (int n = 0; n < 2; ++n) {
            f32x4 w0[2], w1[2], w2[2], bb[2];
#pragma unroll
            for (int bj = 0; bj < 2; ++bj) {
                const int ci = bj * DFF + ch + 4 * n;
                w0[bj] = *(const f32x4*)(cw + ci); w1[bj] = *(const f32x4*)(cw + DFF2 + ci); w2[bj] = *(const f32x4*)(cw + 2 * DFF2 + ci); bb[bj] = *(const f32x4*)(cb + ci);
            }
#pragma unroll
            for (int ai = 0; ai < 2; ++ai) {
                asm volatile("" : "+v"(gr0));
                const int g = 2 * ai + wr;
                f32x4 pm[2];
#pragma unroll
                for (int bj = 0; bj < 2; ++bj) {
                    pm[bj] = (f32x4){0.f, 0.f, 0.f, 0.f};
                    if (g > 0 && fr >= 14) pm[bj] = *(const LAS f32x4*)(halo + ((((g - 1) * 2) + (fr - 14)) * 256 + bj * 128 + cl + 4 * n));
                }
#pragma unroll
                for (int m = 0; m < 4; ++m) {
                    const int gr = gr0 + ai * 128 + m * 16; const int t = gr & (SEQ - 1);
                    const float k1 = (t >= 1) ? 1.f : 0.f, k2 = (t >= 2) ? 1.f : 0.f;
                    f32x4 y[2];
#pragma unroll
                    for (int bj = 0; bj < 2; ++bj)
#pragma unroll
                        for (int j = 0; j < 4; ++j) {
                            const float cur = acc[ai][bj][m][n][j], pv = pm[bj][j];
                            const float p1 = dpp_mov<0x111>(dpp_mov<0x121>(0.f, pv), cur);
                            const float p2 = dpp_mov<0x112>(dpp_mov<0x122>(0.f, pv), cur);
                            y[bj][j] = bb[bj][j] + w0[bj][j] * (k2 != 0.f ? p2 : 0.f) + w1[bj][j] * (k1 != 0.f ? p1 : 0.f) + w2[bj][j] * cur;
                        }
                    f32x4 h0;
#pragma unroll
                    for (int j = 0; j < 4; ++j) h0[j] = silu_f(y[0][j]) * y[1][j];
                    const bool owned = !(ai == 0 && wr == 0 && m == 0 && fr < 2) && gr < M;
                    if (owned) { u32x2 w; w.x = pk2(h0[0], h0[1]); w.y = pk2(h0[2], h0[3]); *(u32x2*)(HF + (size_t)gr * DFF + ch + 4 * n) = w; }
#pragma unroll
                    for (int bj = 0; bj < 2; ++bj) pm[bj] = acc[ai][bj][m][n];
                    asm volatile("" ::: "memory");
                }
            }
        }
    }
};
}

__device__ __forceinline__ void cvt_item(const float* W, int ldn, int scol0, int k0, const float* gain, bf16_t* WT, int K, int drow0, LAS float* scr, int lane) {
#pragma unroll 8
    for (int i = 0; i < 32; ++i) {
        const int kk = 2 * i + (lane >> 5);
        float v = W[(size_t)(k0 + kk) * ldn + scol0 + (lane & 31)];
        if (gain) v *= gain[k0 + kk];
        scr[kk * 33 + (lane & 31)] = v;
    }
    LDS_WAIT(); asm volatile("" ::: "memory");
    const int c = lane & 7;
#pragma unroll
    for (int j = 0; j < 4; ++j) {
        const int n = (lane >> 3) + 8 * j; const LAS float* s = scr + (8 * c) * 33 + n;
        u32x4 o; o.x = pk2(s[0 * 33], s[1 * 33]); o.y = pk2(s[2 * 33], s[3 * 33]); o.z = pk2(s[4 * 33], s[5 * 33]); o.w = pk2(s[6 * 33], s[7 * 33]);
        *(u32x4*)(WT + (size_t)(drow0 + n) * K + k0 + 8 * c) = o;
    }
    LDS_WAIT(); asm volatile("" ::: "memory");
}
__device__ __forceinline__ int cvt_map(int map, int drow0) {
    if (map == 1) return (drow0 >> 7) * 256 + (drow0 & 127);
    if (map == 2) return (drow0 >> 7) * 256 + 128 + (drow0 & 127);
    if (map == 3) return ((drow0 >> 7) & 1) * DFF + (drow0 >> 8) * 128 + (drow0 & 127);
    return drow0;
}
__device__ __forceinline__ void cvt_job(const float* W, int K, int ldn, const float* gain, bf16_t* WT, int nrows, int map, int& rot, int gw, int NGW, LAS float* scr, int lane) {
    const int nb = nrows / 32, nitems = (K / 64) * nb;
    int start = gw - (rot % NGW); if (start < 0) start += NGW;
    for (int it = start; it < nitems; it += NGW) {
        const int kb = it / nb, b = it % nb;
        cvt_item(W, ldn, cvt_map(map, 32 * b), 64 * kb, gain, WT, K, 32 * b, scr, lane);
    }
    rot += nitems;
}

__device__ __forceinline__ void hgrn_local(LAS unsigned char* lds, const bf16_t* V, const float* LF, bf16_t* ST, float* DL, int G, int bid, unsigned* dgp = nullptr) {
    int tid = threadIdx.x; asm volatile("" : "+v"(tid));
    const int lane = tid & 63, wid = __builtin_amdgcn_readfirstlane(tid >> 6);
    LAS bf16_t* KdT = (LAS bf16_t*)lds;
    LAS bf16_t* VT = (LAS bf16_t*)(lds + 18432);
    LAS float* tot = (LAS float*)(lds + 36864);
    const int d = tid & 127, part = tid >> 7, l15 = lane & 15, q4 = lane >> 4;
    for (int unit = bid; unit < 16 * 127; unit += G) {
        const int bh = unit / 127, n = unit % 127, b = bh >> 3, h = bh & 7;
        const size_t row0 = (size_t)b * SEQ + n * 64 + part * 16;
        const float* lfp = LF + row0 * 1024 + h * 128 + d;
        const bf16_t* vp = V + row0 * 1024 + h * 128 + d;
        float g[16], kk[16]; unsigned vv[16];
#pragma unroll
        for (int j = 0; j < 16; ++j) { g[j] = lfp[(size_t)j * 1024]; vv[j] = vp[(size_t)j * 1024]; }
        float run = 0.f;
#pragma unroll
        for (int j = 0; j < 16; ++j) { kk[j] = 1.f - __expf(g[j]); run += g[j]; g[j] = run; }
        tot[part * 128 + d] = run;
        __syncthreads();
        const float t0 = tot[d], t1 = tot[128 + d], t2 = tot[256 + d], t3 = tot[384 + d];
        const float off = part == 0 ? 0.f : (part == 1 ? t0 : (part == 2 ? t0 + t1 : t0 + t1 + t2));
        const float gl = (t0 + t1) + (t2 + t3);
#pragma unroll
        for (int j = 0; j < 16; ++j) kk[j] *= __expf(gl - (off + g[j]));
#ifdef DIAG_SUBCHK
        { bool bk = false, bv = false;
#pragma unroll
          for (int j = 0; j < 16; ++j) { if (!(fabsf(kk[j]) < 1.01f)) bk = true; if (!(fabsf(bf2f(vv[j])) < 100.f)) bv = true; }
          if (bk) atomicMin(dgp, 51u); if (bv) atomicMin(dgp, 52u); }
#endif
        u32x4 w0, w1, x0, x1;
        w0.x = pk2(kk[0], kk[1]); w0.y = pk2(kk[2], kk[3]); w0.z = pk2(kk[4], kk[5]); w0.w = pk2(kk[6], kk[7]);
        w1.x = pk2(kk[8], kk[9]); w1.y = pk2(kk[10], kk[11]); w1.z = pk2(kk[12], kk[13]); w1.w = pk2(kk[14], kk[15]);
        x0.x = vv[0] | (vv[1] << 16); x0.y = vv[2] | (vv[3] << 16); x0.z = vv[4] | (vv[5] << 16); x0.w = vv[6] | (vv[7] << 16);
        x1.x = vv[8] | (vv[9] << 16); x1.y = vv[10] | (vv[11] << 16); x1.z = vv[12] | (vv[13] << 16); x1.w = vv[14] | (vv[15] << 16);
        *(LAS u32x4*)(KdT + d * 72 + part * 16) = w0; *(LAS u32x4*)(KdT + d * 72 + part * 16 + 8) = w1;
        *(LAS u32x4*)(VT + d * 72 + part * 16) = x0; *(LAS u32x4*)(VT + d * 72 + part * 16 + 8) = x1;
        if (part == 0) DL[(size_t)(bh * 128 + n) * 128 + d] = __expf(gl);
        __syncthreads();
        bf16x8 af[2];
#pragma unroll
        for (int ks = 0; ks < 2; ++ks) af[ks] = *(const LAS bf16x8*)(KdT + (16 * wid + l15) * 72 + 32 * ks + 8 * q4);
        bf16_t* dst = ST + (size_t)(bh * 128 + n) * 16384;
#pragma unroll
        for (int et = 0; et < 8; ++et) {
            f32x4 c = {0.f, 0.f, 0.f, 0.f};
#pragma unroll
            for (int ks = 0; ks < 2; ++ks) {
                const bf16x8 bfr = *(const LAS bf16x8*)(VT + (16 * et + l15) * 72 + 32 * ks + 8 * q4);
                c = __builtin_amdgcn_mfma_f32_16x16x32_bf16(af[ks], bfr, c, 0, 0, 0);
            }
#ifdef DIAG_SUBCHK
            { bool bc = false;
#pragma unroll
              for (int r = 0; r < 4; ++r) if (!(fabsf(c[r]) < 1e5f)) bc = true;
              if (bc) atomicMin(dgp, 53u); }
#endif
            u32x2 o; o.x = pk2c(c[0], c[1]); o.y = pk2c(c[2], c[3]);
            *(u32x2*)(dst + (size_t)(16 * et + l15) * 128 + 16 * wid + 4 * q4) = o;
        }
    }
}

__device__ __forceinline__ void hgrn_scan(bf16_t* ST, const float* DL, int gtid, int gthreads) {
    for (int item = gtid; item < 16 * 8192; item += gthreads) {
        const int bh = item >> 13, idx = (item & 8191) * 2, d = idx & 127;
        float s0 = 0.f, s1 = 0.f;
        unsigned* p = (unsigned*)(ST + (size_t)bh * 128 * 16384 + idx);
        const float* dl = DL + (size_t)bh * 128 * 128 + d;
#pragma unroll 8
        for (int n = 0; n < 127; ++n) {
            const unsigned w = p[(size_t)n * 8192]; const float d0 = dl[n * 128], d1 = dl[n * 128 + 1];
            s0 = s0 * d0 + bflo(w); s1 = s1 * d1 + bfhi(w);
            p[(size_t)n * 8192] = pk2(s0, s1);
        }
    }
}

__device__ __forceinline__ void hgrn_out(LAS unsigned char* lds, const bf16_t* Q, const bf16_t* V, const bf16_t* Gt, const float* LF, const bf16_t* ST, const float* onorm, bf16_t* OH, int G, int bid) {
    int tid = threadIdx.x; asm volatile("" : "+v"(tid));
    const int lane = tid & 63, wid = __builtin_amdgcn_readfirstlane(tid >> 6);
    LAS bf16_t* QtS = (LAS bf16_t*)lds;
    LAS bf16_t* KtS = (LAS bf16_t*)(lds + 17408);
    LAS bf16_t* VT = (LAS bf16_t*)(lds + 34816);
    LAS bf16_t* STs = (LAS bf16_t*)(lds + 53248);
    LAS float* tot = (LAS float*)(lds + 88064);
    LAS float* eg = (LAS float*)(lds + 90112);
    LAS float* red = (LAS float*)(lds + 90624);
    const int d = tid & 127, part = tid >> 7, l15 = lane & 15, q4 = lane >> 4;
    const int tb = wid & 3, eh = wid >> 2;
    for (int unit = bid; unit < 16 * 128; unit += G) {
        const int bh = unit >> 7, n = unit & 127, b = bh >> 3, h = bh & 7;
        const size_t row0 = (size_t)b * SEQ + n * 64 + part * 16;
        const float* lfp = LF + row0 * 1024 + h * 128 + d;
        const bf16_t* vp = V + row0 * 1024 + h * 128 + d;
        const bf16_t* qp = Q + row0 * 1024 + h * 128 + d;
        float g[16], kk[16], qq[16]; unsigned vv[16];
#pragma unroll
        for (int j = 0; j < 16; ++j) { g[j] = lfp[(size_t)j * 1024]; vv[j] = vp[(size_t)j * 1024]; qq[j] = bf2f(qp[(size_t)j * 1024]); }
        u32x4 sreg[4];
        const bf16_t* stp = ST + (size_t)(bh * 128 + (n > 0 ? n - 1 : 0)) * 16384;
        if (n > 0) {
#pragma unroll
            for (int i = 0; i < 4; ++i) { const int p = tid + 512 * i; sreg[i] = *(const u32x4*)(stp + (size_t)(p >> 4) * 128 + (p & 15) * 8); }
        }
        float run = 0.f;
#pragma unroll
        for (int j = 0; j < 16; ++j) { kk[j] = 1.f - __expf(g[j]); run += g[j]; g[j] = run; }
        tot[part * 128 + d] = run;
        __syncthreads();
        const float t0 = tot[d], t1 = tot[128 + d], t2 = tot[256 + d];
        const float off = part == 0 ? 0.f : (part == 1 ? t0 : (part == 2 ? t0 + t1 : t0 + t1 + t2));
        const float gref = t0 + t1;
#pragma unroll
        for (int j = 0; j < 16; ++j) {
            const float gs = off + g[j];
            QtS[(part * 16 + j) * 136 + d] = (bf16_t)(pk2(qq[j] * __expf(gs - gref), 0.f) & 0xffffu);
            KtS[(part * 16 + j) * 136 + d] = (bf16_t)(pk2(kk[j] * __expf(gref - gs), 0.f) & 0xffffu);
        }
        u32x4 x0, x1;
        x0.x = vv[0] | (vv[1] << 16); x0.y = vv[2] | (vv[3] << 16); x0.z = vv[4] | (vv[5] << 16); x0.w = vv[6] | (vv[7] << 16);
        x1.x = vv[8] | (vv[9] << 16); x1.y = vv[10] | (vv[11] << 16); x1.z = vv[12] | (vv[13] << 16); x1.w = vv[14] | (vv[15] << 16);
        *(LAS u32x4*)(VT + d * 72 + part * 16) = x0; *(LAS u32x4*)(VT + d * 72 + part * 16 + 8) = x1;
        if (part == 0) eg[d] = __expf(gref);
        __syncthreads();
        if (n > 0) {
#pragma unroll
            for (int i = 0; i < 4; ++i) {
                const int p = tid + 512 * i, e = p >> 4, c8 = (p & 15) * 8;
                const f32x4 ea = *(const LAS f32x4*)(eg + c8), eb = *(const LAS f32x4*)(eg + c8 + 4);
                u32x4 w = sreg[i], o;
                o.x = pk2(bflo(w.x) * ea[0], bfhi(w.x) * ea[1]); o.y = pk2(bflo(w.y) * ea[2], bfhi(w.y) * ea[3]);
                o.z = pk2(bflo(w.z) * eb[0], bfhi(w.z) * eb[1]); o.w = pk2(bflo(w.w) * eb[2], bfhi(w.w) * eb[3]);
                *(LAS u32x4*)(STs + e * 136 + c8) = o;
            }
        }
        __syncthreads();
        bf16x8 qfr[4];
#pragma unroll
        for (int k4 = 0; k4 < 4; ++k4) qfr[k4] = *(const LAS bf16x8*)(QtS + (16 * tb + l15) * 136 + 32 * k4 + 8 * q4);
        f32x4 sc[4];
#pragma unroll
        for (int si = 0; si < 4; ++si) {
            sc[si] = (f32x4){0.f, 0.f, 0.f, 0.f};
            if (si <= tb) {
#pragma unroll
                for (int k4 = 0; k4 < 4; ++k4) {
                    const bf16x8 kf = *(const LAS bf16x8*)(KtS + (16 * si + l15) * 136 + 32 * k4 + 8 * q4);
                    sc[si] = __builtin_amdgcn_mfma_f32_16x16x32_bf16(kf, qfr[k4], sc[si], 0, 0, 0);
                }
            }
#pragma unroll
            for (int r = 0; r < 4; ++r) if (!(16 * si + 4 * q4 + r <= 16 * tb + l15)) sc[si][r] = 0.f;
        }
        bf16x8 pf[2];
#pragma unroll
        for (int ks = 0; ks < 2; ++ks) {
            u32x4 w; w.x = pk2(sc[2 * ks][0], sc[2 * ks][1]); w.y = pk2(sc[2 * ks][2], sc[2 * ks][3]); w.z = pk2(sc[2 * ks + 1][0], sc[2 * ks + 1][1]); w.w = pk2(sc[2 * ks + 1][2], sc[2 * ks + 1][3]);
            pf[ks] = __builtin_bit_cast(bf16x8, w);
        }
        f32x4 oa[4]; float ss = 0.f;
#pragma unroll
        for (int et = 0; et < 4; ++et) {
            const int erow = 64 * eh + 16 * et + l15;
            oa[et] = (f32x4){0.f, 0.f, 0.f, 0.f};
#pragma unroll
            for (int ks = 0; ks < 2; ++ks) {
                if (ks == 0 || tb >= 2) {
                    const u32x2 lo = *(const LAS u32x2*)(VT + erow * 72 + 32 * ks + 4 * q4), hi = *(const LAS u32x2*)(VT + erow * 72 + 32 * ks + 16 + 4 * q4);
                    const u32x4 w = {lo.x, lo.y, hi.x, hi.y};
                    oa[et] = __builtin_amdgcn_mfma_f32_16x16x32_bf16(__builtin_bit_cast(bf16x8, w), pf[ks], oa[et], 0, 0, 0);
                }
            }
            if (n > 0) {
#pragma unroll
                for (int k4 = 0; k4 < 4; ++k4) {
                    const bf16x8 sf = *(const LAS bf16x8*)(STs + erow * 136 + 32 * k4 + 8 * q4);
                    oa[et] = __builtin_amdgcn_mfma_f32_16x16x32_bf16(sf, qfr[k4], oa[et], 0, 0, 0);
                }
            }
            ss += (oa[et][0] * oa[et][0] + oa[et][1] * oa[et][1]) + (oa[et][2] * oa[et][2] + oa[et][3] * oa[et][3]);
        }
        ss += __shfl_xor(ss, 16); ss += __shfl_xor(ss, 32);
        if (q4 == 0) red[(16 * tb + l15) * 2 + eh] = ss;
        __syncthreads();
        const float tss = red[(16 * tb + l15) * 2] + red[(16 * tb + l15) * 2 + 1];
        const float rstd = rsqrtf(tss * (1.f / 128.f) + EPS);
        const size_t orow = (size_t)b * SEQ + n * 64 + 16 * tb + l15;
#pragma unroll
        for (int et = 0; et < 4; ++et) {
            const int e0 = 64 * eh + 16 * et + 4 * q4;
            const f32x4 gn = *(const f32x4*)(onorm + e0);
            const u32x2 gt = *(const u32x2*)(Gt + orow * 1024 + h * 128 + e0);
            u32x2 o;
            o.x = pk2(oa[et][0] * rstd * gn[0] * bflo(gt.x), oa[et][1] * rstd * gn[1] * bfhi(gt.x));
            o.y = pk2(oa[et][2] * rstd * gn[2] * bflo(gt.y), oa[et][3] * rstd * gn[3] * bfhi(gt.y));
            *(u32x2*)(OH + orow * 1024 + h * 128 + e0) = o;
        }
    }
}

__device__ __forceinline__ void rope_cs(float ang, float& c, float& s) {
    const float n = rintf(ang * 0.15915494309189535f);
    float r = fmaf(-n, 6.2831855f, ang); r = fmaf(-n, -1.7484555e-7f, r);
    c = __cosf(r); s = __sinf(r);
}
__device__ __forceinline__ void mla_finalize(bf16_t* QF, const bf16_t* KN, const float* KR, bf16_t* KF, const int* pos, const float* invf, const float* qg, const float* kg, int gw, int NGW, int lane) {
    const int hd = lane >> 3, sub = lane & 7;
    float gq[16], gk[16], gq1[4], gq2[4], gk1[4], gk2[4], fr[4];
#pragma unroll
    for (int e = 0; e < 16; ++e) { gq[e] = qg[16 * sub + e]; gk[e] = kg[16 * sub + e]; }
#pragma unroll
    for (int j = 0; j < 4; ++j) { gq1[j] = qg[128 + 4 * sub + j]; gq2[j] = qg[160 + 4 * sub + j]; gk1[j] = kg[128 + 4 * sub + j]; gk2[j] = kg[160 + 4 * sub + j]; fr[j] = invf[4 * sub + j]; }
    for (int row = gw; row < M; row += NGW) {
        const float pf = (float)pos[row];
        float cs[4], sn[4];
#pragma unroll
        for (int j = 0; j < 4; ++j) rope_cs(pf * fr[j], cs[j], sn[j]);
        {
            bf16_t* qp = QF + (size_t)row * 1536 + hd * 192;
            const u32x4 a = *(const u32x4*)(qp + 16 * sub), b2 = *(const u32x4*)(qp + 16 * sub + 8);
            const u32x2 r1 = *(const u32x2*)(qp + 128 + 4 * sub), r2 = *(const u32x2*)(qp + 160 + 4 * sub);
            float xn[16], x1[4], x2[4];
            xn[0] = bflo(a.x); xn[1] = bfhi(a.x); xn[2] = bflo(a.y); xn[3] = bfhi(a.y); xn[4] = bflo(a.z); xn[5] = bfhi(a.z); xn[6] = bflo(a.w); xn[7] = bfhi(a.w);
            xn[8] = bflo(b2.x); xn[9] = bfhi(b2.x); xn[10] = bflo(b2.y); xn[11] = bfhi(b2.y); xn[12] = bflo(b2.z); xn[13] = bfhi(b2.z); xn[14] = bflo(b2.w); xn[15] = bfhi(b2.w);
            x1[0] = bflo(r1.x); x1[1] = bfhi(r1.x); x1[2] = bflo(r1.y); x1[3] = bfhi(r1.y);
            x2[0] = bflo(r2.x); x2[1] = bfhi(r2.x); x2[2] = bflo(r2.y); x2[3] = bfhi(r2.y);
            float ss = 0.f;
#pragma unroll
            for (int e = 0; e < 16; ++e) ss += xn[e] * xn[e];
#pragma unroll
            for (int j = 0; j < 4; ++j) ss += x1[j] * x1[j] + x2[j] * x2[j];
            ss += __shfl_xor(ss, 1); ss += __shfl_xor(ss, 2); ss += __shfl_xor(ss, 4);
            const float rs = rsqrtf(ss * (1.f / 192.f) + EPS) * QSCALE;
#pragma unroll
            for (int e = 0; e < 16; ++e) xn[e] *= rs * gq[e];
            float o1[4], o2[4];
#pragma unroll
            for (int j = 0; j < 4; ++j) { const float y1 = x1[j] * rs * gq1[j], y2 = x2[j] * rs * gq2[j]; o1[j] = y1 * cs[j] - y2 * sn[j]; o2[j] = y2 * cs[j] + y1 * sn[j]; }
            u32x4 wa, wb; u32x2 w1, w2;
            wa.x = pk2(xn[0], xn[1]); wa.y = pk2(xn[2], xn[3]); wa.z = pk2(xn[4], xn[5]); wa.w = pk2(xn[6], xn[7]);
            wb.x = pk2(xn[8], xn[9]); wb.y = pk2(xn[10], xn[11]); wb.z = pk2(xn[12], xn[13]); wb.w = pk2(xn[14], xn[15]);
            w1.x = pk2(o1[0], o1[1]); w1.y = pk2(o1[2], o1[3]); w2.x = pk2(o2[0], o2[1]); w2.y = pk2(o2[2], o2[3]);
            *(u32x4*)(qp + 16 * sub) = wa; *(u32x4*)(qp + 16 * sub + 8) = wb; *(u32x2*)(qp + 128 + 4 * sub) = w1; *(u32x2*)(qp + 160 + 4 * sub) = w2;
        }
        {
            const bf16_t* kp = KN + (size_t)row * 1024 + hd * 128;
            const u32x4 a = *(const u32x4*)(kp + 16 * sub), b2 = *(const u32x4*)(kp + 16 * sub + 8);
            const f32x4 r1 = *(const f32x4*)(KR + (size_t)row * 64 + 4 * sub), r2 = *(const f32x4*)(KR + (size_t)row * 64 + 32 + 4 * sub);
            float xn[16];
            xn[0] = bflo(a.x); xn[1] = bfhi(a.x); xn[2] = bflo(a.y); xn[3] = bfhi(a.y); xn[4] = bflo(a.z); xn[5] = bfhi(a.z); xn[6] = bflo(a.w); xn[7] = bfhi(a.w);
            xn[8] = bflo(b2.x); xn[9] = bfhi(b2.x); xn[10] = bflo(b2.y); xn[11] = bfhi(b2.y); xn[12] = bflo(b2.z); xn[13] = bfhi(b2.z); xn[14] = bflo(b2.w); xn[15] = bfhi(b2.w);
            float ss = 0.f;
#pragma unroll
            for (int e = 0; e < 16; ++e) ss += xn[e] * xn[e];
#pragma unroll
            for (int j = 0; j < 4; ++j) ss += r1[j] * r1[j] + r2[j] * r2[j];
            ss += __shfl_xor(ss, 1); ss += __shfl_xor(ss, 2); ss += __shfl_xor(ss, 4);
            const float rs = rsqrtf(ss * (1.f / 192.f) + EPS);
#pragma unroll
            for (int e = 0; e < 16; ++e) xn[e] *= rs * gk[e];
            float o1[4], o2[4];
#pragma unroll
            for (int j = 0; j < 4; ++j) { const float y1 = r1[j] * rs * gk1[j], y2 = r2[j] * rs * gk2[j]; o1[j] = y1 * cs[j] - y2 * sn[j]; o2[j] = y2 * cs[j] + y1 * sn[j]; }
            bf16_t* op = KF + (size_t)row * 1536 + hd * 192;
            u32x4 wa, wb; u32x2 w1, w2;
            wa.x = pk2(xn[0], xn[1]); wa.y = pk2(xn[2], xn[3]); wa.z = pk2(xn[4], xn[5]); wa.w = pk2(xn[6], xn[7]);
            wb.x = pk2(xn[8], xn[9]); wb.y = pk2(xn[10], xn[11]); wb.z = pk2(xn[12], xn[13]); wb.w = pk2(xn[14], xn[15]);
            w1.x = pk2(o1[0], o1[1]); w1.y = pk2(o1[2], o1[3]); w2.x = pk2(o2[0], o2[1]); w2.y = pk2(o2[2], o2[3]);
            *(u32x4*)(op + 16 * sub) = wa; *(u32x4*)(op + 16 * sub + 8) = wb; *(u32x2*)(op + 128 + 4 * sub) = w1; *(u32x2*)(op + 160 + 4 * sub) = w2;
        }
    }
}

__device__ __forceinline__ int crow(int r, int hi) { return (r & 3) + 8 * (r >> 2) + 4 * hi; }

__device__ __forceinline__ void attn_unit(LAS unsigned char* lds, const bf16_t* QF, const bf16_t* KF, const bf16_t* VT, bf16_t* O, int b, int h, int qb) {
    int tid = threadIdx.x; asm volatile("" : "+v"(tid));
    const int lane = tid & 63, wid = __builtin_amdgcn_readfirstlane(tid >> 6), l31 = lane & 31, hi = lane >> 5;
    LAS bf16_t* Ks = (LAS bf16_t*)lds;
    LAS bf16_t* Vs = (LAS bf16_t*)(lds + 25600);
    const int q0 = qb * 256, qw = q0 + wid * 32;
    const size_t rowb = (size_t)b * SEQ;
    bf16x8 qf[12];
    {
        const bf16_t* qp = QF + (rowb + qw + l31) * 1536 + h * 192 + hi * 8;
#pragma unroll
        for (int ks = 0; ks < 12; ++ks) qf[ks] = *(const bf16x8*)(qp + ks * 16);
    }
    f32x16 o[4];
#pragma unroll
    for (int i = 0; i < 4; ++i)
#pragma unroll
        for (int r = 0; r < 16; ++r) o[i][r] = 0.f;
    float mrun = -INFINITY, lrun = 0.f;
    const int NT = (q0 + 256) / 64;
    unsigned kgo[3], klo[3], vgo[2], vlo[2];
#pragma unroll
    for (int i = 0; i < 3; ++i) { const int p = tid + 512 * i, r = p / 24, c = p % 24; kgo[i] = (unsigned)(r * 1536 + c * 8) * 2u; klo[i] = (unsigned)(r * 200 + c * 8) * 2u; }
#pragma unroll
    for (int i = 0; i < 2; ++i) { const int p = tid + 512 * i; vgo[i] = (unsigned)((p >> 3) * M + (p & 7) * 8) * 2u; vlo[i] = (unsigned)((p >> 3) * 72 + (p & 7) * 8) * 2u; }
    const char* kbase = (const char*)(KF + rowb * 1536 + h * 192);
    const char* vbase = (const char*)(VT + (size_t)(h * 128) * M + rowb);
    u32x4 kreg[3], vreg[2];
#pragma unroll
    for (int i = 0; i < 3; ++i) kreg[i] = *(const u32x4*)(kbase + kgo[i]);
#pragma unroll
    for (int i = 0; i < 2; ++i) vreg[i] = *(const u32x4*)(vbase + vgo[i]);
    for (int j = 0; j < NT; ++j) {
        const int kv0 = 64 * j;
        __syncthreads();
#pragma unroll
        for (int i = 0; i < 3; ++i) *(LAS u32x4*)((LAS unsigned char*)Ks + klo[i]) = kreg[i];
#pragma unroll
        for (int i = 0; i < 2; ++i) *(LAS u32x4*)((LAS unsigned char*)Vs + vlo[i]) = vreg[i];
        __syncthreads();
        if (j + 1 < NT) {
            const char* kb2 = kbase + (size_t)(kv0 + 64) * 3072; const char* vb2 = vbase + (size_t)(kv0 + 64) * 2;
#pragma unroll
            for (int i = 0; i < 3; ++i) kreg[i] = *(const u32x4*)(kb2 + kgo[i]);
#pragma unroll
            for (int i = 0; i < 2; ++i) vreg[i] = *(const u32x4*)(vb2 + vgo[i]);
        }
        if (kv0 <= qw + 31) {
            f32x16 p0, p1;
#pragma unroll
            for (int r = 0; r < 16; ++r) { p0[r] = 0.f; p1[r] = 0.f; }
#pragma unroll
            for (int ks = 0; ks < 12; ++ks) {
                const bf16x8 a0 = *(const LAS bf16x8*)(Ks + l31 * 200 + ks * 16 + hi * 8);
                const bf16x8 a1 = *(const LAS bf16x8*)(Ks + (32 + l31) * 200 + ks * 16 + hi * 8);
                p0 = __builtin_amdgcn_mfma_f32_32x32x16_bf16(a0, qf[ks], p0, 0, 0, 0);
                p1 = __builtin_amdgcn_mfma_f32_32x32x16_bf16(a1, qf[ks], p1, 0, 0, 0);
                if (ks & 1) asm volatile("" ::: "memory");
            }
            if (kv0 + 63 > qw) {
                const int q = qw + l31;
#pragma unroll
                for (int r = 0; r < 16; ++r) { const int kv = kv0 + crow(r, hi); if (kv > q) p0[r] = -INFINITY; if (kv + 32 > q) p1[r] = -INFINITY; }
            }
            float mx = fmaxf(p0[0], p1[0]);
#pragma unroll
            for (int r = 1; r < 16; ++r) mx = fmaxf(mx, fmaxf(p0[r], p1[r]));
            mx = fmaxf(mx, __shfl_xor(mx, 32));
            const float mnew = fmaxf(mrun, mx);
            const float alpha = __builtin_amdgcn_exp2f(mrun - mnew);
            mrun = mnew;
            float rsum = 0.f;
#pragma unroll
            for (int r = 0; r < 16; ++r) { p0[r] = __builtin_amdgcn_exp2f(p0[r] - mnew); p1[r] = __builtin_amdgcn_exp2f(p1[r] - mnew); rsum += p0[r] + p1[r]; }
            lrun = lrun * alpha + rsum;
#pragma unroll
            for (int i = 0; i < 4; ++i)
#pragma unroll
                for (int r = 0; r < 16; ++r) o[i][r] *= alpha;
            bf16x8 pf[4];
            {
                u32x4 w;
                w.x = pk2(p0[0], p0[1]); w.y = pk2(p0[2], p0[3]); w.z = pk2(p0[4], p0[5]); w.w = pk2(p0[6], p0[7]); pf[0] = __builtin_bit_cast(bf16x8, w);
                w.x = pk2(p0[8], p0[9]); w.y = pk2(p0[10], p0[11]); w.z = pk2(p0[12], p0[13]); w.w = pk2(p0[14], p0[15]); pf[1] = __builtin_bit_cast(bf16x8, w);
                w.x = pk2(p1[0], p1[1]); w.y = pk2(p1[2], p1[3]); w.z = pk2(p1[4], p1[5]); w.w = pk2(p1[6], p1[7]); pf[2] = __builtin_bit_cast(bf16x8, w);
                w.x = pk2(p1[8], p1[9]); w.y = pk2(p1[10], p1[11]); w.z = pk2(p1[12], p1[13]); w.w = pk2(p1[14], p1[15]); pf[3] = __builtin_bit_cast(bf16x8, w);
            }
#pragma unroll
            for (int db = 0; db < 4; ++db)
#pragma unroll
                for (int st = 0; st < 4; ++st) {
                    const u32x2 lo = *(const LAS u32x2*)(Vs + (32 * db + l31) * 72 + 16 * st + 4 * hi), hh = *(const LAS u32x2*)(Vs + (32 * db + l31) * 72 + 16 * st + 8 + 4 * hi);
                    const u32x4 w = {lo.x, lo.y, hh.x, hh.y};
                    o[db] = __builtin_amdgcn_mfma_f32_32x32x16_bf16(__builtin_bit_cast(bf16x8, w), pf[st], o[db], 0, 0, 0);
                    if (st == 3) asm volatile("" ::: "memory");
                }
        }
    }
    lrun += __shfl_xor(lrun, 32);
    const float inv = 1.f / lrun;
    bf16_t* op = O + (rowb + qw + l31) * 1024 + h * 128 + 4 * hi;
#pragma unroll
    for (int db = 0; db < 4; ++db)
#pragma unroll
        for (int g = 0; g < 4; ++g) {
            u32x2 w; w.x = pk2(o[db][4 * g] * inv, o[db][4 * g + 1] * inv); w.y = pk2(o[db][4 * g + 2] * inv, o[db][4 * g + 3] * inv);
            *(u32x2*)(op + 32 * db + 8 * g) = w;
        }
}

template <class Epi> __device__ __forceinline__ void run_gemm(LAS unsigned char* lds, const bf16_t* A, int arows, const bf16_t* Bt, int nM, int nN, int K, int G, int c, const Epi& E) {
    pg8::Gemm g{A, Bt, nM * 256, nN * 256, K, arows};
    pg8::StaticOrder S; S.init2(nM, nN, G, c);
    pg8::gemm_phase<Epi, pg8::StaticOrder, true, true>(lds, g, S, E);
}

#define GRID_SYNC() do { asm volatile("s_waitcnt vmcnt(0) lgkmcnt(0)" ::: "memory"); grid.sync(); __builtin_amdgcn_fence(__ATOMIC_ACQUIRE, "agent"); asm volatile("s_waitcnt vmcnt(0)" ::: "memory"); } while (0)
typedef const __attribute__((address_space(4))) Args* KArgs;
#define KA() ({ KArgs k_ = (KArgs)__builtin_amdgcn_kernarg_segment_ptr(); asm volatile("" : "+s"(k_)); k_; })

#ifdef STOP_LAYER
__device__ __forceinline__ void dump_bf16(float* o, const bf16_t* p, size_t n, bool add, int gtid, int gthreads) {
    const size_t per = (n + (size_t)M * DM - 1) / ((size_t)M * DM);
    for (size_t i = gtid; i < (size_t)M * DM; i += gthreads) { float a = add ? o[i] : 0.f; for (size_t k = 0; k < per; ++k) { const size_t q = i * per + k; if (q < n) a += bf2f(p[q]); } o[i] = a; }
}
__device__ __forceinline__ void dump_f32(float* o, const float* p, size_t n, bool add, int gtid, int gthreads) {
    const size_t per = (n + (size_t)M * DM - 1) / ((size_t)M * DM);
    for (size_t i = gtid; i < (size_t)M * DM; i += gthreads) { float a = add ? o[i] : 0.f; for (size_t k = 0; k < per; ++k) { const size_t q = i * per + k; if (q < n) a += p[q]; } o[i] = a; }
}
#define STOP(ph, stmts) do { if (layer == STOP_LAYER && (ph) == STOP_PHASE) { KArgs ka = KA(); unsigned char* ws = ka->ws; float* o = ka->out; int tid_ = threadIdx.x; asm volatile("" : "+v"(tid_)); const int gt = bid * NTHREADS + tid_; (void)ws; (void)o; (void)gt; stmts; return; } } while (0)
#define DBF(ptr, n, add) dump_bf16(o, ptr, n, add, gt, gthreads)
#define DFF_(ptr, n, add) dump_f32(o, ptr, n, add, gt, gthreads)
#else
#define STOP(ph, stmts) do {} while (0)
#endif


#ifdef DIAG_BISECT
__device__ __forceinline__ void dg_bf16(const bf16_t* p, size_t n, unsigned code, unsigned* diag, int gtid, int gthreads, float lim = 1e6f) {
    bool bad = false;
    for (size_t i = (size_t)gtid * 8; i < n; i += (size_t)gthreads * 8) {
        const u32x4 w = *(const u32x4*)(p + i);
        const unsigned ws4[4] = {w.x, w.y, w.z, w.w};
#pragma unroll
        for (int k = 0; k < 4; ++k) { const float a = bflo(ws4[k]), b = bfhi(ws4[k]); if (!(fabsf(a) < lim) || !(fabsf(b) < lim)) bad = true; }
    }
    if (bad) atomicMin(diag, code * 10u);
}
__device__ __forceinline__ void dg_f32(const float* p, size_t n, unsigned code, unsigned* diag, int gtid, int gthreads, float lim = 1e8f) {
    bool bad = false;
    for (size_t i = (size_t)gtid; i < n; i += (size_t)gthreads) { if (!(fabsf(p[i]) < lim)) bad = true; }
    if (bad) atomicMin(diag, code * 10u);
}
__device__ __forceinline__ void dg_pos(const float* p, size_t n, unsigned code, unsigned* diag, int gtid, int gthreads) {
    bool bad = false;
    for (size_t i = (size_t)gtid; i < n; i += (size_t)gthreads) { if (p[i] > 1e-3f) bad = true; }
    if (bad) atomicMin(diag, code * 10u);
}
#define DG(stmts) do { KArgs ka = KA(); unsigned char* ws = ka->ws; unsigned* diag = (unsigned*)(ws + 32768); int tid_ = threadIdx.x; asm volatile("" : "+v"(tid_)); const int gt = bid * NTHREADS + tid_; (void)diag; (void)gt; stmts; } while (0)
#define DB(ptr, n, code) dg_bf16(ptr, n, code, diag, gt, gthreads)
#define DF(ptr, n, code) dg_f32(ptr, n, code, diag, gt, gthreads)
#else
#define DG(stmts) do {} while (0)
#endif

#define INF(k) ((const float*)ka->in[k])
#define WSP(T, off) ((T*)(ws + (off)))

__global__ void __launch_bounds__(NTHREADS, 2) trunk_fwd(Args args) {
    extern __shared__ __attribute__((aligned(16))) unsigned char lds_raw[];
    cg::grid_group grid = cg::this_grid();
    LAS unsigned char* lds = (LAS unsigned char*)lds_raw;
    const int G = gridDim.x, bid = blockIdx.x;
    const int vcu = (G % 8 == 0) ? (bid % 8) * (G / 8) + bid / 8 : bid;
    const int NGW = G * NWAVES, gthreads = G * NTHREADS;
    (void)args;

    {
        KArgs ka = KA(); unsigned char* ws = ka->ws;
        int tid = threadIdx.x; asm volatile("" : "+v"(tid));
        const int lane = tid & 63, wave = __builtin_amdgcn_readfirstlane(tid >> 6), gw = vcu * NWAVES + wave, gtid = bid * NTHREADS + tid;
        LAS float* scr = (LAS float*)(lds + wave * 16384);
        float* SSQ = WSP(float, WS_SSQ); float* LBT = WSP(float, WS_LBT); float* INVF = WSP(float, WS_INVF); bf16_t* XB = WSP(bf16_t, WS_XB);
        const float* x_in = INF(0); const float* hgrn_lbs = INF(5);
        for (int i = gtid; i < 2048; i += gthreads) {
            const int c = i & 1023;
            LBT[i] = (i < 1024) ? 0.f : 1.f / (1.f + __expf(hgrn_lbs[c] - hgrn_lbs[1024 + c]));
        }
#ifdef DIAG_BISECT
        if (gtid == 0) *(unsigned*)(ws + 32768) = 990u;
#endif
        if (gtid < 32) INVF[gtid] = exp2f(-(float)gtid * (13.287712379549449f / 32.0f));
        for (int m = gw; m < M; m += NGW) {
            const f32x4* xr = (const f32x4*)(x_in + (size_t)m * 1024) + lane;
            float s = 0.f; f32x4 v[4];
#pragma unroll
            for (int j = 0; j < 4; ++j) { v[j] = xr[64 * j]; s += (v[j][0] * v[j][0] + v[j][1] * v[j][1]) + (v[j][2] * v[j][2] + v[j][3] * v[j][3]); }
            s = wave_sum(s);
            u32x2* o8 = (u32x2*)(XB + (size_t)m * 1024) + lane;
#pragma unroll
            for (int j = 0; j < 4; ++j) { u32x2 w; w.x = pk2(v[j][0], v[j][1]); w.y = pk2(v[j][2], v[j][3]); o8[64 * j] = w; }
            if (lane < 4) SSQ[(size_t)lane * M + m] = (lane == 0) ? s : 0.f;
        }
        int rot = 0;
        for (int j = 0; j < 2; ++j) {
            cvt_job(INF(4) + (size_t)j * 1024 * 4096, 1024, 4096, INF(2) + (2 * j) * 1024, WSP(bf16_t, WS_WHIN) + (size_t)j * 4096 * 1024, 4096, 0, rot, gw, NGW, scr, lane);
            cvt_job(INF(7) + (size_t)j * 1024 * 1024, 1024, 1024, nullptr, WSP(bf16_t, WS_WHOUT) + (size_t)j * 1024 * 1024, 1024, 0, rot, gw, NGW, scr, lane);
            cvt_job(INF(8) + (size_t)j * 1024 * 576, 1024, 576, INF(2) + (2 * j + 1) * 1024, WSP(bf16_t, WS_WMIN) + (size_t)j * 768 * 1024, 576, 0, rot, gw, NGW, scr, lane);
            cvt_job(INF(10) + (size_t)j * 256 * 1536, 256, 1536, INF(9) + j * 256, WSP(bf16_t, WS_WQ) + (size_t)j * 1536 * 256, 1536, 0, rot, gw, NGW, scr, lane);
            cvt_job(INF(12) + (size_t)j * 256 * 2048, 256, 2048, INF(11) + j * 256, WSP(bf16_t, WS_WKN) + (size_t)j * 1024 * 256, 1024, 1, rot, gw, NGW, scr, lane);
            cvt_job(INF(12) + (size_t)j * 256 * 2048, 256, 2048, INF(11) + j * 256, WSP(bf16_t, WS_WV) + (size_t)j * 1024 * 256, 1024, 2, rot, gw, NGW, scr, lane);
            cvt_job(INF(15) + (size_t)j * 1024 * 1024, 1024, 1024, nullptr, WSP(bf16_t, WS_WMOUT) + (size_t)j * 1024 * 1024, 1024, 0, rot, gw, NGW, scr, lane);
        }
    }
    GRID_SYNC();

    for (int layer = 0; layer < 4; ++layer) {
        const int j = layer >> 1;
        const unsigned cb_ = 20u * (unsigned)layer; (void)cb_;
        if (layer == 0) DG(DB(WSP(bf16_t, WS_XB), (size_t)M * 1024, 1); DF(WSP(float, WS_SSQ), (size_t)4 * M, 1); DB(WSP(bf16_t, WS_WHIN), (size_t)4096 * 1024, 1); DB(WSP(bf16_t, WS_WHOUT), (size_t)1024 * 1024, 1));
        if ((layer & 1) == 0) {
#ifndef SKIP_H1
            { KArgs ka = KA(); unsigned char* ws = ka->ws;
              epi::EpiHgrnIn E{WSP(float, WS_SSQ) + (size_t)(2 * layer) * 4 * M, WSP(float, WS_LBT) + j * 1024, WSP(bf16_t, WS_QH), WSP(bf16_t, WS_VH), WSP(bf16_t, WS_GH), WSP(float, WS_LF)};
              run_gemm(lds, WSP(bf16_t, WS_XB), 256, WSP(bf16_t, WS_WHIN) + (size_t)j * 4096 * 1024, 64, 16, 1024, G, bid, E); }
#endif
            GRID_SYNC();
            STOP(1, DBF(WSP(bf16_t, WS_QH), (size_t)M * 1024, false); DBF(WSP(bf16_t, WS_VH), (size_t)M * 1024, true); DBF(WSP(bf16_t, WS_GH), (size_t)M * 1024, true); DFF_(WSP(float, WS_LF), (size_t)M * 1024, true));
            DG(dg_bf16(WSP(bf16_t, WS_QH), (size_t)M * 1024, cb_ + 2, diag, gt, gthreads, 100.f); dg_bf16(WSP(bf16_t, WS_VH), (size_t)M * 1024, cb_ + 2, diag, gt, gthreads, 100.f); dg_bf16(WSP(bf16_t, WS_GH), (size_t)M * 1024, cb_ + 2, diag, gt, gthreads, 100.f); dg_f32(WSP(float, WS_LF), (size_t)M * 1024, cb_ + 2, diag, gt, gthreads, 100.f); dg_pos(WSP(float, WS_LF), (size_t)M * 1024, cb_ + 3, diag, gt, gthreads));
#ifndef SKIP_H2
            { KArgs ka = KA(); unsigned char* ws = ka->ws; hgrn_local(lds, WSP(bf16_t, WS_VH), WSP(float, WS_LF), WSP(bf16_t, WS_ST), WSP(float, WS_DL), G, bid, (unsigned*)(ws + 32768)); }
#endif
            GRID_SYNC();
            STOP(2, DBF(WSP(bf16_t, WS_ST), (size_t)16 * 128 * 16384 - 16384, false); DFF_(WSP(float, WS_DL), (size_t)16 * 128 * 128 - 128, true));
            DG(for (int q_ = 0; q_ < 16; ++q_) DB(WSP(bf16_t, WS_ST) + (size_t)q_ * 128 * 16384, (size_t)127 * 16384, cb_ + 5); DF(WSP(float, WS_DL), (size_t)16 * 128 * 128 - 128, cb_ + 4));
#ifndef SKIP_H3
            { KArgs ka = KA(); unsigned char* ws = ka->ws; int tid = threadIdx.x; asm volatile("" : "+v"(tid)); hgrn_scan(WSP(bf16_t, WS_ST), WSP(float, WS_DL), bid * NTHREADS + tid, gthreads); }
#endif
        } else {
#ifndef SKIP_M1
            { KArgs ka = KA(); unsigned char* ws = ka->ws;
              epi::EpiMlaIn E{WSP(float, WS_SSQ) + (size_t)(2 * layer) * 4 * M, WSP(bf16_t, WS_CQ), WSP(bf16_t, WS_CKV), WSP(float, WS_KR), WSP(float, WS_SSQCQ) + (size_t)j * M, WSP(float, WS_SSQCKV) + (size_t)j * M, (LAS float*)(lds + HALO_OFF)};
              run_gemm(lds, WSP(bf16_t, WS_XB), 256, WSP(bf16_t, WS_WMIN) + (size_t)j * 768 * 1024, 64, 3, 1024, G, bid, E); }
#endif
            GRID_SYNC();
            STOP(1, DBF(WSP(bf16_t, WS_CQ), (size_t)M * 256, false); DBF(WSP(bf16_t, WS_CKV), (size_t)M * 256, true); DFF_(WSP(float, WS_KR), (size_t)M * 64, true); DFF_(WSP(float, WS_SSQCQ) + (size_t)j * M, (size_t)4 * M, true));
            DG(DB(WSP(bf16_t, WS_CQ), (size_t)M * 256, cb_ + 2); DB(WSP(bf16_t, WS_CKV), (size_t)M * 256, cb_ + 2); DF(WSP(float, WS_KR), (size_t)M * 64, cb_ + 2); DF(WSP(float, WS_SSQCQ) + (size_t)j * M, (size_t)4 * M, cb_ + 2));
#ifndef SKIP_M2A
            { KArgs ka = KA(); unsigned char* ws = ka->ws;
              epi::EpiScale<true> E{WSP(float, WS_SSQCQ) + (size_t)j * M, 1.f / 256.f, WSP(bf16_t, WS_QF), 1536}; run_gemm(lds, WSP(bf16_t, WS_CQ), 256, WSP(bf16_t, WS_WQ) + (size_t)j * 1536 * 256, 64, 6, 256, G, bid, E); }
#endif
#ifndef SKIP_M2B
            { KArgs ka = KA(); unsigned char* ws = ka->ws;
              epi::EpiScale<true> E{WSP(float, WS_SSQCKV) + (size_t)j * M, 1.f / 256.f, WSP(bf16_t, WS_KN), 1024}; run_gemm(lds, WSP(bf16_t, WS_CKV), 256, WSP(bf16_t, WS_WKN) + (size_t)j * 1024 * 256, 64, 4, 256, G, (bid + 128) % G, E); }
#endif
#ifndef SKIP_M2C
            { KArgs ka = KA(); unsigned char* ws = ka->ws;
              epi::EpiScale<false> E{WSP(float, WS_SSQCKV) + (size_t)j * M, 1.f / 256.f, WSP(bf16_t, WS_VT), M}; run_gemm(lds, WSP(bf16_t, WS_WV) + (size_t)j * 1024 * 256, 256, WSP(bf16_t, WS_CKV), 4, 64, 256, G, (bid + 128) % G, E); }
#endif
            GRID_SYNC();
            STOP(2, DBF(WSP(bf16_t, WS_QF), (size_t)M * 1536, false); DBF(WSP(bf16_t, WS_KN), (size_t)M * 1024, true); DBF(WSP(bf16_t, WS_VT), (size_t)M * 1024, true));
            DG(DB(WSP(bf16_t, WS_QF), (size_t)M * 1536, cb_ + 5); DB(WSP(bf16_t, WS_KN), (size_t)M * 1024, cb_ + 5); DB(WSP(bf16_t, WS_VT), (size_t)M * 1024, cb_ + 5));
#ifndef SKIP_M3
            { KArgs ka = KA(); unsigned char* ws = ka->ws; int tid = threadIdx.x; asm volatile("" : "+v"(tid));
              const int wave = __builtin_amdgcn_readfirstlane(tid >> 6);
              mla_finalize(WSP(bf16_t, WS_QF), WSP(bf16_t, WS_KN), WSP(float, WS_KR), WSP(bf16_t, WS_KF), (const int*)ka->in[1], WSP(float, WS_INVF), INF(13) + j * 192, INF(14) + j * 192, vcu * NWAVES + wave, NGW, tid & 63); }
#endif
        }
        {
            KArgs ka = KA(); unsigned char* ws = ka->ws; int tid = threadIdx.x; asm volatile("" : "+v"(tid));
            const int wave = __builtin_amdgcn_readfirstlane(tid >> 6);
            LAS float* scr = (LAS float*)(lds + wave * 16384);
            __syncthreads();
            int rot = 0;
            cvt_job(INF(16) + (size_t)layer * 1024 * DFF2, 1024, DFF2, INF(3) + layer * 1024, WSP(bf16_t, WS_WUP), DFF2, 3, rot, vcu * NWAVES + wave, NGW, scr, tid & 63);
            cvt_job(INF(19) + (size_t)layer * DFF * 1024, DFF, 1024, nullptr, WSP(bf16_t, WS_WDN), 1024, 0, rot, vcu * NWAVES + wave, NGW, scr, tid & 63);
        }
        GRID_SYNC();
        STOP(3, DBF(WSP(bf16_t, WS_WUP), (size_t)DFF2 * 1024, false); DBF(WSP(bf16_t, WS_WDN), (size_t)DFF * 1024, true); if ((layer & 1) == 0) { DBF(WSP(bf16_t, WS_ST), (size_t)16 * 128 * 16384 - 16384, true); } else { DBF(WSP(bf16_t, WS_QF), (size_t)M * 1536, true); DBF(WSP(bf16_t, WS_KF), (size_t)M * 1536, true); });
        DG(DB(WSP(bf16_t, WS_WUP), (size_t)DFF2 * 1024, cb_ + 6); DB(WSP(bf16_t, WS_WDN), (size_t)DFF * 1024, cb_ + 6);
           if ((layer & 1) == 0) { for (int q_ = 0; q_ < 16; ++q_) DB(WSP(bf16_t, WS_ST) + (size_t)q_ * 128 * 16384, (size_t)127 * 16384, cb_ + 7); } else { DB(WSP(bf16_t, WS_QF), (size_t)M * 1536, cb_ + 7); DB(WSP(bf16_t, WS_KF), (size_t)M * 1536, cb_ + 7); });
        if ((layer & 1) == 0) {
#ifndef SKIP_H4
            { KArgs ka = KA(); unsigned char* ws = ka->ws;
              hgrn_out(lds, WSP(bf16_t, WS_QH), WSP(bf16_t, WS_VH), WSP(bf16_t, WS_GH), WSP(float, WS_LF), WSP(bf16_t, WS_ST), INF(6) + j * 128, WSP(bf16_t, WS_QH), G, bid); }
#endif
            GRID_SYNC();
            STOP(4, DBF(WSP(bf16_t, WS_QH), (size_t)M * 1024, false));
            DG(DB(WSP(bf16_t, WS_QH), (size_t)M * 1024, cb_ + 8));
#ifndef SKIP_H5
            { KArgs ka = KA(); unsigned char* ws = ka->ws;
              epi::EpiResid E{layer == 0 ? INF(0) : (const float*)ka->out, ka->out, WSP(bf16_t, WS_XB), WSP(float, WS_SSQ) + (size_t)(2 * layer + 1) * 4 * M, (LAS float*)(lds + HALO_OFF)};
              run_gemm(lds, WSP(bf16_t, WS_QH), 256, WSP(bf16_t, WS_WHOUT) + (size_t)j * 1024 * 1024, 64, 4, 1024, G, bid, E); }
#endif
        } else {
#ifndef SKIP_M4
            { KArgs ka = KA(); unsigned char* ws = ka->ws;
              for (int pu = vcu; pu < 256; pu += G) {
                  const int bh = pu >> 4, s = pu & 15;
                  attn_unit(lds, WSP(bf16_t, WS_QF), WSP(bf16_t, WS_KF), WSP(bf16_t, WS_VT), WSP(bf16_t, WS_KN), bh >> 3, bh & 7, 31 - s);
                  attn_unit(lds, WSP(bf16_t, WS_QF), WSP(bf16_t, WS_KF), WSP(bf16_t, WS_VT), WSP(bf16_t, WS_KN), bh >> 3, bh & 7, s);
              } }
#endif
            GRID_SYNC();
            STOP(4, DBF(WSP(bf16_t, WS_KN), (size_t)M * 1024, false));
            DG(DB(WSP(bf16_t, WS_KN), (size_t)M * 1024, cb_ + 8));
#ifndef SKIP_M5
            { KArgs ka = KA(); unsigned char* ws = ka->ws;
              epi::EpiResid E{(const float*)ka->out, ka->out, WSP(bf16_t, WS_XB), WSP(float, WS_SSQ) + (size_t)(2 * layer + 1) * 4 * M, (LAS float*)(lds + HALO_OFF)};
              run_gemm(lds, WSP(bf16_t, WS_KN), 256, WSP(bf16_t, WS_WMOUT) + (size_t)j * 1024 * 1024, 64, 4, 1024, G, bid, E); }
#endif
        }
        GRID_SYNC();
        STOP(5, DBF(WSP(bf16_t, WS_XB), (size_t)M * 1024, true); DFF_(WSP(float, WS_SSQ) + (size_t)(2 * layer + 1) * 4 * M, (size_t)4 * M, true));
        DG(DF(ka->out, (size_t)M * 1024, cb_ + 9); DB(WSP(bf16_t, WS_XB), (size_t)M * 1024, cb_ + 9); DF(WSP(float, WS_SSQ) + (size_t)(2 * layer + 1) * 4 * M, (size_t)4 * M, cb_ + 9));
#ifndef SKIP_F1
        { KArgs ka = KA(); unsigned char* ws = ka->ws;
          epi::EpiFfnUp E{WSP(float, WS_SSQ) + (size_t)(2 * layer + 1) * 4 * M, INF(17) + (size_t)layer * 3 * DFF2, INF(18) + (size_t)layer * DFF2, WSP(bf16_t, WS_HF), (LAS float*)(lds + HALO_OFF)};
          run_gemm(lds, WSP(bf16_t, WS_XB) - 2 * 1024, 254, WSP(bf16_t, WS_WUP), 65, 22, 1024, G, bid, E); }
#endif
        GRID_SYNC();
        STOP(6, DBF(WSP(bf16_t, WS_HF), (size_t)M * DFF, false));
        DG(DB(WSP(bf16_t, WS_HF), (size_t)M * DFF, cb_ + 10));
#ifndef SKIP_F2
        { KArgs ka = KA(); unsigned char* ws = ka->ws;
          epi::EpiResid E{(const float*)ka->out, ka->out, (layer < 3) ? WSP(bf16_t, WS_XB) : nullptr, (layer < 3) ? WSP(float, WS_SSQ) + (size_t)(2 * layer + 2) * 4 * M : nullptr, (LAS float*)(lds + HALO_OFF)};
          run_gemm(lds, WSP(bf16_t, WS_HF), 256, WSP(bf16_t, WS_WDN), 64, 4, DFF, G, bid, E); }
#endif
        if (layer < 3) GRID_SYNC();
        STOP(7, (void)0);
    }
#ifdef DIAG_BISECT
    GRID_SYNC();
    DG(DF(ka->out, (size_t)M * 1024, 89));
    GRID_SYNC();
    { KArgs ka = KA(); float* o = ka->out; int tid = threadIdx.x; asm volatile("" : "+v"(tid)); const unsigned dv = *(volatile unsigned*)(ka->ws + 32768);
      for (int i = bid * NTHREADS + tid; i < M * DM; i += gthreads) o[i] = (i == 0) ? 100.f * (float)dv : 0.f; }
#endif
#ifdef DIAG_SANITIZE
    GRID_SYNC();
    { KArgs ka = KA(); float* o = ka->out; int tid = threadIdx.x; asm volatile("" : "+v"(tid));
      for (int i = bid * NTHREADS + tid; i < M * DM; i += gthreads) { const float v = o[i]; if (!(fabsf(v) < 1e30f)) o[i] = 1e30f; } }
#endif
}

extern "C" void kernel_launch(void* const* d_in, const int* in_sizes, int n_in, void* d_out, int out_size, void* d_ws, size_t ws_size, hipStream_t stream) {
    static int grid = 0;
    if (grid == 0) {
        if (n_in != 20 || out_size != M * DM || ws_size < WS_NEED) { fprintf(stderr, "kernel_launch: unexpected problem (n_in %d, out %d, ws %zu, need %zu)\n", n_in, out_size, ws_size, (size_t)WS_NEED); grid = -1; return; }
        int dev = 0, cus = 0, per_cu = 0;
        if (hipGetDevice(&dev) != hipSuccess || hipDeviceGetAttribute(&cus, hipDeviceAttributeMultiprocessorCount, dev) != hipSuccess) { grid = -1; return; }
        if (hipFuncSetAttribute((const void*)trunk_fwd, hipFuncAttributeMaxDynamicSharedMemorySize, LDS_BYTES) != hipSuccess) { fprintf(stderr, "kernel_launch: hipFuncSetAttribute failed\n"); grid = -1; return; }
        if (hipOccupancyMaxActiveBlocksPerMultiprocessor(&per_cu, (const void*)trunk_fwd, NTHREADS, LDS_BYTES) != hipSuccess || per_cu < 1) { fprintf(stderr, "kernel_launch: occupancy query failed (%d)\n", per_cu); (void)hipGetLastError(); per_cu = 1; }
        grid = cus * per_cu;
    }
    if (grid < 0) return;
    Args a{};
    for (int i = 0; i < 20; ++i) a.in[i] = d_in[i];
    a.out = (float*)d_out; a.ws = (unsigned char*)d_ws;
    void* kargs[] = {&a};
    hipError_t e = hipLaunchCooperativeKernel((const void*)trunk_fwd, dim3(grid), dim3(NTHREADS), kargs, LDS_BYTES, stream);
    if (e != hipSuccess) fprintf(stderr, "kernel_launch: cooperative launch failed: %s (grid %d)\n", hipGetErrorString(e), grid);
}
```

```cpp
#include <hip/hip_runtime.h>
#include <hip/hip_cooperative_groups.h>
#include <cstdio>
#include <cstdint>
namespace cg = cooperative_groups;
namespace pg8 {
#define PG8_LAS __attribute__((address_space(3)))
typedef unsigned short bf16_t;
typedef short bf16x8 __attribute__((ext_vector_type(8)));
typedef float f32x4 __attribute__((ext_vector_type(4)));
typedef unsigned u32x4 __attribute__((ext_vector_type(4)));
constexpr int BM = 256, BK = 64, HALF = 128, HTB = HALF * BK * 2  , STAGE_BYTES = 8 * HTB, NXCD = 8, WGM = 8;

__host__ __device__ __forceinline__ int lds_byte(int r, int c) { const int st = (r >> 4) * 2 + (c >> 5), rr = r & 15, cc = c & 31, ob = rr * 64 + cc * 2; return st * 1024 + (ob ^ (((ob >> 9) & 1) << 5)); }
__host__ __device__ __forceinline__ void stage_rc(int b, int& R, int& C) { const int st = b / 1024, sb = b % 1024, swz = sb ^ (((sb >> 9) & 1) << 5); R = (st >> 1) * 16 + swz / 64; C = (st & 1) * 32 + (swz % 64) / 2; }
__host__ __device__ __forceinline__ int perm32(int rho) { const int n = rho >> 4, i = rho & 15; return 8 * (i >> 2) + 4 * n + (i & 3); }

struct Unit { int pm, pn; };
struct Gemm { const bf16_t* A; const bf16_t* Bt; int M, N, K; int arows; };

struct StaticOrder {
    int nM, nN, nwg, G, c;
    __host__ __device__ void init(int M, int N, int G_, int c_) { nM = M / BM; nN = N / BM; nwg = nM * nN; G = G_; c = c_; }
    __host__ __device__ void init2(int nM_, int nN_, int G_, int c_) { nM = nM_; nN = nN_; nwg = nM * nN; G = G_; c = c_; }
    __host__ __device__ bool next(int i, Unit& u) const {
        const long L = (long)i * G + c; if (L >= nwg) return false;
        int wgid = (int)L; { const int q = nwg / NXCD, r = nwg % NXCD, xcd = wgid % NXCD, off = wgid / NXCD; wgid = (xcd < r ? xcd * (q + 1) : r * (q + 1) + (xcd - r) * q) + off; }
        const int nig = WGM * nN, gid = wgid / nig, fm = gid * WGM, gsz = (nM - fm) < WGM ? (nM - fm) : WGM;
        u.pm = fm + ((wgid % nig) % gsz); u.pn = (wgid % nig) / gsz; return true;
    }
    __device__ __forceinline__ void a_ready(const Unit&) const {}
    __device__ __forceinline__ void done(const Unit&) const {}
};

__device__ __forceinline__ unsigned cvt_pk_bf16(float lo, float hi) { unsigned r; asm volatile("v_cvt_pk_bf16_f32 %0, %1, %2" : "=v"(r) : "v"(lo), "v"(hi)); return r; }
typedef float f32x2 __attribute__((ext_vector_type(2)));
__device__ __forceinline__ f32x2 gelu_pk(f32x2 v) {
    const f32x2 av = __builtin_elementwise_abs(v), d = av * 0.2316418882f + 1.0f;
    f32x2 t; t.x = __builtin_amdgcn_rcpf(d.x); t.y = __builtin_amdgcn_rcpf(d.y);
    f32x2 q = t * 0.5307027145f + (-0.7265760135f); q = q * t + 0.7107068705f; q = q * t + (-0.142248368f); q = q * t + 0.127414796f; q = q * t;
    const f32x2 s = (v * v) * (-0.72134752044f);
    f32x2 e; e.x = __builtin_amdgcn_exp2f(s.x); e.y = __builtin_amdgcn_exp2f(s.y);
    const f32x2 m = v * (q * e), r = v - m;
    f32x2 o; o.x = v.x < 0.f ? m.x : r.x; o.y = v.y < 0.f ? m.y : r.y; return o;
}

template <int ACT  > struct EpiBf16 {
    static constexpr bool PERM = true, AFTER_DRAIN = false; static_assert(ACT == 0 || ACT == 1, "EpiBf16: ACT is 0 (none) or 1 (gelu_pk)");
    bf16_t* O; int ldc; const float* bias; int split_cols; size_t split_stride; float scale0;
    __device__ __forceinline__ void operator()(const f32x4 (&acc)[2][2][4][2], const Unit& u, int wr, int wc, int fr, int fq) const {
        const int row0 = u.pm * BM + wr * 64 + fr; int colt = u.pn * BM; bf16_t* base = O;
        float sc = 1.f; if (split_cols) { const int t = colt / split_cols; base += (size_t)t * split_stride; colt -= t * split_cols; if (t == 0) sc = scale0; }
        const int col0 = colt + wc * 32 + 8 * fq, bcol0 = u.pn * BM + wc * 32 + 8 * fq;
        f32x4 bv[2][2];
#pragma unroll
        for (int bj = 0; bj < 2; ++bj)
#pragma unroll
            for (int n = 0; n < 2; ++n) bv[bj][n] = bias ? *(const f32x4*)(bias + bcol0 + bj * HALF + 4 * n) : (f32x4){0.f, 0.f, 0.f, 0.f};
#pragma unroll
        for (int ai = 0; ai < 2; ++ai)
#pragma unroll
            for (int m = 0; m < 4; ++m) { bf16_t* rowp = base + (size_t)(row0 + ai * HALF + m * 16) * ldc + col0;
#pragma unroll
                for (int bj = 0; bj < 2; ++bj) { f32x4 v0 = acc[ai][bj][m][0] + bv[bj][0], v1 = acc[ai][bj][m][1] + bv[bj][1];
                    if (ACT == 1) { f32x2 a = gelu_pk((f32x2){v0[0], v0[1]}), b = gelu_pk((f32x2){v0[2], v0[3]}), c = gelu_pk((f32x2){v1[0], v1[1]}), d = gelu_pk((f32x2){v1[2], v1[3]});
                        v0 = (f32x4){a.x, a.y, b.x, b.y}; v1 = (f32x4){c.x, c.y, d.x, d.y}; }
                    v0 = v0 * sc; v1 = v1 * sc; u32x4 w; w.x = cvt_pk_bf16(v0[0], v0[1]); w.y = cvt_pk_bf16(v0[2], v0[3]); w.z = cvt_pk_bf16(v1[0], v1[1]); w.w = cvt_pk_bf16(v1[2], v1[3]);
                    *(u32x4*)(rowp + bj * HALF) = w; } }
    }
};

struct PanelStats {
    unsigned* xbuf;
    unsigned* cnt;
    unsigned* tmo;
    int ntn; float eps;
    unsigned code;
    __device__ __forceinline__ bool run(const f32x4 (&v)[2][2][4][2], const Unit& u, int wr, int wc, int fr, int fq, PG8_LAS unsigned char* lds, int wid, int lane) const {
        typedef float f32x2v __attribute__((ext_vector_type(2)));
        PG8_LAS f32x2v* P = (PG8_LAS f32x2v*)lds;
        PG8_LAS f32x2v* S = (PG8_LAS f32x2v*)(lds + 8192);
        PG8_LAS unsigned* flag = (PG8_LAS unsigned*)(lds + 8192 + 2048);
#pragma unroll
        for (int ai = 0; ai < 2; ++ai)
#pragma unroll
            for (int m = 0; m < 4; ++m) {
                float s = 0.f;
#pragma unroll
                for (int bj = 0; bj < 2; ++bj)
#pragma unroll
                    for (int n = 0; n < 2; ++n) { const f32x4 x = v[ai][bj][m][n]; s += (x[0] + x[1]) + (x[2] + x[3]); }
                s += __shfl_xor(s, 16); s += __shfl_xor(s, 32);
                const float mw = s * (1.0f / 64.0f); float q = 0.f;
#pragma unroll
                for (int bj = 0; bj < 2; ++bj)
#pragma unroll
                    for (int n = 0; n < 2; ++n) { const f32x4 d = v[ai][bj][m][n] - mw; q += (d[0] * d[0] + d[1] * d[1]) + (d[2] * d[2] + d[3] * d[3]); }
                q += __shfl_xor(q, 16); q += __shfl_xor(q, 32);
                if (fq == 0) P[(ai * HALF + wr * 64 + m * 16 + fr) * 4 + wc] = (f32x2v){mw, q};
            }
        asm volatile("s_waitcnt lgkmcnt(0)" ::: "memory"); __builtin_amdgcn_s_barrier(); asm volatile("" ::: "memory");
#if defined(BROKEN_EXCHANGE_NO_WAIT)
#warning BROKEN CONTROL BUILD: the row-statistics exchange does not wait; results are wrong by design
        if (blockIdx.x >= 64) { const long long t0_ = clock64(); while (clock64() - t0_ < 60000) __builtin_amdgcn_s_sleep(8); }
#endif
        const int row = wid * 32 + (lane & 31);
        if (lane < 32) {
            const f32x2v a = P[row * 4 + 0], b = P[row * 4 + 1], c = P[row * 4 + 2], d = P[row * 4 + 3];
            const float mt = (a.x + b.x + c.x + d.x) * 0.25f;
            const float da = a.x - mt, db = b.x - mt, dc = c.x - mt, dd = d.x - mt;
            const float m2 = (a.y + b.y) + (c.y + d.y) + 64.0f * ((da * da + db * db) + (dc * dc + dd * dd));
            unsigned long long* slot = (unsigned long long*)xbuf + ((size_t)(u.pm * BM + row) * 4 + u.pn);
            __hip_atomic_store(slot, ((unsigned long long)__float_as_uint(m2) << 32) | __float_as_uint(mt), __ATOMIC_RELAXED, __HIP_MEMORY_SCOPE_AGENT);
        }
        asm volatile("s_waitcnt vmcnt(0)" ::: "memory");
        if (lane == 0) __hip_atomic_fetch_add(cnt + 64 * u.pm, 1u, __ATOMIC_RELAXED, __HIP_MEMORY_SCOPE_AGENT);
        if (wid == 0) {
            bool dead = false; const unsigned long long t0 = __builtin_amdgcn_s_memrealtime(); const unsigned want = 8u * (unsigned)ntn;
            for (;;) {
#if defined(BROKEN_EXCHANGE_NO_WAIT)
                break;
#endif
                if ((unsigned)__builtin_amdgcn_readfirstlane(__hip_atomic_load(cnt + 64 * u.pm, __ATOMIC_RELAXED, __HIP_MEMORY_SCOPE_AGENT)) >= want) break;
                if (__builtin_amdgcn_s_memrealtime() - t0 > 2000000ull) {
                    if (lane == 0) { unsigned expect = 0u; __hip_atomic_compare_exchange_strong(tmo + 1, &expect, code | (unsigned)(u.pm & 0xff), __ATOMIC_RELAXED, __ATOMIC_RELAXED, __HIP_MEMORY_SCOPE_AGENT);
                                     __hip_atomic_store(tmo, 1u, __ATOMIC_RELAXED, __HIP_MEMORY_SCOPE_AGENT); }
                    dead = true; break; }
                __builtin_amdgcn_s_sleep(2);
            }
            __builtin_amdgcn_fence(__ATOMIC_ACQUIRE, "agent");
            if (lane == 0) flag[0] = dead ? 1u : 0u;
        }
        asm volatile("s_waitcnt vmcnt(0) lgkmcnt(0)" ::: "memory"); __builtin_amdgcn_s_barrier(); asm volatile("" ::: "memory");
        const bool bad = flag[0] != 0u;
        if (lane < 32) {
            const unsigned long long* slot = (const unsigned long long*)xbuf + (size_t)(u.pm * BM + row) * 4; float mt[4], m2[4]; float ms = 0.f;
#pragma unroll
            for (int t = 0; t < 4; ++t) { if (t < ntn) { const unsigned long long w = __hip_atomic_load(slot + t, __ATOMIC_RELAXED, __HIP_MEMORY_SCOPE_AGENT); mt[t] = __uint_as_float((unsigned)w); m2[t] = __uint_as_float((unsigned)(w >> 32)); } else { mt[t] = 0.f; m2[t] = 0.f; } ms += mt[t]; }
            const float mean = ms / (float)ntn; float q = 0.f;
#pragma unroll
            for (int t = 0; t < 4; ++t) if (t < ntn) { const float dm = mt[t] - mean; q += m2[t] + 256.0f * dm * dm; }
            S[row] = (f32x2v){mean, 1.0f / sqrtf(q / (256.0f * (float)ntn) + eps)};
        }
        asm volatile("s_waitcnt lgkmcnt(0)" ::: "memory"); __builtin_amdgcn_s_barrier(); asm volatile("" ::: "memory");
        return bad;
    }
};
struct EpiLnRes {
    static constexpr bool PERM = false, AFTER_DRAIN = true;
    const float* base; float* out; int ldc; const float* bias; PanelStats st; unsigned poison;
    __device__ __forceinline__ void fused(f32x4 (&acc)[2][2][4][2], const Unit& u, int wr, int wc, int fr, int fq, PG8_LAS unsigned char* lds, int wid, int lane) const {
        typedef float f32x2v __attribute__((ext_vector_type(2)));
        const PG8_LAS f32x2v* S = (const PG8_LAS f32x2v*)(lds + 8192);
        const int col0 = u.pn * BM + wc * 32 + 4 * fq;
#pragma unroll
        for (int bj = 0; bj < 2; ++bj)
#pragma unroll
            for (int n = 0; n < 2; ++n) { const f32x4 bv = bias ? *(const f32x4*)(bias + col0 + bj * HALF + n * 16) : (f32x4){0.f, 0.f, 0.f, 0.f};
#pragma unroll
                for (int ai = 0; ai < 2; ++ai)
#pragma unroll
                    for (int m = 0; m < 4; ++m) acc[ai][bj][m][n] += bv; }
        f32x4 pre[4][2][2];
#pragma unroll
        for (int m = 0; m < 4; ++m) { const size_t off = (size_t)(u.pm * BM + wr * 64 + m * 16 + fr) * ldc + col0;
#pragma unroll
            for (int bj = 0; bj < 2; ++bj)
#pragma unroll
                for (int n = 0; n < 2; ++n) pre[m][bj][n] = *(const f32x4*)(base + off + bj * HALF + n * 16); }
        const bool bad = st.run(acc, u, wr, wc, fr, fq, lds, wid, lane) || poison != 0u;
        const float qnan = __builtin_nanf("");
#pragma unroll
        for (int ai = 0; ai < 2; ++ai)
#pragma unroll
            for (int m = 0; m < 4; ++m) { const int r = ai * HALF + wr * 64 + m * 16 + fr; const f32x2v sr = S[r]; const size_t off = (size_t)(u.pm * BM + r) * ldc + col0;
#pragma unroll
                for (int bj = 0; bj < 2; ++bj)
#pragma unroll
                    for (int n = 0; n < 2; ++n) { const f32x4 bs = ai == 0 ? pre[m][bj][n] : *(const f32x4*)(base + off + bj * HALF + n * 16); f32x4 o = bs + (acc[ai][bj][m][n] - sr.x) * sr.y;
                        if (bad) o = (f32x4){qnan, qnan, qnan, qnan}; *(f32x4*)(out + off + bj * HALF + n * 16) = o; }
                if (m & 1) asm volatile("" ::: "memory"); }
    }
};
struct EpiLnResLn {
    static constexpr bool PERM = false, AFTER_DRAIN = true;
    const float* base; float* out; bf16_t* xn; int ldc; const float* bias; PanelStats st1, st2; unsigned poison;
    __device__ __forceinline__ void fused(f32x4 (&acc)[2][2][4][2], const Unit& u, int wr, int wc, int fr, int fq, PG8_LAS unsigned char* lds, int wid, int lane) const {
        typedef float f32x2v __attribute__((ext_vector_type(2))); typedef unsigned u32x2v __attribute__((ext_vector_type(2)));
        const PG8_LAS f32x2v* S = (const PG8_LAS f32x2v*)(lds + 8192);
        const int col0 = u.pn * BM + wc * 32 + 4 * fq;
#pragma unroll
        for (int bj = 0; bj < 2; ++bj)
#pragma unroll
            for (int n = 0; n < 2; ++n) { const f32x4 bv = bias ? *(const f32x4*)(bias + col0 + bj * HALF + n * 16) : (f32x4){0.f, 0.f, 0.f, 0.f};
#pragma unroll
                for (int ai = 0; ai < 2; ++ai)
#pragma unroll
                    for (int m = 0; m < 4; ++m) acc[ai][bj][m][n] += bv; }
        bool bad = st1.run(acc, u, wr, wc, fr, fq, lds, wid, lane) || poison != 0u;
        const float qnan = __builtin_nanf("");
#pragma unroll
        for (int ai = 0; ai < 2; ++ai)
#pragma unroll
            for (int m = 0; m < 4; ++m) { const int r = ai * HALF + wr * 64 + m * 16 + fr; const f32x2v sr = S[r]; const size_t off = (size_t)(u.pm * BM + r) * ldc + col0;
#pragma unroll
                for (int bj = 0; bj < 2; ++bj)
#pragma unroll
                    for (int n = 0; n < 2; ++n) { const f32x4 bs = *(const f32x4*)(base + off + bj * HALF + n * 16); acc[ai][bj][m][n] = bs + (acc[ai][bj][m][n] - sr.x) * sr.y; }
                asm volatile("" : "+v"(acc[ai][0][m][0]), "+v"(acc[ai][0][m][1]), "+v"(acc[ai][1][m][0]), "+v"(acc[ai][1][m][1]));
                if (m & 1) asm volatile("" ::: "memory"); }
        const bool bad1 = bad;
        bad = st2.run(acc, u, wr, wc, fr, fq, lds, wid, lane) || bad;
#pragma unroll
        for (int ai = 0; ai < 2; ++ai)
#pragma unroll
            for (int m = 0; m < 4; ++m) { const int r = ai * HALF + wr * 64 + m * 16 + fr; const f32x2v sr = S[r]; const size_t off = (size_t)(u.pm * BM + r) * ldc + col0;
#pragma unroll
                for (int bj = 0; bj < 2; ++bj)
#pragma unroll
                    for (int n = 0; n < 2; ++n) { const f32x4 x1 = acc[ai][bj][m][n]; *(f32x4*)(out + off + bj * HALF + n * 16) = bad1 ? (f32x4){qnan, qnan, qnan, qnan} : x1;
                        const f32x4 o = (x1 - sr.x) * sr.y; u32x2v w; w.x = cvt_pk_bf16(o[0], o[1]); w.y = cvt_pk_bf16(o[2], o[3]);
                        if (bad) { w.x = 0x7fc07fc0u; w.y = 0x7fc07fc0u; } *(u32x2v*)(xn + off + bj * HALF + n * 16) = w; }
                asm volatile("" ::: "memory"); }
    }
};

template <class Epi, class Sched, bool ALIGN_EPI = false, bool SP2 = false>
__device__ __forceinline__ void gemm_phase(PG8_LAS unsigned char* lds, const Gemm g, const Sched& S, const Epi& E) {
    int tid = threadIdx.x; asm volatile("" : "+v"(tid));
    const int wid = __builtin_amdgcn_readfirstlane(tid >> 6), lane = tid & 63, wr = wid >> 2, wc = wid & 3, fr = lane & 15, fq = lane >> 4;
    const int K = g.K, nt = K / BK;
    unsigned voffA[2], voffB[2];
#pragma unroll
    for (int i = 0; i < 2; ++i) { int R, C; stage_rc(tid * 16 + i * 8192, R, C); const int Rb = Epi::PERM ? ((R & ~31) + perm32(R & 31)) : R;
        voffA[i] = (unsigned)(R * K + C) * 2u; voffB[i] = (unsigned)(Rb * K + C) * 2u; }
    const size_t kstep = (size_t)(BK * 2);
    const size_t hstep = (size_t)HALF * K * 2;
    const size_t tstep = 2 * hstep;
    const size_t tstepA = (size_t)g.arows * K * 2;
    const unsigned lds_u32 = (unsigned)(__UINTPTR_TYPE__)lds;
    const unsigned ldsw = (unsigned)wid * 1024u;
    const int aoff = lds_byte(wr * 64 + fr, fq * 8), boff = lds_byte(wc * 32 + fr, fq * 8);
#define PG8_SA(b, h) (((b) * 2 + (h)) * HTB)
#define PG8_SB(b, h) ((4 + (b) * 2 + (h)) * HTB)
#define PG8_STAGE(bufoff, gbase, voff) do { _Pragma("unroll") for (int _i = 0; _i < 2; ++_i) { \
        const unsigned _m0 = lds_u32 + (unsigned)(bufoff) + ldsw + (unsigned)_i * 8192u; const char* _gb = (const char*)(gbase); \
        unsigned _keep; asm volatile("s_mov_b32 %0, m0\n\ts_mov_b32 m0, %1\n\ts_nop 0\n\tglobal_load_lds_dwordx4 %2, %3\n\ts_mov_b32 m0, %0" : "=&s"(_keep) : "s"(_m0), "v"((voff)[_i]), "s"(_gb) : "memory"); } } while (0)
#define PG8_LDA(dst, b, h) do { _Pragma("unroll") for (int m = 0; m < 4; ++m) _Pragma("unroll") for (int k = 0; k < 2; ++k) dst[m][k] = *(const PG8_LAS bf16x8*)(lds + PG8_SA(b, h) + aoff + m * 2048 + k * 1024); } while (0)
#define PG8_LDB(dst, b, h) do { _Pragma("unroll") for (int n = 0; n < 2; ++n) _Pragma("unroll") for (int k = 0; k < 2; ++k) dst[n][k] = *(const PG8_LAS bf16x8*)(lds + PG8_SB(b, h) + boff + n * 2048 + k * 1024); } while (0)
#define PG8_MMA(ai, bj, At, Bt) do { __builtin_amdgcn_s_setprio(1); _Pragma("unroll") for (int m = 0; m < 4; ++m) _Pragma("unroll") for (int n = 0; n < 2; ++n) _Pragma("unroll") for (int k = 0; k < 2; ++k) \
        acc[ai][bj][m][n] = __builtin_amdgcn_mfma_f32_16x16x32_bf16(Bt[n][k], At[m][k], acc[ai][bj][m][n], 0, 0, 0); __builtin_amdgcn_s_setprio(0); } while (0)
#define PG8_WAIT_V(n) asm volatile("s_waitcnt vmcnt(" #n ")" ::: "memory")
#define PG8_WAIT_L(n) asm volatile("s_waitcnt lgkmcnt(" #n ")" ::: "memory")
#define PG8_BAR __builtin_amdgcn_s_barrier()
#define PG8_SCHED __builtin_amdgcn_sched_barrier(0)
    Unit cur, nxt; int ui = 0;
    if (!S.next(0, cur)) return;
    f32x4 acc[2][2][4][2];
#pragma unroll
    for (int a = 0; a < 2; ++a)
#pragma unroll
        for (int b = 0; b < 2; ++b)
#pragma unroll
            for (int m = 0; m < 4; ++m)
#pragma unroll
                for (int n = 0; n < 2; ++n) acc[a][b][m][n] = (f32x4){0.f, 0.f, 0.f, 0.f};
    bf16x8 At[4][2], B0[2][2], B1[2][2];
    const char* cA = (const char*)g.A + (size_t)cur.pm * tstepA; const char* cB = (const char*)g.Bt + (size_t)cur.pn * tstep;
    S.a_ready(cur);
    if constexpr (SP2) {
        PG8_STAGE(PG8_SB(0, 0), cB, voffB); PG8_STAGE(PG8_SB(0, 1), cB + hstep, voffB); PG8_STAGE(PG8_SA(0, 0), cA, voffA); PG8_STAGE(PG8_SA(0, 1), cA + hstep, voffA);
        if (wr == 1) PG8_BAR;
        PG8_WAIT_V(2); PG8_BAR;
        PG8_STAGE(PG8_SB(1, 0), cB + kstep, voffB); PG8_STAGE(PG8_SA(1, 0), cA + kstep, voffA); PG8_STAGE(PG8_SB(1, 1), cB + hstep + kstep, voffB);
        PG8_WAIT_V(6); PG8_BAR;
    } else {
        PG8_STAGE(PG8_SB(0, 0), cB, voffB); PG8_STAGE(PG8_SA(0, 0), cA, voffA); PG8_STAGE(PG8_SB(0, 1), cB + hstep, voffB); PG8_STAGE(PG8_SA(0, 1), cA + hstep, voffA);
        if (wr == 1) PG8_BAR;
        PG8_WAIT_V(4); PG8_BAR;
        PG8_STAGE(PG8_SB(1, 0), cB + kstep, voffB); PG8_STAGE(PG8_SA(1, 0), cA + kstep, voffA); PG8_STAGE(PG8_SB(1, 1), cB + hstep + kstep, voffB);
        PG8_WAIT_V(6); PG8_BAR;
    }
    for (;;) {
        const bool has_next = S.next(ui + 1, nxt);
        const char* nA = has_next ? (const char*)g.A + (size_t)nxt.pm * tstepA : cA; const char* nB = has_next ? (const char*)g.Bt + (size_t)nxt.pn * tstep : cB;
        _Pragma("nounroll") for (int t = 0; t < nt; t += 2) {
            const bool last = (t == nt - 2);
            const char* a1 = cA + (size_t)(t + 1) * kstep;
            const char* a2 = last ? nA : cA + (size_t)(t + 2) * kstep; const char* b2 = last ? nB : cB + (size_t)(t + 2) * kstep;
            const char* a3 = a2 + kstep; const char* b3 = b2 + kstep;
            if (last && has_next) S.a_ready(nxt);
            if constexpr (SP2) {
            PG8_LDB(B0, 0, 0); PG8_LDB(B1, 0, 1); PG8_SCHED; PG8_LDA(At, 0, 0); PG8_STAGE(PG8_SA(1, 1), a1 + hstep, voffA);
            PG8_WAIT_V(8); PG8_WAIT_L(0); PG8_BAR; PG8_MMA(0, 0, At, B0); PG8_MMA(0, 1, At, B1); PG8_BAR; PG8_SCHED;
            PG8_LDA(At, 0, 1); PG8_STAGE(PG8_SB(0, 0), b2, voffB); PG8_STAGE(PG8_SB(0, 1), b2 + hstep, voffB); PG8_STAGE(PG8_SA(0, 0), a2, voffA);
            PG8_WAIT_V(8); PG8_WAIT_L(0); PG8_BAR; PG8_MMA(1, 0, At, B0); PG8_MMA(1, 1, At, B1); PG8_BAR; PG8_SCHED;
            PG8_LDB(B0, 1, 0); PG8_LDB(B1, 1, 1); PG8_SCHED; PG8_LDA(At, 1, 0); PG8_STAGE(PG8_SA(0, 1), a2 + hstep, voffA);
            PG8_WAIT_V(8); PG8_WAIT_L(0); PG8_BAR; PG8_MMA(0, 0, At, B0); PG8_MMA(0, 1, At, B1); PG8_BAR; PG8_SCHED;
            PG8_LDA(At, 1, 1); PG8_STAGE(PG8_SB(1, 0), b3, voffB); PG8_STAGE(PG8_SB(1, 1), b3 + hstep, voffB); PG8_STAGE(PG8_SA(1, 0), a3, voffA);
            PG8_WAIT_V(8); PG8_WAIT_L(0); PG8_BAR; PG8_MMA(1, 0, At, B0); PG8_MMA(1, 1, At, B1); PG8_BAR; PG8_SCHED;
            } else {
            PG8_LDB(B0, 0, 0); PG8_SCHED; PG8_LDA(At, 0, 0); PG8_STAGE(PG8_SA(1, 1), a1 + hstep, voffA);
            PG8_WAIT_L(8); PG8_BAR; PG8_WAIT_L(0); PG8_MMA(0, 0, At, B0); PG8_BAR; PG8_SCHED;
            PG8_LDB(B1, 0, 1); PG8_STAGE(PG8_SB(0, 0), b2, voffB);
            PG8_BAR; PG8_WAIT_L(0); PG8_MMA(0, 1, At, B1); PG8_BAR;
            PG8_LDA(At, 0, 1); PG8_STAGE(PG8_SA(0, 0), a2, voffA);
            PG8_BAR; PG8_WAIT_L(0); PG8_MMA(1, 0, At, B0); PG8_BAR; PG8_SCHED;
            PG8_STAGE(PG8_SB(0, 1), b2 + hstep, voffB);
            PG8_WAIT_V(6); PG8_BAR; PG8_MMA(1, 1, At, B1); PG8_BAR;
            PG8_LDB(B0, 1, 0); PG8_SCHED; PG8_LDA(At, 1, 0); PG8_STAGE(PG8_SA(0, 1), a2 + hstep, voffA);
            PG8_WAIT_L(8); PG8_BAR; PG8_WAIT_L(0); PG8_MMA(0, 0, At, B0); PG8_BAR; PG8_SCHED;
            PG8_LDB(B1, 1, 1); PG8_STAGE(PG8_SB(1, 0), b3, voffB);
            PG8_BAR; PG8_WAIT_L(0); PG8_MMA(0, 1, At, B1); PG8_BAR;
            PG8_LDA(At, 1, 1); PG8_STAGE(PG8_SA(1, 0), a3, voffA);
            PG8_BAR; PG8_WAIT_L(0); PG8_MMA(1, 0, At, B0); PG8_BAR; PG8_SCHED;
            PG8_STAGE(PG8_SB(1, 1), b3 + hstep, voffB);
            PG8_WAIT_V(6); PG8_BAR; PG8_MMA(1, 1, At, B1); PG8_BAR;
            }
        }
        if constexpr (ALIGN_EPI) { if (wr == 0) PG8_BAR; }
        if constexpr (!Epi::AFTER_DRAIN) { E(acc, cur, wr, wc, fr, fq); S.done(cur); }
        if (!has_next) break;
#pragma unroll
        for (int a = 0; a < 2; ++a)
#pragma unroll
            for (int b = 0; b < 2; ++b)
#pragma unroll
                for (int m = 0; m < 4; ++m)
#pragma unroll
                    for (int n = 0; n < 2; ++n) acc[a][b][m][n] = (f32x4){0.f, 0.f, 0.f, 0.f};
        cur = nxt; cA = nA; cB = nB; ++ui;
        if constexpr (ALIGN_EPI) { if (wr == 1) PG8_BAR; }
    }
    PG8_WAIT_V(0);
    if constexpr (!ALIGN_EPI) { if (wr == 0) PG8_BAR; }
    PG8_BAR;
    if constexpr (Epi::AFTER_DRAIN) { E.fused(acc, cur, wr, wc, fr, fq, lds, wid, lane); S.done(cur); }
#undef PG8_SA
#undef PG8_SB
#undef PG8_STAGE
#undef PG8_LDA
#undef PG8_LDB
#undef PG8_MMA
#undef PG8_WAIT_V
#undef PG8_WAIT_L
#undef PG8_BAR
#undef PG8_SCHED
}
}

#define LAS __attribute__((address_space(3)))
using pg8::bf16_t; using pg8::f32x4; using pg8::u32x4; using pg8::bf16x8; using pg8::Unit;
typedef float f32x16 __attribute__((ext_vector_type(16)));
typedef unsigned u32x2 __attribute__((ext_vector_type(2)));

constexpr int M = 16384, SEQ = 8192, DM = 1024, DFF = 2816, DFF2 = 5632;
constexpr float EPS = 1e-6f;
constexpr int NTHREADS = 512, NWAVES = 8;
constexpr int LDS_BYTES = 147456;
constexpr int HALO_OFF = 131072;
constexpr int XMISC_OFF = 131072 + 12288;
constexpr float QSCALE = 0.07216878364870323f * 1.4426950408889634f;

constexpr size_t MiB = 1u << 20;
constexpr size_t WS_LBT = 0;
constexpr size_t WS_INVF = 16384;
constexpr size_t WS_BAR = 32768, WS_BAR_BYTES = 16384;
constexpr size_t WS_WHIN = 2 * MiB;
constexpr size_t WS_WHOUT = 18 * MiB;
constexpr size_t WS_WMIN = 22 * MiB;
constexpr size_t WS_WQ = 25 * MiB;
constexpr size_t WS_WKN = 27 * MiB;
constexpr size_t WS_WV = 28 * MiB;
constexpr size_t WS_WMOUT = 29 * MiB;
constexpr size_t WS_WUP = 33 * MiB;
constexpr size_t WS_WDN = 44 * MiB;
constexpr size_t WS_XB = 50 * MiB + 65536;
constexpr size_t WS_R = 83 * MiB;
constexpr size_t WS_QH = WS_R, WS_VH = WS_R + 32 * MiB, WS_GH = WS_R + 64 * MiB, WS_LF = WS_R + 96 * MiB, WS_ST = WS_R + 160 * MiB, WS_DL = WS_R + 224 * MiB;
constexpr size_t WS_CQ = WS_R, WS_CKV = WS_R + 8 * MiB, WS_KR = WS_R + 16 * MiB, WS_QF = WS_R + 20 * MiB, WS_KN = WS_R + 68 * MiB, WS_VT = WS_R + 100 * MiB, WS_KF = WS_R + 132 * MiB;
constexpr size_t WS_HF = WS_R;
constexpr size_t WS_SSQ = WS_R + 226 * MiB;
constexpr size_t WS_SSQCQ = WS_SSQ + 9 * 16 * (size_t)M * 4;
constexpr size_t WS_SSQCKV = WS_SSQCQ + 2 * 4 * (size_t)M * 4;
constexpr size_t WS_SSQKR = WS_SSQCKV + 2 * (size_t)M * 4;
constexpr size_t WS_NEED = WS_R + 238 * MiB;
static_assert(WS_SSQCKV + 2 * 4 * (size_t)M * 4 <= WS_NEED && WS_SSQCKV == WS_SSQCQ + 8 * (size_t)M * 4 && WS_SSQKR == WS_SSQCQ + 10 * (size_t)M * 4, "ws map");

struct Args { const void* in[20]; float* out; unsigned char* ws; };

__device__ __forceinline__ float bf2f(unsigned v) { return __uint_as_float(v << 16); }
__device__ __forceinline__ float bflo(unsigned w) { return __uint_as_float(w << 16); }
__device__ __forceinline__ float bfhi(unsigned w) { return __uint_as_float(w & 0xffff0000u); }
typedef float f32x2_t __attribute__((ext_vector_type(2))); typedef __bf16 bf16x2_t __attribute__((ext_vector_type(2)));
__device__ __forceinline__ unsigned pk2c(float lo, float hi) { f32x2_t v = {lo, hi}; bf16x2_t b = __builtin_convertvector(v, bf16x2_t); return __builtin_bit_cast(unsigned, b); }
__device__ __forceinline__ unsigned pk2(float lo, float hi) { return pk2c(lo, hi); }
__device__ __forceinline__ u32x4 pack8(const f32x4& a, const f32x4& b) { u32x4 w; w.x = pk2(a[0], a[1]); w.y = pk2(a[2], a[3]); w.z = pk2(b[0], b[1]); w.w = pk2(b[2], b[3]); return w; }
__device__ __forceinline__ float sigm_f(float x) { return __builtin_amdgcn_rcpf(1.f + __expf(-x)); }
__device__ __forceinline__ float silu_f(float x) { return x * sigm_f(x); }
__device__ __forceinline__ float wave_sum(float v) {
#pragma unroll
    for (int o = 1; o < 64; o <<= 1) v += __shfl_xor(v, o);
    return v;
}
#define LDS_WAIT() asm volatile("s_waitcnt lgkmcnt(0)" ::: "memory")
template <int NS> __device__ __forceinline__ float ssq_sum(const float* p, int r) {
    float s = 0.f;
#pragma unroll
    for (int k = 0; k < NS; ++k) s += p[(size_t)k * M + r];
    return s;
}

__device__ __forceinline__ void rope_cs(float ang, float& c, float& s) {
    const float n = rintf(ang * 0.15915494309189535f);
    float r = fmaf(-n, 6.2831855f, ang); r = fmaf(-n, -1.7484555e-7f, r);
    c = __cosf(r); s = __sinf(r);
}
namespace epi {
using namespace pg8;

__device__ __forceinline__ void wg_row_ssq(LAS float* part, const float (&ss)[2][4], int wr, int wc, int fr, int fq, float* dst, int rowbase) {
    if (fq == 0) {
#pragma unroll
        for (int ai = 0; ai < 2; ++ai)
#pragma unroll
            for (int m = 0; m < 4; ++m) part[(ai * 128 + wr * 64 + m * 16 + fr) * 4 + wc] = ss[ai][m];
    }
    asm volatile("s_waitcnt lgkmcnt(0)" ::: "memory"); __builtin_amdgcn_s_barrier(); asm volatile("" ::: "memory");
    if (wc == 0 && fq == 0) {
#pragma unroll
        for (int ai = 0; ai < 2; ++ai)
#pragma unroll
            for (int m = 0; m < 4; ++m) { const int row = ai * 128 + wr * 64 + m * 16 + fr; const f32x4 v = *(const LAS f32x4*)(part + row * 4); dst[rowbase + row] = (v[0] + v[1]) + (v[2] + v[3]); }
    }
}

struct EpiResid {
    static constexpr bool PERM = true, AFTER_DRAIN = false;
    const float* xin; float* xout; bf16_t* xb; float* ssq; LAS float* part;
    __device__ __forceinline__ void operator()(f32x4 (&acc)[2][2][4][2], const Unit& u, int wr, int wc, int fr, int fq) const {
        int row0 = u.pm * 256 + wr * 64 + fr, col0 = u.pn * 256 + wc * 32 + 8 * fq;
        asm volatile("" : "+v"(row0), "+v"(col0));
        float ssv[2][4];
#pragma unroll
        for (int ai = 0; ai < 2; ++ai)
#pragma unroll
            for (int m = 0; m < 4; ++m) {
                const int r = row0 + ai * 128 + m * 16; float ss = 0.f;
#pragma unroll
                for (int bj = 0; bj < 2; ++bj) {
                    const size_t off = (size_t)r * 1024 + col0 + bj * 128;
                    f32x4 a = *(const f32x4*)(xin + off), b = *(const f32x4*)(xin + off + 4);
                    a += acc[ai][bj][m][0]; b += acc[ai][bj][m][1];
                    *(f32x4*)(xout + off) = a; *(f32x4*)(xout + off + 4) = b;
                    ss += ((a[0] * a[0] + a[1] * a[1]) + (a[2] * a[2] + a[3] * a[3])) + ((b[0] * b[0] + b[1] * b[1]) + (b[2] * b[2] + b[3] * b[3]));
                    if (xb) *(u32x4*)(xb + off) = pack8(a, b);
                }
                ss += __shfl_xor(ss, 16); ss += __shfl_xor(ss, 32); ssv[ai][m] = ss;
                if (m & 1) asm volatile("" ::: "memory");
            }
        if (ssq) wg_row_ssq(part, ssv, wr, wc, fr, fq, ssq + (size_t)u.pn * M, u.pm * 256);
    }
};

struct EpiHgrnIn {
    static constexpr bool PERM = true, AFTER_DRAIN = false;
    const float* ssq; const float* lb; bf16_t* Q; bf16_t* V; bf16_t* G; float* LF;
    __device__ __forceinline__ void operator()(f32x4 (&acc)[2][2][4][2], const Unit& u, int wr, int wc, int fr, int fq) const {
        const int sec = u.pn >> 2;
        int row0 = u.pm * 256 + wr * 64 + fr, c0 = (u.pn & 3) * 256 + wc * 32 + 8 * fq;
        asm volatile("" : "+v"(row0), "+v"(c0));
        f32x4 l0[2], l1[2];
#pragma unroll
        for (int bj = 0; bj < 2; ++bj) { l0[bj] = *(const f32x4*)(lb + c0 + bj * 128); l1[bj] = *(const f32x4*)(lb + c0 + bj * 128 + 4); }
#pragma unroll
        for (int ai = 0; ai < 2; ++ai)
#pragma unroll
            for (int m = 0; m < 4; ++m) {
                const int r = row0 + ai * 128 + m * 16; const float rs = rsqrtf(ssq_sum<4>(ssq, r) * (1.f / 1024.f) + EPS);
#pragma unroll
                for (int bj = 0; bj < 2; ++bj) {
                    const size_t off = (size_t)r * 1024 + c0 + bj * 128;
                    f32x4 a = acc[ai][bj][m][0] * rs, b = acc[ai][bj][m][1] * rs;
                    if (sec == 1) {
#pragma unroll
                        for (int j = 0; j < 4; ++j) {
                            const float sa = sigm_f(a[j]), sb = sigm_f(b[j]);
                            a[j] = __logf(l0[bj][j] + (1.f - l0[bj][j]) * sa); b[j] = __logf(l1[bj][j] + (1.f - l1[bj][j]) * sb);
                        }
                        *(f32x4*)(LF + off) = a; *(f32x4*)(LF + off + 4) = b;
                    } else if (sec == 2) {
                        *(u32x4*)(V + off) = pack8(a, b);
                    } else {
#pragma unroll
                        for (int j = 0; j < 4; ++j) { a[j] = silu_f(a[j]); b[j] = silu_f(b[j]); }
                        *(u32x4*)((sec == 0 ? Q : G) + off) = pack8(a, b);
                    }
                }
            }
    }
};

struct EpiMlaIn {
    static constexpr bool PERM = true, AFTER_DRAIN = false;
    const float* ssq; bf16_t* CQ; bf16_t* CKV; float* KR; float* ssq_cq; float* ssq_ckv; float* ssq_kr; LAS float* part;
    __device__ __forceinline__ void operator()(f32x4 (&acc)[2][2][4][2], const Unit& u, int wr, int wc, int fr, int fq) const {
        int row0 = u.pm * 256 + wr * 64 + fr, cl = wc * 32 + 8 * fq;
        asm volatile("" : "+v"(row0), "+v"(cl));
        float ssv[2][4];
#pragma unroll
        for (int ai = 0; ai < 2; ++ai)
#pragma unroll
            for (int m = 0; m < 4; ++m) {
                const int r = row0 + ai * 128 + m * 16; const float rs = rsqrtf(ssq_sum<4>(ssq, r) * (1.f / 1024.f) + EPS);
                ssv[ai][m] = 0.f;
                if (u.pn < 2) {
                    bf16_t* dst = u.pn == 0 ? CQ : CKV; float ss = 0.f;
#pragma unroll
                    for (int bj = 0; bj < 2; ++bj) {
                        const f32x4 a = acc[ai][bj][m][0] * rs, b = acc[ai][bj][m][1] * rs;
                        ss += ((a[0] * a[0] + a[1] * a[1]) + (a[2] * a[2] + a[3] * a[3])) + ((b[0] * b[0] + b[1] * b[1]) + (b[2] * b[2] + b[3] * b[3]));
                        *(u32x4*)(dst + (size_t)r * 256 + cl + bj * 128) = pack8(a, b);
                    }
                    ss += __shfl_xor(ss, 16); ss += __shfl_xor(ss, 32); ssv[ai][m] = ss;
                } else if (cl < 64) {
                    const f32x4 a = acc[ai][0][m][0] * rs, b = acc[ai][0][m][1] * rs;
                    *(f32x4*)(KR + (size_t)r * 64 + cl) = a; *(f32x4*)(KR + (size_t)r * 64 + cl + 4) = b;
                    float ss = ((a[0] * a[0] + a[1] * a[1]) + (a[2] * a[2] + a[3] * a[3])) + ((b[0] * b[0] + b[1] * b[1]) + (b[2] * b[2] + b[3] * b[3]));
                    ss += __shfl_xor(ss, 16); ss += __shfl_xor(ss, 32); ssv[ai][m] = ss;
                }
            }
        wg_row_ssq(part, ssv, wr, wc, fr, fq, ssq_cq + (u.pn == 0 ? 0 : (u.pn == 1 ? 8 * M : 10 * M)), u.pm * 256);
    }
};

struct EpiKFinal {
    static constexpr bool PERM = true, AFTER_DRAIN = false;
    const float* ssq_ckv; const float* ssq_kr; const float* KR; const int* pos; const float* invf; const float* kg; bf16_t* KF; LAS float* part;
    __device__ __forceinline__ void operator()(f32x4 (&acc)[2][2][4][2], const Unit& u, int wr, int wc, int fr, int fq) const {
        int row0 = u.pm * 256 + wr * 64 + fr, cl = wc * 32 + 8 * fq;
        asm volatile("" : "+v"(row0), "+v"(cl));
#pragma unroll
        for (int ai = 0; ai < 2; ++ai)
#pragma unroll
            for (int m = 0; m < 4; ++m) {
                const int r = row0 + ai * 128 + m * 16; const float rs = rsqrtf(ssq_ckv[r] * (1.f / 256.f) + EPS);
#pragma unroll
                for (int bj = 0; bj < 2; ++bj) {
                    acc[ai][bj][m][0] *= rs; acc[ai][bj][m][1] *= rs;
                    const f32x4 a = acc[ai][bj][m][0], b = acc[ai][bj][m][1];
                    float ss = ((a[0] * a[0] + a[1] * a[1]) + (a[2] * a[2] + a[3] * a[3])) + ((b[0] * b[0] + b[1] * b[1]) + (b[2] * b[2] + b[3] * b[3]));
                    ss += __shfl_xor(ss, 16); ss += __shfl_xor(ss, 32);
                    if (fq == 0) part[((ai * 128 + wr * 64 + m * 16 + fr) * 2 + bj) * 4 + wc] = ss;
                }
            }
        asm volatile("s_waitcnt lgkmcnt(0)" ::: "memory"); __builtin_amdgcn_s_barrier(); asm volatile("" ::: "memory");
        const int i0 = 2 * (4 * wc + fq);
        const f32x4 g0 = *(const f32x4*)(kg + cl), g1 = *(const f32x4*)(kg + cl + 4);
        const float ga0 = kg[128 + i0], ga1 = kg[129 + i0], gb0 = kg[160 + i0], gb1 = kg[161 + i0], f0 = invf[i0], f1 = invf[i0 + 1];
#pragma unroll
        for (int ai = 0; ai < 2; ++ai)
#pragma unroll
            for (int m = 0; m < 4; ++m) {
                const int rl = ai * 128 + wr * 64 + m * 16 + fr, r = u.pm * 256 + rl;
                const float skr = ssq_kr[r]; const float pf = (float)pos[r];
                const f32x2_t x1 = *(const f32x2_t*)(KR + (size_t)r * 64 + i0), x2 = *(const f32x2_t*)(KR + (size_t)r * 64 + 32 + i0);
                float c0, s0, c1, s1; rope_cs(pf * f0, c0, s0); rope_cs(pf * f1, c1, s1);
#pragma unroll
                for (int bj = 0; bj < 2; ++bj) {
                    const f32x4 v = *(const LAS f32x4*)(part + (rl * 2 + bj) * 4);
                    const float rstd = rsqrtf((((v[0] + v[1]) + (v[2] + v[3])) + skr) * (1.f / 192.f) + EPS);
                    bf16_t* kp = KF + (size_t)r * 1536 + (2 * u.pn + bj) * 192;
                    const f32x4 a = acc[ai][bj][m][0] * rstd * g0, b = acc[ai][bj][m][1] * rstd * g1;
                    *(u32x4*)(kp + cl) = pack8(a, b);
                    const float y10 = x1.x * rstd * ga0, y11 = x1.y * rstd * ga1, y20 = x2.x * rstd * gb0, y21 = x2.y * rstd * gb1;
                    *(unsigned*)(kp + 128 + i0) = pk2(y10 * c0 - y20 * s0, y11 * c1 - y21 * s1);
                    *(unsigned*)(kp + 160 + i0) = pk2(y20 * c0 + y10 * s0, y21 * c1 + y11 * s1);
                }
            }
    }
};

template <bool ROW> struct EpiScale {
    static constexpr bool PERM = true, AFTER_DRAIN = false;
    const float* ssq; float inv_n; bf16_t* O; int ldc;
    __device__ __forceinline__ void operator()(f32x4 (&acc)[2][2][4][2], const Unit& u, int wr, int wc, int fr, int fq) const {
        int row0 = u.pm * 256 + wr * 64 + fr, col0 = u.pn * 256 + wc * 32 + 8 * fq;
        asm volatile("" : "+v"(row0), "+v"(col0));
        f32x4 c0[2], c1[2];
#pragma unroll
        for (int bj = 0; bj < 2; ++bj) {
            if (!ROW) {
                const f32x4 s0 = *(const f32x4*)(ssq + col0 + bj * 128), s1 = *(const f32x4*)(ssq + col0 + bj * 128 + 4);
#pragma unroll
                for (int j = 0; j < 4; ++j) { c0[bj][j] = rsqrtf(s0[j] * inv_n + EPS); c1[bj][j] = rsqrtf(s1[j] * inv_n + EPS); }
            } else { c0[bj] = (f32x4){1.f, 1.f, 1.f, 1.f}; c1[bj] = c0[bj]; }
        }
#pragma unroll
        for (int ai = 0; ai < 2; ++ai)
#pragma unroll
            for (int m = 0; m < 4; ++m) {
                const int r = row0 + ai * 128 + m * 16; const float rs = ROW ? rsqrtf(ssq[r] * inv_n + EPS) : 1.f;
#pragma unroll
                for (int bj = 0; bj < 2; ++bj) {
                    const f32x4 a = acc[ai][bj][m][0] * rs * c0[bj], b = acc[ai][bj][m][1] * rs * c1[bj];
                    *(u32x4*)(O + (size_t)r * ldc + col0 + bj * 128) = pack8(a, b);
                }
            }
    }
};

template <int CTRL> __device__ __forceinline__ float dpp_mov(float old, float src) {
    return __builtin_bit_cast(float, __builtin_amdgcn_update_dpp(__builtin_bit_cast(int, old), __builtin_bit_cast(int, src), CTRL, 0xf, 0xf, false));
}

struct EpiFfnUp {
    static constexpr bool PERM = true, AFTER_DRAIN = false;
    const float* ssq; const float* cw; const float* cb; bf16_t* HF; LAS float* halo;
    __device__ __forceinline__ void operator()(f32x4 (&acc)[2][2][4][2], const Unit& u, int wr, int wc, int fr, int fq) const {
        int gr0 = u.pm * 254 - 2 + wr * 64 + fr;
        int cl = wc * 32 + 8 * fq;
        asm volatile("" : "+v"(gr0), "+v"(cl));
#pragma unroll
        for (int ai = 0; ai < 2; ++ai)
#pragma unroll
            for (int m = 0; m < 4; ++m) {
                const int gr = gr0 + ai * 128 + m * 16;
                const bool vr = (gr >= 0 && gr < M);
                const float rs = rsqrtf(ssq_sum<4>(ssq, vr ? gr : 0) * (1.f / 1024.f) + EPS);
#pragma unroll
                for (int bj = 0; bj < 2; ++bj)
#pragma unroll
                    for (int n = 0; n < 2; ++n) acc[ai][bj][m][n] = vr ? acc[ai][bj][m][n] * rs : (f32x4){0.f, 0.f, 0.f, 0.f};
                asm volatile("" ::: "memory");
            }
        if (fr >= 14) {
#pragma unroll
            for (int ai = 0; ai < 2; ++ai)
#pragma unroll
                for (int bj = 0; bj < 2; ++bj)
#pragma unroll
                    for (int n = 0; n < 2; ++n) *(LAS f32x4*)(halo + (((2 * ai + wr) * 2 + (fr - 14)) * 256 + bj * 128 + cl + 4 * n)) = acc[ai][bj][3][n];
        }
        asm volatile("s_waitcnt lgkmcnt(0)" ::: "memory"); __builtin_amdgcn_s_barrier(); asm volatile("" ::: "memory");
        const int ch = u.pn * 128 + cl;
#pragma unroll
        for (int n = 0; n < 2; ++n) {
            f32x4 w0[2], w1[2], w2[2], bb[2];
#pragma unroll
            for (int bj = 0; bj < 2; ++bj) {
                const int ci = bj * DFF + ch + 4 * n;
                w0[bj] = *(const f32x4*)(cw + ci); w1[bj] = *(const f32x4*)(cw + DFF2 + ci); w2[bj] = *(const f32x4*)(cw + 2 * DFF2 + ci); bb[bj] = *(const f32x4*)(cb + ci);
            }
#pragma unroll
            for (int ai = 0; ai < 2; ++ai) {
                asm volatile("" : "+v"(gr0));
                const int g = 2 * ai + wr;
                f32x4 pm[2];
#pragma unroll
                for (int bj = 0; bj < 2; ++bj) {
                    pm[bj] = (f32x4){0.f, 0.f, 0.f, 0.f};
                    if (g > 0 && fr >= 14) pm[bj] = *(const LAS f32x4*)(halo + ((((g - 1) * 2) + (fr - 14)) * 256 + bj * 128 + cl + 4 * n));
                }
#pragma unroll
                for (int m = 0; m < 4; ++m) {
                    const int gr = gr0 + ai * 128 + m * 16; const int t = gr & (SEQ - 1);
                    const float k1 = (t >= 1) ? 1.f : 0.f, k2 = (t >= 2) ? 1.f : 0.f;
                    f32x4 y[2];
#pragma unroll
                    for (int bj = 0; bj < 2; ++bj)
#pragma unroll
                        for (int j = 0; j < 4; ++j) {
                            const float cur = acc[ai][bj][m][n][j], pv = pm[bj][j];
                            const float p1 = dpp_mov<0x111>(dpp_mov<0x121>(0.f, pv), cur);
                            const float p2 = dpp_mov<0x112>(dpp_mov<0x122>(0.f, pv), cur);
                            y[bj][j] = bb[bj][j] + w0[bj][j] * (k2 != 0.f ? p2 : 0.f) + w1[bj][j] * (k1 != 0.f ? p1 : 0.f) + w2[bj][j] * cur;
                        }
                    f32x4 h0;
#pragma unroll
                    for (int j = 0; j < 4; ++j) h0[j] = silu_f(y[0][j]) * y[1][j];
                    const bool owned = !(ai == 0 && wr == 0 && m == 0 && fr < 2) && gr < M;
                    if (owned) { u32x2 w; w.x = pk2(h0[0], h0[1]); w.y = pk2(h0[2], h0[3]); *(u32x2*)(HF + (size_t)gr * DFF + ch + 4 * n) = w; }
#pragma unroll
                    for (int bj = 0; bj < 2; ++bj) pm[bj] = acc[ai][bj][m][n];
                    if (m & 1) asm volatile("" ::: "memory");
                }
            }
        }
    }
};
}

__device__ __forceinline__ void cvt_item(const float* W, int ldn, int scol0, int k0, const float* gain, bf16_t* WT, int K, int drow0, LAS float* scr, int lane) {
#pragma unroll 8
    for (int i = 0; i < 32; ++i) {
        const int kk = 2 * i + (lane >> 5);
        float v = W[(size_t)(k0 + kk) * ldn + scol0 + (lane & 31)];
        if (gain) v *= gain[k0 + kk];
        scr[kk * 33 + (lane & 31)] = v;
    }
    LDS_WAIT(); asm volatile("" ::: "memory");
    const int c = lane & 7;
#pragma unroll
    for (int j = 0; j < 4; ++j) {
        const int n = (lane >> 3) + 8 * j; const LAS float* s = scr + (8 * c) * 33 + n;
        u32x4 o; o.x = pk2(s[0 * 33], s[1 * 33]); o.y = pk2(s[2 * 33], s[3 * 33]); o.z = pk2(s[4 * 33], s[5 * 33]); o.w = pk2(s[6 * 33], s[7 * 33]);
        *(u32x4*)(WT + (size_t)(drow0 + n) * K + k0 + 8 * c) = o;
    }
    LDS_WAIT(); asm volatile("" ::: "memory");
}
__device__ __forceinline__ int cvt_map(int map, int drow0) {
    if (map == 1) return (drow0 >> 7) * 256 + (drow0 & 127);
    if (map == 2) return (drow0 >> 7) * 256 + 128 + (drow0 & 127);
    if (map == 3) return ((drow0 >> 7) & 1) * DFF + (drow0 >> 8) * 128 + (drow0 & 127);
    return drow0;
}
__device__ __forceinline__ void cvt_item2(const float* W, int ldn, int scolA, int kA, int scolB, int kB, bool hasB, const float* gain, bf16_t* WT, int K, int drowA, int drowB, LAS float* scr, int lane) {
    LAS float* scrB = scr + 64 * 33;
    float va[32], vb[32];
#pragma unroll
    for (int i = 0; i < 32; ++i) { const int kk = 2 * i + (lane >> 5); va[i] = W[(size_t)(kA + kk) * ldn + scolA + (lane & 31)]; }
    if (hasB) {
#pragma unroll
        for (int i = 0; i < 32; ++i) { const int kk = 2 * i + (lane >> 5); vb[i] = W[(size_t)(kB + kk) * ldn + scolB + (lane & 31)]; }
    }
#pragma unroll
    for (int i = 0; i < 32; ++i) { const int kk = 2 * i + (lane >> 5); float v = va[i]; if (gain) v *= gain[kA + kk]; scr[kk * 33 + (lane & 31)] = v; }
    if (hasB) {
#pragma unroll
        for (int i = 0; i < 32; ++i) { const int kk = 2 * i + (lane >> 5); float v = vb[i]; if (gain) v *= gain[kB + kk]; scrB[kk * 33 + (lane & 31)] = v; }
    }
    LDS_WAIT(); asm volatile("" ::: "memory");
    const int c = lane & 7;
#pragma unroll
    for (int j = 0; j < 4; ++j) {
        const int n = (lane >> 3) + 8 * j; const LAS float* s = scr + (8 * c) * 33 + n;
        u32x4 o; o.x = pk2(s[0 * 33], s[1 * 33]); o.y = pk2(s[2 * 33], s[3 * 33]); o.z = pk2(s[4 * 33], s[5 * 33]); o.w = pk2(s[6 * 33], s[7 * 33]);
        *(u32x4*)(WT + (size_t)(drowA + n) * K + kA + 8 * c) = o;
    }
    if (hasB) {
#pragma unroll
        for (int j = 0; j < 4; ++j) {
            const int n = (lane >> 3) + 8 * j; const LAS float* s = scrB + (8 * c) * 33 + n;
            u32x4 o; o.x = pk2(s[0 * 33], s[1 * 33]); o.y = pk2(s[2 * 33], s[3 * 33]); o.z = pk2(s[4 * 33], s[5 * 33]); o.w = pk2(s[6 * 33], s[7 * 33]);
            *(u32x4*)(WT + (size_t)(drowB + n) * K + kB + 8 * c) = o;
        }
    }
    LDS_WAIT(); asm volatile("" ::: "memory");
}
__device__ __forceinline__ void cvt_job(const float* W, int K, int ldn, const float* gain, bf16_t* WT, int nrows, int map, int& rot, int gw, int NGW, LAS float* scr, int lane) {
    const int nb = nrows / 32, nitems = (K / 64) * nb;
    int start = gw - (rot % NGW); if (start < 0) start += NGW;
    for (int it = start; it < nitems; it += 2 * NGW) {
        const int it2 = it + NGW; const bool hasB = it2 < nitems; const int itb = hasB ? it2 : it;
        const int kbA = it / nb, bA = it % nb, kbB = itb / nb, bB = itb % nb;
        cvt_item2(W, ldn, cvt_map(map, 32 * bA), 64 * kbA, cvt_map(map, 32 * bB), 64 * kbB, hasB, gain, WT, K, 32 * bA, 32 * bB, scr, lane);
    }
    rot += nitems;
}

__device__ __forceinline__ void hgrn_local(LAS unsigned char* lds, const bf16_t* V, const float* LF, bf16_t* ST, float* DL, int G, int bid, unsigned* dgp = nullptr) {
    int tid = threadIdx.x; asm volatile("" : "+v"(tid));
    const int lane = tid & 63, wid = __builtin_amdgcn_readfirstlane(tid >> 6);
    LAS bf16_t* KdT = (LAS bf16_t*)lds;
    LAS bf16_t* VT = (LAS bf16_t*)(lds + 18432);
    LAS float* tot = (LAS float*)(lds + 36864);
    const int d = tid & 127, part = tid >> 7, l15 = lane & 15, q4 = lane >> 4;
    for (int unit = bid; unit < 16 * 127; unit += G) {
        const int bh = unit / 127, n = unit % 127, b = bh >> 3, h = bh & 7;
        const size_t row0 = (size_t)b * SEQ + n * 64 + part * 16;
        const float* lfp = LF + row0 * 1024 + h * 128 + d;
        const bf16_t* vp = V + row0 * 1024 + h * 128 + d;
        float g[16], kk[16]; unsigned vv[16];
#pragma unroll
        for (int j = 0; j < 16; ++j) { g[j] = lfp[(size_t)j * 1024]; vv[j] = vp[(size_t)j * 1024]; }
        float run = 0.f;
#pragma unroll
        for (int j = 0; j < 16; ++j) { kk[j] = 1.f - __expf(g[j]); run += g[j]; g[j] = run; }
        tot[part * 128 + d] = run;
        __syncthreads();
        const float t0 = tot[d], t1 = tot[128 + d], t2 = tot[256 + d], t3 = tot[384 + d];
        const float off = part == 0 ? 0.f : (part == 1 ? t0 : (part == 2 ? t0 + t1 : t0 + t1 + t2));
        const float gl = (t0 + t1) + (t2 + t3);
#pragma unroll
        for (int j = 0; j < 16; ++j) kk[j] *= __expf(gl - (off + g[j]));
#ifdef DIAG_SUBCHK
        { bool bk = false, bv = false;
#pragma unroll
          for (int j = 0; j < 16; ++j) { if (!(fabsf(kk[j]) < 1.01f)) bk = true; if (!(fabsf(bf2f(vv[j])) < 100.f)) bv = true; }
          if (bk) atomicMin(dgp, 51u); if (bv) atomicMin(dgp, 52u); }
#endif
        u32x4 w0, w1, x0, x1;
        w0.x = pk2(kk[0], kk[1]); w0.y = pk2(kk[2], kk[3]); w0.z = pk2(kk[4], kk[5]); w0.w = pk2(kk[6], kk[7]);
        w1.x = pk2(kk[8], kk[9]); w1.y = pk2(kk[10], kk[11]); w1.z = pk2(kk[12], kk[13]); w1.w = pk2(kk[14], kk[15]);
        x0.x = vv[0] | (vv[1] << 16); x0.y = vv[2] | (vv[3] << 16); x0.z = vv[4] | (vv[5] << 16); x0.w = vv[6] | (vv[7] << 16);
        x1.x = vv[8] | (vv[9] << 16); x1.y = vv[10] | (vv[11] << 16); x1.z = vv[12] | (vv[13] << 16); x1.w = vv[14] | (vv[15] << 16);
        *(LAS u32x4*)(KdT + d * 72 + part * 16) = w0; *(LAS u32x4*)(KdT + d * 72 + part * 16 + 8) = w1;
        *(LAS u32x4*)(VT + d * 72 + part * 16) = x0; *(LAS u32x4*)(VT + d * 72 + part * 16 + 8) = x1;
        if (part == 0) DL[(size_t)(bh * 128 + n) * 128 + d] = __expf(gl);
        __syncthreads();
        bf16x8 af[2];
#pragma unroll
        for (int ks = 0; ks < 2; ++ks) af[ks] = *(const LAS bf16x8*)(KdT + (16 * wid + l15) * 72 + 32 * ks + 8 * q4);
        bf16_t* dst = ST + (size_t)(bh * 128 + n) * 16384;
#pragma unroll
        for (int et = 0; et < 8; ++et) {
            f32x4 c = {0.f, 0.f, 0.f, 0.f};
#pragma unroll
            for (int ks = 0; ks < 2; ++ks) {
                const bf16x8 bfr = *(const LAS bf16x8*)(VT + (16 * et + l15) * 72 + 32 * ks + 8 * q4);
                c = __builtin_amdgcn_mfma_f32_16x16x32_bf16(af[ks], bfr, c, 0, 0, 0);
            }
#ifdef DIAG_SUBCHK
            { bool bc = false;
#pragma unroll
              for (int r = 0; r < 4; ++r) if (!(fabsf(c[r]) < 1e5f)) bc = true;
              if (bc) atomicMin(dgp, 53u); }
#endif
            u32x2 o; o.x = pk2c(c[0], c[1]); o.y = pk2c(c[2], c[3]);
            *(u32x2*)(dst + (size_t)(16 * et + l15) * 128 + 16 * wid + 4 * q4) = o;
        }
    }
}

__device__ __forceinline__ void hgrn_scan(bf16_t* ST, const float* DL, int gtid, int gthreads) {
    for (int item = gtid; item < 16 * 8192; item += gthreads) {
        const int bh = item >> 13, idx = (item & 8191) * 2, d = idx & 127;
        float s0 = 0.f, s1 = 0.f;
        unsigned* p = (unsigned*)(ST + (size_t)bh * 128 * 16384 + idx);
        const float* dl = DL + (size_t)bh * 128 * 128 + d;
#pragma unroll 8
        for (int n = 0; n < 127; ++n) {
            const unsigned w = p[(size_t)n * 8192]; const float d0 = dl[n * 128], d1 = dl[n * 128 + 1];
            s0 = s0 * d0 + bflo(w); s1 = s1 * d1 + bfhi(w);
            p[(size_t)n * 8192] = pk2(s0, s1);
        }
    }
}

__device__ __forceinline__ void hgrn_out(LAS unsigned char* lds, const bf16_t* Q, const bf16_t* V, const bf16_t* Gt, const float* LF, const bf16_t* ST, const float* onorm, bf16_t* OH, int G, int bid) {
    int tid = threadIdx.x; asm volatile("" : "+v"(tid));
    const int lane = tid & 63, wid = __builtin_amdgcn_readfirstlane(tid >> 6);
    LAS bf16_t* QtS = (LAS bf16_t*)lds;
    LAS bf16_t* KtS = (LAS bf16_t*)(lds + 17408);
    LAS bf16_t* VT = (LAS bf16_t*)(lds + 34816);
    LAS bf16_t* STs = (LAS bf16_t*)(lds + 53248);
    LAS float* tot = (LAS float*)(lds + 88064);
    LAS float* eg = (LAS float*)(lds + 90112);
    LAS float* red = (LAS float*)(lds + 90624);
    const int d = tid & 127, part = tid >> 7, l15 = lane & 15, q4 = lane >> 4;
    const int tb = wid & 3, eh = wid >> 2;
    float rg[16]; unsigned rv[16], rq[16]; u32x4 rs[4];
#define HO_LOAD(unit_) do { const int bh_ = (unit_) >> 7, n_ = (unit_) & 127; const size_t c0_ = ((size_t)(bh_ >> 3) * SEQ + n_ * 64 + part * 16) * 1024 + (bh_ & 7) * 128 + d; \
        _Pragma("unroll") for (int j = 0; j < 16; ++j) { rg[j] = LF[c0_ + (size_t)j * 1024]; rv[j] = V[c0_ + (size_t)j * 1024]; rq[j] = Q[c0_ + (size_t)j * 1024]; } \
        if (n_ > 0) { const bf16_t* stp_ = ST + (size_t)(bh_ * 128 + n_ - 1) * 16384; _Pragma("unroll") for (int i = 0; i < 4; ++i) { const int p_ = tid + 512 * i; rs[i] = *(const u32x4*)(stp_ + (size_t)(p_ >> 4) * 128 + (p_ & 15) * 8); } } } while (0)
    if (bid < 16 * 128) HO_LOAD(bid);
    for (int unit = bid; unit < 16 * 128; unit += G) {
        const int bh = unit >> 7, n = unit & 127, b = bh >> 3, h = bh & 7;
        float g[16], kk[16], qq[16]; unsigned vv[16]; u32x4 sreg[4];
#pragma unroll
        for (int j = 0; j < 16; ++j) { g[j] = rg[j]; vv[j] = rv[j]; qq[j] = bf2f(rq[j]); }
#pragma unroll
        for (int i = 0; i < 4; ++i) sreg[i] = rs[i];
        if (unit + G < 16 * 128) HO_LOAD(unit + G);
        float run = 0.f;
#pragma unroll
        for (int j = 0; j < 16; ++j) { kk[j] = 1.f - __expf(g[j]); run += g[j]; g[j] = run; }
        tot[part * 128 + d] = run;
        __syncthreads();
        const float t0 = tot[d], t1 = tot[128 + d], t2 = tot[256 + d];
        const float off = part == 0 ? 0.f : (part == 1 ? t0 : (part == 2 ? t0 + t1 : t0 + t1 + t2));
        const float gref = t0 + t1;
#pragma unroll
        for (int j = 0; j < 16; ++j) {
            const float gs = off + g[j];
            QtS[(part * 16 + j) * 136 + d] = (bf16_t)(pk2(qq[j] * __expf(gs - gref), 0.f) & 0xffffu);
            KtS[(part * 16 + j) * 136 + d] = (bf16_t)(pk2(kk[j] * __expf(gref - gs), 0.f) & 0xffffu);
        }
        u32x4 x0, x1;
        x0.x = vv[0] | (vv[1] << 16); x0.y = vv[2] | (vv[3] << 16); x0.z = vv[4] | (vv[5] << 16); x0.w = vv[6] | (vv[7] << 16);
        x1.x = vv[8] | (vv[9] << 16); x1.y = vv[10] | (vv[11] << 16); x1.z = vv[12] | (vv[13] << 16); x1.w = vv[14] | (vv[15] << 16);
        *(LAS u32x4*)(VT + d * 72 + part * 16) = x0; *(LAS u32x4*)(VT + d * 72 + part * 16 + 8) = x1;
        if (part == 0) eg[d] = __expf(gref);
        __syncthreads();
        if (n > 0) {
#pragma unroll
            for (int i = 0; i < 4; ++i) {
                const int p = tid + 512 * i, e = p >> 4, c8 = (p & 15) * 8;
                const f32x4 ea = *(const LAS f32x4*)(eg + c8), eb = *(const LAS f32x4*)(eg + c8 + 4);
                u32x4 w = sreg[i], o;
                o.x = pk2(bflo(w.x) * ea[0], bfhi(w.x) * ea[1]); o.y = pk2(bflo(w.y) * ea[2], bfhi(w.y) * ea[3]);
                o.z = pk2(bflo(w.z) * eb[0], bfhi(w.z) * eb[1]); o.w = pk2(bflo(w.w) * eb[2], bfhi(w.w) * eb[3]);
                *(LAS u32x4*)(STs + e * 136 + c8) = o;
            }
        }
        __syncthreads();
        bf16x8 qfr[4];
#pragma unroll
        for (int k4 = 0; k4 < 4; ++k4) qfr[k4] = *(const LAS bf16x8*)(QtS + (16 * tb + l15) * 136 + 32 * k4 + 8 * q4);
        f32x4 sc[4];
#pragma unroll
        for (int si = 0; si < 4; ++si) {
            sc[si] = (f32x4){0.f, 0.f, 0.f, 0.f};
            if (si <= tb) {
#pragma unroll
                for (int k4 = 0; k4 < 4; ++k4) {
                    const bf16x8 kf = *(const LAS bf16x8*)(KtS + (16 * si + l15) * 136 + 32 * k4 + 8 * q4);
                    sc[si] = __builtin_amdgcn_mfma_f32_16x16x32_bf16(kf, qfr[k4], sc[si], 0, 0, 0);
                }
            }
#pragma unroll
            for (int r = 0; r < 4; ++r) if (!(16 * si + 4 * q4 + r <= 16 * tb + l15)) sc[si][r] = 0.f;
        }
        bf16x8 pf[2];
#pragma unroll
        for (int ks = 0; ks < 2; ++ks) {
            u32x4 w; w.x = pk2(sc[2 * ks][0], sc[2 * ks][1]); w.y = pk2(sc[2 * ks][2], sc[2 * ks][3]); w.z = pk2(sc[2 * ks + 1][0], sc[2 * ks + 1][1]); w.w = pk2(sc[2 * ks + 1][2], sc[2 * ks + 1][3]);
            pf[ks] = __builtin_bit_cast(bf16x8, w);
        }
        f32x4 oa[4]; float ss = 0.f;
#pragma unroll
        for (int et = 0; et < 4; ++et) {
            const int erow = 64 * eh + 16 * et + l15;
            oa[et] = (f32x4){0.f, 0.f, 0.f, 0.f};
#pragma unroll
            for (int ks = 0; ks < 2; ++ks) {
                if (ks == 0 || tb >= 2) {
                    const u32x2 lo = *(const LAS u32x2*)(VT + erow * 72 + 32 * ks + 4 * q4), hi = *(const LAS u32x2*)(VT + erow * 72 + 32 * ks + 16 + 4 * q4);
                    const u32x4 w = {lo.x, lo.y, hi.x, hi.y};
                    oa[et] = __builtin_amdgcn_mfma_f32_16x16x32_bf16(__builtin_bit_cast(bf16x8, w), pf[ks], oa[et], 0, 0, 0);
                }
            }
            if (n > 0) {
#pragma unroll
                for (int k4 = 0; k4 < 4; ++k4) {
                    const bf16x8 sf = *(const LAS bf16x8*)(STs + erow * 136 + 32 * k4 + 8 * q4);
                    oa[et] = __builtin_amdgcn_mfma_f32_16x16x32_bf16(sf, qfr[k4], oa[et], 0, 0, 0);
                }
            }
            ss += (oa[et][0] * oa[et][0] + oa[et][1] * oa[et][1]) + (oa[et][2] * oa[et][2] + oa[et][3] * oa[et][3]);
        }
        ss += __shfl_xor(ss, 16); ss += __shfl_xor(ss, 32);
        if (q4 == 0) red[(16 * tb + l15) * 2 + eh] = ss;
        __syncthreads();
        const float tss = red[(16 * tb + l15) * 2] + red[(16 * tb + l15) * 2 + 1];
        const float rstd = rsqrtf(tss * (1.f / 128.f) + EPS);
        const size_t orow = (size_t)b * SEQ + n * 64 + 16 * tb + l15;
#pragma unroll
        for (int et = 0; et < 4; ++et) {
            const int e0 = 64 * eh + 16 * et + 4 * q4;
            const f32x4 gn = *(const f32x4*)(onorm + e0);
            const u32x2 gt = *(const u32x2*)(Gt + orow * 1024 + h * 128 + e0);
            u32x2 o;
            o.x = pk2(oa[et][0] * rstd * gn[0] * bflo(gt.x), oa[et][1] * rstd * gn[1] * bfhi(gt.x));
            o.y = pk2(oa[et][2] * rstd * gn[2] * bflo(gt.y), oa[et][3] * rstd * gn[3] * bfhi(gt.y));
            *(u32x2*)(OH + orow * 1024 + h * 128 + e0) = o;
        }
    }
#undef HO_LOAD
}

__device__ __forceinline__ void mla_finalize(bf16_t* QF, const bf16_t* KN, const float* KR, bf16_t* KF, const int* pos, const float* invf, const float* qg, const float* kg, int gw, int NGW, int lane) {
    const int hd = lane >> 3, sub = lane & 7;
    float gq[16], gk[16], gq1[4], gq2[4], gk1[4], gk2[4], fr[4];
#pragma unroll
    for (int e = 0; e < 16; ++e) { gq[e] = qg[16 * sub + e]; gk[e] = kg[16 * sub + e]; }
#pragma unroll
    for (int j = 0; j < 4; ++j) { gq1[j] = qg[128 + 4 * sub + j]; gq2[j] = qg[160 + 4 * sub + j]; gk1[j] = kg[128 + 4 * sub + j]; gk2[j] = kg[160 + 4 * sub + j]; fr[j] = invf[4 * sub + j]; }
    for (int row = gw; row < M; row += NGW) {
        const float pf = (float)pos[row];
        float cs[4], sn[4];
#pragma unroll
        for (int j = 0; j < 4; ++j) rope_cs(pf * fr[j], cs[j], sn[j]);
        {
            bf16_t* qp = QF + (size_t)row * 1536 + hd * 192;
            const u32x4 a = *(const u32x4*)(qp + 16 * sub), b2 = *(const u32x4*)(qp + 16 * sub + 8);
            const u32x2 r1 = *(const u32x2*)(qp + 128 + 4 * sub), r2 = *(const u32x2*)(qp + 160 + 4 * sub);
            float xn[16], x1[4], x2[4];
            xn[0] = bflo(a.x); xn[1] = bfhi(a.x); xn[2] = bflo(a.y); xn[3] = bfhi(a.y); xn[4] = bflo(a.z); xn[5] = bfhi(a.z); xn[6] = bflo(a.w); xn[7] = bfhi(a.w);
            xn[8] = bflo(b2.x); xn[9] = bfhi(b2.x); xn[10] = bflo(b2.y); xn[11] = bfhi(b2.y); xn[12] = bflo(b2.z); xn[13] = bfhi(b2.z); xn[14] = bflo(b2.w); xn[15] = bfhi(b2.w);
            x1[0] = bflo(r1.x); x1[1] = bfhi(r1.x); x1[2] = bflo(r1.y); x1[3] = bfhi(r1.y);
            x2[0] = bflo(r2.x); x2[1] = bfhi(r2.x); x2[2] = bflo(r2.y); x2[3] = bfhi(r2.y);
            float ss = 0.f;
#pragma unroll
            for (int e = 0; e < 16; ++e) ss += xn[e] * xn[e];
#pragma unroll
            for (int j = 0; j < 4; ++j) ss += x1[j] * x1[j] + x2[j] * x2[j];
            ss += __shfl_xor(ss, 1); ss += __shfl_xor(ss, 2); ss += __shfl_xor(ss, 4);
            const float rs = rsqrtf(ss * (1.f / 192.f) + EPS) * QSCALE;
#pragma unroll
            for (int e = 0; e < 16; ++e) xn[e] *= rs * gq[e];
            float o1[4], o2[4];
#pragma unroll
            for (int j = 0; j < 4; ++j) { const float y1 = x1[j] * rs * gq1[j], y2 = x2[j] * rs * gq2[j]; o1[j] = y1 * cs[j] - y2 * sn[j]; o2[j] = y2 * cs[j] + y1 * sn[j]; }
            u32x4 wa, wb; u32x2 w1, w2;
            wa.x = pk2(xn[0], xn[1]); wa.y = pk2(xn[2], xn[3]); wa.z = pk2(xn[4], xn[5]); wa.w = pk2(xn[6], xn[7]);
            wb.x = pk2(xn[8], xn[9]); wb.y = pk2(xn[10], xn[11]); wb.z = pk2(xn[12], xn[13]); wb.w = pk2(xn[14], xn[15]);
            w1.x = pk2(o1[0], o1[1]); w1.y = pk2(o1[2], o1[3]); w2.x = pk2(o2[0], o2[1]); w2.y = pk2(o2[2], o2[3]);
            *(u32x4*)(qp + 16 * sub) = wa; *(u32x4*)(qp + 16 * sub + 8) = wb; *(u32x2*)(qp + 128 + 4 * sub) = w1; *(u32x2*)(qp + 160 + 4 * sub) = w2;
        }
        {
            const bf16_t* kp = KN + (size_t)row * 1024 + hd * 128;
            const u32x4 a = *(const u32x4*)(kp + 16 * sub), b2 = *(const u32x4*)(kp + 16 * sub + 8);
            const f32x4 r1 = *(const f32x4*)(KR + (size_t)row * 64 + 4 * sub), r2 = *(const f32x4*)(KR + (size_t)row * 64 + 32 + 4 * sub);
            float xn[16];
            xn[0] = bflo(a.x); xn[1] = bfhi(a.x); xn[2] = bflo(a.y); xn[3] = bfhi(a.y); xn[4] = bflo(a.z); xn[5] = bfhi(a.z); xn[6] = bflo(a.w); xn[7] = bfhi(a.w);
            xn[8] = bflo(b2.x); xn[9] = bfhi(b2.x); xn[10] = bflo(b2.y); xn[11] = bfhi(b2.y); xn[12] = bflo(b2.z); xn[13] = bfhi(b2.z); xn[14] = bflo(b2.w); xn[15] = bfhi(b2.w);
            float ss = 0.f;
#pragma unroll
            for (int e = 0; e < 16; ++e) ss += xn[e] * xn[e];
#pragma unroll
            for (int j = 0; j < 4; ++j) ss += r1[j] * r1[j] + r2[j] * r2[j];
            ss += __shfl_xor(ss, 1); ss += __shfl_xor(ss, 2); ss += __shfl_xor(ss, 4);
            const float rs = rsqrtf(ss * (1.f / 192.f) + EPS);
#pragma unroll
            for (int e = 0; e < 16; ++e) xn[e] *= rs * gk[e];
            float o1[4], o2[4];
#pragma unroll
            for (int j = 0; j < 4; ++j) { const float y1 = r1[j] * rs * gk1[j], y2 = r2[j] * rs * gk2[j]; o1[j] = y1 * cs[j] - y2 * sn[j]; o2[j] = y2 * cs[j] + y1 * sn[j]; }
            bf16_t* op = KF + (size_t)row * 1536 + hd * 192;
            u32x4 wa, wb; u32x2 w1, w2;
            wa.x = pk2(xn[0], xn[1]); wa.y = pk2(xn[2], xn[3]); wa.z = pk2(xn[4], xn[5]); wa.w = pk2(xn[6], xn[7]);
            wb.x = pk2(xn[8], xn[9]); wb.y = pk2(xn[10], xn[11]); wb.z = pk2(xn[12], xn[13]); wb.w = pk2(xn[14], xn[15]);
            w1.x = pk2(o1[0], o1[1]); w1.y = pk2(o1[2], o1[3]); w2.x = pk2(o2[0], o2[1]); w2.y = pk2(o2[2], o2[3]);
            *(u32x4*)(op + 16 * sub) = wa; *(u32x4*)(op + 16 * sub + 8) = wb; *(u32x2*)(op + 128 + 4 * sub) = w1; *(u32x2*)(op + 160 + 4 * sub) = w2;
        }
    }
}

__device__ __forceinline__ int crow(int r, int hi) { return (r & 3) + 8 * (r >> 2) + 4 * hi; }

constexpr int ATT_KBUF = 25600, ATT_VBUF = 18432, ATT_VBASE = 2 * ATT_KBUF;
__device__ __forceinline__ void att_dma(unsigned ldsdst, unsigned voff, const char* sbase) {
    unsigned keep;
    asm volatile("s_mov_b32 %0, m0\n\ts_mov_b32 m0, %1\n\ts_nop 0\n\tglobal_load_lds_dwordx4 %2, %3\n\ts_mov_b32 m0, %0" : "=&s"(keep) : "s"(ldsdst), "v"(voff), "s"(sbase) : "memory");
}
__device__ __forceinline__ void att_pv(f32x16 (&o)[4], const bf16x8 (&pf)[4], const LAS bf16_t* Vs, int l31, int hi) {
#pragma unroll
    for (int db = 0; db < 4; ++db)
#pragma unroll
        for (int st = 0; st < 4; ++st) {
            const bf16x8 vf = *(const LAS bf16x8*)(Vs + (32 * db + l31) * 72 + 16 * st + 8 * hi);
            o[db] = __builtin_amdgcn_mfma_f32_32x32x16_bf16(vf, pf[st], o[db], 0, 0, 0);
            if (st == 3) asm volatile("" ::: "memory");
        }
}
__device__ __forceinline__ void attn_unit(LAS unsigned char* lds, const bf16_t* QF, const bf16_t* KF, const bf16_t* VT, bf16_t* O, const int* pos, const float* invf, const float* qg, int b, int h, int qb) {
    int tid = threadIdx.x; asm volatile("" : "+v"(tid));
    const int lane = tid & 63, wid = __builtin_amdgcn_readfirstlane(tid >> 6), l31 = lane & 31, hi = lane >> 5;
    const bool grpB = wid >= 4;
    const unsigned lds_u32 = (unsigned)(__UINTPTR_TYPE__)lds;
    const int q0 = qb * 256, qw = q0 + wid * 32;
    const size_t rowb = (size_t)b * SEQ;
    const int NT = (q0 + 256) / 64;
    unsigned doff[6];
#pragma unroll
    for (int k = 0; k < 6; ++k) {
        const int I = wid + 8 * k;
        if (I < 25) { const int P = 64 * I + lane, r = P / 25, c = P % 25, rs = (r & ~12) | ((r & 4) << 1) | ((r & 8) >> 1);
            doff[k] = (unsigned)(rs * 3072 + (c < 24 ? c : 23) * 16); }
        else { const int P = 64 * (I - 25) + lane, d = P / 9, c = P % 9; doff[k] = (unsigned)(d * (M * 2) + (c < 8 ? c : 7) * 16); }
    }
    const char* kbase = (const char*)(KF + rowb * 1536 + h * 192);
    const char* vbase = (const char*)(VT + (size_t)(h * 128) * M + rowb);
#define ATT_ISSUE(t, kb, vb) do { const char* kb_ = kbase + (size_t)(t) * (64 * 3072); const char* vb_ = vbase + (size_t)(t) * 128; const unsigned lk_ = lds_u32 + (unsigned)(kb) * ATT_KBUF, lv_ = lds_u32 + ATT_VBASE + (unsigned)(vb) * ATT_VBUF; \
        _Pragma("unroll") for (int k = 0; k < 6; ++k) { const int I = wid + 8 * k; if (I < 25) att_dma(lk_ + (unsigned)I * 1024u, doff[k], kb_); else if (I < 43) att_dma(lv_ + (unsigned)(I - 25) * 1024u, doff[k], vb_); } } while (0)
    ATT_ISSUE(0, 0, 0);
    bf16x8 qf[12];
    {
        const bf16_t* qp = QF + (rowb + qw + l31) * 1536 + h * 192 + hi * 8;
#pragma unroll
        for (int ks = 0; ks < 12; ++ks) qf[ks] = *(const bf16x8*)(qp + ks * 16);
        float ss = 0.f;
#pragma unroll
        for (int ks = 0; ks < 12; ++ks) { const u32x4 w = __builtin_bit_cast(u32x4, qf[ks]);
            ss += (bflo(w.x) * bflo(w.x) + bfhi(w.x) * bfhi(w.x)) + (bflo(w.y) * bflo(w.y) + bfhi(w.y) * bfhi(w.y)) + (bflo(w.z) * bflo(w.z) + bfhi(w.z) * bfhi(w.z)) + (bflo(w.w) * bflo(w.w) + bfhi(w.w) * bfhi(w.w)); }
        ss += __shfl_xor(ss, 32);
        const float rstd = rsqrtf(ss * (1.f / 192.f) + EPS) * QSCALE;
#pragma unroll
        for (int ks = 0; ks < 8; ++ks) { const u32x4 w = __builtin_bit_cast(u32x4, qf[ks]); const f32x4 ga = *(const f32x4*)(qg + ks * 16 + hi * 8), gb = *(const f32x4*)(qg + ks * 16 + hi * 8 + 4);
            const f32x4 a = {bflo(w.x) * rstd * ga[0], bfhi(w.x) * rstd * ga[1], bflo(w.y) * rstd * ga[2], bfhi(w.y) * rstd * ga[3]}, bq = {bflo(w.z) * rstd * gb[0], bfhi(w.z) * rstd * gb[1], bflo(w.w) * rstd * gb[2], bfhi(w.w) * rstd * gb[3]};
            qf[ks] = __builtin_bit_cast(bf16x8, pack8(a, bq)); }
        const float pf_ = (float)pos[rowb + qw + l31];
#pragma unroll
        for (int kk = 0; kk < 2; ++kk) {
            const u32x4 w1 = __builtin_bit_cast(u32x4, qf[8 + kk]), w2 = __builtin_bit_cast(u32x4, qf[10 + kk]);
            u32x4 r1, r2;
#define ATT_ROPE2(W1, W2, R1, R2, e) do { const int i_ = 16 * kk + 8 * hi + 2 * (e); \
                const float xa_ = bflo(W1) * rstd * qg[128 + i_], xb_ = bfhi(W1) * rstd * qg[129 + i_], ya_ = bflo(W2) * rstd * qg[160 + i_], yb_ = bfhi(W2) * rstd * qg[161 + i_]; \
                float ca_, sa_, cb_, sb_; rope_cs(pf_ * invf[i_], ca_, sa_); rope_cs(pf_ * invf[i_ + 1], cb_, sb_); \
                R1 = pk2(xa_ * ca_ - ya_ * sa_, xb_ * cb_ - yb_ * sb_); R2 = pk2(ya_ * ca_ + xa_ * sa_, yb_ * cb_ + xb_ * sb_); } while (0)
            ATT_ROPE2(w1.x, w2.x, r1.x, r2.x, 0); ATT_ROPE2(w1.y, w2.y, r1.y, r2.y, 1); ATT_ROPE2(w1.z, w2.z, r1.z, r2.z, 2); ATT_ROPE2(w1.w, w2.w, r1.w, r2.w, 3);
#undef ATT_ROPE2
            qf[8 + kk] = __builtin_bit_cast(bf16x8, r1); qf[10 + kk] = __builtin_bit_cast(bf16x8, r2);
        }
    }
    f32x16 o[4];
#pragma unroll
    for (int i = 0; i < 4; ++i)
#pragma unroll
        for (int r = 0; r < 16; ++r) o[i][r] = 0.f;
    float mrun = -INFINITY, lrun = 0.f;
    bf16x8 pf[4];
#pragma unroll
    for (int i = 0; i < 4; ++i) pf[i] = (bf16x8){0, 0, 0, 0, 0, 0, 0, 0};
    bool pend = false; int vb = 0, vbp = 0;
    asm volatile("s_waitcnt vmcnt(0)\n\ts_barrier" ::: "memory");
    for (int j = 0; j < NT; ++j) {
        const int kv0 = 64 * j;
        const int vbn = (vb == 2) ? 0 : vb + 1;
        if (j + 1 < NT) ATT_ISSUE(j + 1, (j + 1) & 1, vbn);
        const LAS bf16_t* Ks = (const LAS bf16_t*)(lds + (j & 1) * ATT_KBUF);
        if (pend) { att_pv(o, pf, (const LAS bf16_t*)(lds + ATT_VBASE + vbp * ATT_VBUF), l31, hi); pend = false; }
        if (kv0 <= qw + 31) {
            f32x16 p0, p1;
#pragma unroll
            for (int r = 0; r < 16; ++r) { p0[r] = 0.f; p1[r] = 0.f; }
#pragma unroll
            for (int ks = 0; ks < 12; ++ks) {
                const bf16x8 a0 = *(const LAS bf16x8*)(Ks + l31 * 200 + ks * 16 + hi * 8);
                const bf16x8 a1 = *(const LAS bf16x8*)(Ks + (32 + l31) * 200 + ks * 16 + hi * 8);
                p0 = __builtin_amdgcn_mfma_f32_32x32x16_bf16(a0, qf[ks], p0, 0, 0, 0);
                p1 = __builtin_amdgcn_mfma_f32_32x32x16_bf16(a1, qf[ks], p1, 0, 0, 0);
                if (ks & 1) asm volatile("" ::: "memory");
            }
            if (kv0 + 63 > qw) {
                const int q = qw + l31;
#pragma unroll
                for (int r = 0; r < 16; ++r) { const int kv = kv0 + (r & 3) + 4 * ((r >> 2) & 1) + 8 * hi + 16 * (r >> 3); if (kv > q) p0[r] = -INFINITY; if (kv + 32 > q) p1[r] = -INFINITY; }
            }
            float mx = fmaxf(p0[0], p1[0]);
#pragma unroll
            for (int r = 1; r < 16; ++r) mx = fmaxf(mx, fmaxf(p0[r], p1[r]));
            mx = fmaxf(mx, __shfl_xor(mx, 32));
            if (__any(mx > mrun + 8.f)) {
                const float mnew = fmaxf(mrun, mx);
                const float alpha = __builtin_amdgcn_exp2f(mrun - mnew);
                mrun = mnew; lrun *= alpha;
#pragma unroll
                for (int i = 0; i < 4; ++i)
#pragma unroll
                    for (int r = 0; r < 16; ++r) o[i][r] *= alpha;
            }
            float rsum = 0.f;
#pragma unroll
            for (int r = 0; r < 16; ++r) { p0[r] = __builtin_amdgcn_exp2f(p0[r] - mrun); p1[r] = __builtin_amdgcn_exp2f(p1[r] - mrun); rsum += p0[r] + p1[r]; }
            lrun += rsum;
            {
                u32x4 w;
                w.x = pk2(p0[0], p0[1]); w.y = pk2(p0[2], p0[3]); w.z = pk2(p0[4], p0[5]); w.w = pk2(p0[6], p0[7]); pf[0] = __builtin_bit_cast(bf16x8, w);
                w.x = pk2(p0[8], p0[9]); w.y = pk2(p0[10], p0[11]); w.z = pk2(p0[12], p0[13]); w.w = pk2(p0[14], p0[15]); pf[1] = __builtin_bit_cast(bf16x8, w);
                w.x = pk2(p1[0], p1[1]); w.y = pk2(p1[2], p1[3]); w.z = pk2(p1[4], p1[5]); w.w = pk2(p1[6], p1[7]); pf[2] = __builtin_bit_cast(bf16x8, w);
                w.x = pk2(p1[8], p1[9]); w.y = pk2(p1[10], p1[11]); w.z = pk2(p1[12], p1[13]); w.w = pk2(p1[14], p1[15]); pf[3] = __builtin_bit_cast(bf16x8, w);
            }
            if (grpB) { pend = true; vbp = vb; }
            else att_pv(o, pf, (const LAS bf16_t*)(lds + ATT_VBASE + vb * ATT_VBUF), l31, hi);
        }
        vb = vbn;
        asm volatile("s_waitcnt vmcnt(0) lgkmcnt(0)\n\ts_barrier" ::: "memory");
    }
#undef ATT_ISSUE
    if (pend) att_pv(o, pf, (const LAS bf16_t*)(lds + ATT_VBASE + vbp * ATT_VBUF), l31, hi);
    lrun += __shfl_xor(lrun, 32);
    const float inv = 1.f / lrun;
    bf16_t* op = O + (rowb + qw + l31) * 1024 + h * 128 + 4 * hi;
#pragma unroll
    for (int db = 0; db < 4; ++db)
#pragma unroll
        for (int g = 0; g < 4; ++g) {
            u32x2 w; w.x = pk2(o[db][4 * g] * inv, o[db][4 * g + 1] * inv); w.y = pk2(o[db][4 * g + 2] * inv, o[db][4 * g + 3] * inv);
            *(u32x2*)(op + 32 * db + 8 * g) = w;
        }
    asm volatile("s_waitcnt lgkmcnt(0)\n\ts_barrier" ::: "memory");
}

template <class Epi> __device__ __forceinline__ void run_gemm(LAS unsigned char* lds, const bf16_t* A, int arows, const bf16_t* Bt, int nM, int nN, int K, int G, int c, const Epi& E) {
    pg8::Gemm g{A, Bt, nM * 256, nN * 256, K, arows};
    pg8::StaticOrder S; S.init2(nM, nN, G, c);
    pg8::gemm_phase<Epi, pg8::StaticOrder, true, true>(lds, g, S, E);
}

#define XB_TMO      128
#define XB_XCNT(j)  (256  + 64 * (j))
#define XB_XSUB(j)  (1280 + 64 * (j))
#define XB_XGEN(j)  (2304 + 64 * (j))
#define XB_TOP      3328
#define XB_TOPGEN   3392
#define XCD_BAR_WORDS 3456
#define XB_SPIN_CAP (1u << 18)

__device__ __forceinline__ unsigned xb_ld(unsigned* p)              { return __hip_atomic_load(p, __ATOMIC_RELAXED, __HIP_MEMORY_SCOPE_AGENT); }
__device__ __forceinline__ unsigned xb_add(unsigned* p, unsigned v) { return __hip_atomic_fetch_add(p, v, __ATOMIC_RELAXED, __HIP_MEMORY_SCOPE_AGENT); }
__device__ __forceinline__ unsigned xb_xcc_id() { return (unsigned)__builtin_amdgcn_s_getreg((3 << 11) | 20) & 0xFu; }
#define XB_SPIN(cond, bar) do { unsigned _sp = 0; while (cond) { __builtin_amdgcn_s_sleep(1); \
    if ((++_sp & 255u) == 0u) { if (xb_ld(&(bar)[XB_TMO])) break; if (_sp > XB_SPIN_CAP) { atomicAdd(&(bar)[XB_TMO], 1u); break; } } } } while (0)

struct XcdBarrier {
    unsigned* bar; unsigned x;
    volatile LAS unsigned* st;
};

__device__ __forceinline__ XcdBarrier xcd_barrier_post(unsigned* bar, volatile LAS unsigned* st) {
    XcdBarrier b; b.bar = bar; b.x = xb_xcc_id(); b.st = st;
    if (threadIdx.x == 0) (void)xb_add(&bar[XB_XCNT(b.x)], 1u);
    return b;
}
__device__ __forceinline__ void xcd_barrier_complete(unsigned* bar, unsigned x, unsigned& nloc, unsigned& nx) {
    const unsigned G = gridDim.x * gridDim.y * gridDim.z;
    unsigned sum, cnt, mine, sp = 0u;
    for (;;) {
        sum = 0u; cnt = 0u; mine = 0u;
#pragma unroll
        for (unsigned j = 0; j < 16; ++j) { const unsigned c = xb_ld(&bar[XB_XCNT(j)]); sum += c; cnt += (c > 0u) ? 1u : 0u; mine = (j == x) ? c : mine; }
        if (sum == G) break;
        __builtin_amdgcn_s_sleep(1);
        if ((++sp & 255u) == 0u) { if (xb_ld(&bar[XB_TMO])) break; if (sp > XB_SPIN_CAP) { atomicAdd(&bar[XB_TMO], 1u); break; } }
    }
    nloc = mine > 0u ? mine : 1u; nx = cnt > 0u ? cnt : 1u;
}

__device__ __forceinline__ void xcd_barrier(const XcdBarrier& b) {
    asm volatile("s_waitcnt vmcnt(0)" ::: "memory");
    __syncthreads();
    if (threadIdx.x == 0) {
        unsigned* bar = b.bar;
        __builtin_amdgcn_s_waitcnt(0);
        unsigned nloc = b.st[0], nx = b.st[1];
        if (nloc == 0u) { xcd_barrier_complete(bar, b.x, nloc, nx); b.st[0] = nloc; b.st[1] = nx; }
        const unsigned old = xb_add(&bar[XB_XSUB(b.x)], 1u);
        const unsigned gen = old / nloc;
        if (old + 1u == (gen + 1u) * nloc) {
            __builtin_amdgcn_fence(__ATOMIC_RELEASE, "agent");
            asm volatile("s_waitcnt vmcnt(0)" ::: "memory");
            const unsigned og = xb_add(&bar[XB_TOP], 1u);
            const unsigned tg = og / nx;
            if (og + 1u == (tg + 1u) * nx) xb_add(&bar[XB_TOPGEN], 1u);
            else XB_SPIN(xb_ld(&bar[XB_TOPGEN]) == tg, bar);
            __builtin_amdgcn_fence(__ATOMIC_ACQUIRE, "agent");
            xb_add(&bar[XB_XGEN(b.x)], 1u);
            asm volatile("s_waitcnt vmcnt(0)" ::: "memory");
        } else {
            XB_SPIN(xb_ld(&bar[XB_XGEN(b.x)]) == gen, bar);
            __builtin_amdgcn_fence(__ATOMIC_ACQUIRE, "agent");
            asm volatile("s_waitcnt vmcnt(0)" ::: "memory");
        }
    }
    __syncthreads();
}

#define GRID_SYNC() do { asm volatile("s_waitcnt vmcnt(0) lgkmcnt(0)" ::: "memory"); grid.sync(); __builtin_amdgcn_fence(__ATOMIC_ACQUIRE, "agent"); asm volatile("s_waitcnt vmcnt(0)" ::: "memory"); } while (0)
#define XSYNC() xcd_barrier(xbar)
typedef const __attribute__((address_space(4))) Args* KArgs;
#define KA() ({ KArgs k_ = (KArgs)__builtin_amdgcn_kernarg_segment_ptr(); asm volatile("" : "+s"(k_)); k_; })

#ifdef STOP_LAYER
__device__ __forceinline__ void dump_bf16(float* o, const bf16_t* p, size_t n, bool add, int gtid, int gthreads) {
    const size_t per = (n + (size_t)M * DM - 1) / ((size_t)M * DM);
    for (size_t i = gtid; i < (size_t)M * DM; i += gthreads) { float a = add ? o[i] : 0.f; for (size_t k = 0; k < per; ++k) { const size_t q = i * per + k; if (q < n) a += bf2f(p[q]); } o[i] = a; }
}
__device__ __forceinline__ void dump_f32(float* o, const float* p, size_t n, bool add, int gtid, int gthreads) {
    const size_t per = (n + (size_t)M * DM - 1) / ((size_t)M * DM);
    for (size_t i = gtid; i < (size_t)M * DM; i += gthreads) { float a = add ? o[i] : 0.f; for (size_t k = 0; k < per; ++k) { const size_t q = i * per + k; if (q < n) a += p[q]; } o[i] = a; }
}
#define STOP(ph, stmts) do { if (layer == STOP_LAYER && (ph) == STOP_PHASE) { KArgs ka = KA(); unsigned char* ws = ka->ws; float* o = ka->out; int tid_ = threadIdx.x; asm volatile("" : "+v"(tid_)); const int gt = bid * NTHREADS + tid_; (void)ws; (void)o; (void)gt; stmts; return; } } while (0)
#define DBF(ptr, n, add) dump_bf16(o, ptr, n, add, gt, gthreads)
#define DFF_(ptr, n, add) dump_f32(o, ptr, n, add, gt, gthreads)
#else
#define STOP(ph, stmts) do {} while (0)
#endif


#ifdef DIAG_BISECT
__device__ __forceinline__ void dg_bf16(const bf16_t* p, size_t n, unsigned code, unsigned* diag, int gtid, int gthreads, float lim = 1e6f) {
    bool bad = false;
    for (size_t i = (size_t)gtid * 8; i < n; i += (size_t)gthreads * 8) {
        const u32x4 w = *(const u32x4*)(p + i);
        const unsigned ws4[4] = {w.x, w.y, w.z, w.w};
#pragma unroll
        for (int k = 0; k < 4; ++k) { const float a = bflo(ws4[k]), b = bfhi(ws4[k]); if (!(fabsf(a) < lim) || !(fabsf(b) < lim)) bad = true; }
    }
    if (bad) atomicMin(diag, code * 10u);
}
__device__ __forceinline__ void dg_f32(const float* p, size_t n, unsigned code, unsigned* diag, int gtid, int gthreads, float lim = 1e8f) {
    bool bad = false;
    for (size_t i = (size_t)gtid; i < n; i += (size_t)gthreads) { if (!(fabsf(p[i]) < lim)) bad = true; }
    if (bad) atomicMin(diag, code * 10u);
}
__device__ __forceinline__ void dg_pos(const float* p, size_t n, unsigned code, unsigned* diag, int gtid, int gthreads) {
    bool bad = false;
    for (size_t i = (size_t)gtid; i < n; i += (size_t)gthreads) { if (p[i] > 1e-3f) bad = true; }
    if (bad) atomicMin(diag, code * 10u);
}
#define DG(stmts) do { KArgs ka = KA(); unsigned char* ws = ka->ws; unsigned* diag = (unsigned*)(ws + 32768); int tid_ = threadIdx.x; asm volatile("" : "+v"(tid_)); const int gt = bid * NTHREADS + tid_; (void)diag; (void)gt; stmts; } while (0)
#define DB(ptr, n, code) dg_bf16(ptr, n, code, diag, gt, gthreads)
#define DF(ptr, n, code) dg_f32(ptr, n, code, diag, gt, gthreads)
#else
#define DG(stmts) do {} while (0)
#endif

#define INF(k) ((const float*)ka->in[k])
#define WSP(T, off) ((T*)(ws + (off)))

__global__ void __launch_bounds__(NTHREADS, 2) trunk_fwd(Args args) {
    extern __shared__ __attribute__((aligned(16))) unsigned char lds_raw[];
    cg::grid_group grid = cg::this_grid();
    LAS unsigned char* lds = (LAS unsigned char*)lds_raw;
    const int G = gridDim.x, bid = blockIdx.x;
    const int vcu = (G % 8 == 0) ? (bid % 8) * (G / 8) + bid / 8 : bid;
    const int NGW = G * NWAVES, gthreads = G * NTHREADS;
    (void)args;
    volatile LAS unsigned* xmisc = (volatile LAS unsigned*)(lds + XMISC_OFF);
    if (threadIdx.x < 2) xmisc[threadIdx.x] = 0u;
    __syncthreads();
    XcdBarrier xbar;
    { KArgs ka0 = (KArgs)__builtin_amdgcn_kernarg_segment_ptr(); xbar = xcd_barrier_post((unsigned*)(ka0->ws + WS_BAR), xmisc); }

    {
        KArgs ka = KA(); unsigned char* ws = ka->ws;
        int tid = threadIdx.x; asm volatile("" : "+v"(tid));
        const int lane = tid & 63, wave = __builtin_amdgcn_readfirstlane(tid >> 6), gw = vcu * NWAVES + wave, gtid = bid * NTHREADS + tid;
        LAS float* scr = (LAS float*)(lds + wave * 17408);
        float* SSQ = WSP(float, WS_SSQ); float* LBT = WSP(float, WS_LBT); float* INVF = WSP(float, WS_INVF); bf16_t* XB = WSP(bf16_t, WS_XB);
        const float* x_in = INF(0); const float* hgrn_lbs = INF(5);
        for (int i = gtid; i < 2048; i += gthreads) {
            const int c = i & 1023;
            LBT[i] = (i < 1024) ? 0.f : 1.f / (1.f + __expf(hgrn_lbs[c] - hgrn_lbs[1024 + c]));
        }
#ifdef DIAG_BISECT
        if (gtid == 0) *(unsigned*)(ws + 32768) = 990u;
#endif
        if (gtid < 32) INVF[gtid] = exp2f(-(float)gtid * (13.287712379549449f / 32.0f));
        for (int m = gw; m < M; m += NGW) {
            const f32x4* xr = (const f32x4*)(x_in + (size_t)m * 1024) + lane;
            float s = 0.f; f32x4 v[4];
#pragma unroll
            for (int j = 0; j < 4; ++j) { v[j] = xr[64 * j]; s += (v[j][0] * v[j][0] + v[j][1] * v[j][1]) + (v[j][2] * v[j][2] + v[j][3] * v[j][3]); }
            s = wave_sum(s);
            u32x2* o8 = (u32x2*)(XB + (size_t)m * 1024) + lane;
#pragma unroll
            for (int j = 0; j < 4; ++j) { u32x2 w; w.x = pk2(v[j][0], v[j][1]); w.y = pk2(v[j][2], v[j][3]); o8[64 * j] = w; }
            if (lane < 4) SSQ[(size_t)lane * M + m] = (lane == 0) ? s : 0.f;
        }
        int rot = 0;
        for (int j = 0; j < 2; ++j) {
            cvt_job(INF(4) + (size_t)j * 1024 * 4096, 1024, 4096, INF(2) + (2 * j) * 1024, WSP(bf16_t, WS_WHIN) + (size_t)j * 4096 * 1024, 4096, 0, rot, gw, NGW, scr, lane);
            cvt_job(INF(7) + (size_t)j * 1024 * 1024, 1024, 1024, nullptr, WSP(bf16_t, WS_WHOUT) + (size_t)j * 1024 * 1024, 1024, 0, rot, gw, NGW, scr, lane);
            cvt_job(INF(8) + (size_t)j * 1024 * 576, 1024, 576, INF(2) + (2 * j + 1) * 1024, WSP(bf16_t, WS_WMIN) + (size_t)j * 768 * 1024, 576, 0, rot, gw, NGW, scr, lane);
            cvt_job(INF(10) + (size_t)j * 256 * 1536, 256, 1536, INF(9) + j * 256, WSP(bf16_t, WS_WQ) + (size_t)j * 1536 * 256, 1536, 0, rot, gw, NGW, scr, lane);
            cvt_job(INF(12) + (size_t)j * 256 * 2048, 256, 2048, INF(11) + j * 256, WSP(bf16_t, WS_WKN) + (size_t)j * 1024 * 256, 1024, 1, rot, gw, NGW, scr, lane);
            cvt_job(INF(12) + (size_t)j * 256 * 2048, 256, 2048, INF(11) + j * 256, WSP(bf16_t, WS_WV) + (size_t)j * 1024 * 256, 1024, 2, rot, gw, NGW, scr, lane);
            cvt_job(INF(15) + (size_t)j * 1024 * 1024, 1024, 1024, nullptr, WSP(bf16_t, WS_WMOUT) + (size_t)j * 1024 * 1024, 1024, 0, rot, gw, NGW, scr, lane);
        }
    }
    XSYNC();
    if (G == 0x7fffffff) GRID_SYNC();

    for (int layer = 0; layer < 4; ++layer) {
        const int j = layer >> 1;
        const unsigned cb_ = 20u * (unsigned)layer; (void)cb_;
        if (layer == 0) DG(DB(WSP(bf16_t, WS_XB), (size_t)M * 1024, 1); DF(WSP(float, WS_SSQ), (size_t)4 * M, 1); DB(WSP(bf16_t, WS_WHIN), (size_t)4096 * 1024, 1); DB(WSP(bf16_t, WS_WHOUT), (size_t)1024 * 1024, 1));
        if ((layer & 1) == 0) {
#ifndef SKIP_H1
            { KArgs ka = KA(); unsigned char* ws = ka->ws;
              epi::EpiHgrnIn E{WSP(float, WS_SSQ) + (size_t)(2 * layer) * 4 * M, WSP(float, WS_LBT) + j * 1024, WSP(bf16_t, WS_QH), WSP(bf16_t, WS_VH), WSP(bf16_t, WS_GH), WSP(float, WS_LF)};
              run_gemm(lds, WSP(bf16_t, WS_XB), 256, WSP(bf16_t, WS_WHIN) + (size_t)j * 4096 * 1024, 64, 16, 1024, G, bid, E); }
#endif
            XSYNC();
            STOP(1, DBF(WSP(bf16_t, WS_QH), (size_t)M * 1024, false); DBF(WSP(bf16_t, WS_VH), (size_t)M * 1024, true); DBF(WSP(bf16_t, WS_GH), (size_t)M * 1024, true); DFF_(WSP(float, WS_LF), (size_t)M * 1024, true));
            DG(dg_bf16(WSP(bf16_t, WS_QH), (size_t)M * 1024, cb_ + 2, diag, gt, gthreads, 100.f); dg_bf16(WSP(bf16_t, WS_VH), (size_t)M * 1024, cb_ + 2, diag, gt, gthreads, 100.f); dg_bf16(WSP(bf16_t, WS_GH), (size_t)M * 1024, cb_ + 2, diag, gt, gthreads, 100.f); dg_f32(WSP(float, WS_LF), (size_t)M * 1024, cb_ + 2, diag, gt, gthreads, 100.f); dg_pos(WSP(float, WS_LF), (size_t)M * 1024, cb_ + 3, diag, gt, gthreads));
#ifndef SKIP_H2
            { KArgs ka = KA(); unsigned char* ws = ka->ws; hgrn_local(lds, WSP(bf16_t, WS_VH), WSP(float, WS_LF), WSP(bf16_t, WS_ST), WSP(float, WS_DL), G, bid, (unsigned*)(ws + 32768)); }
#endif
            XSYNC();
            STOP(2, DBF(WSP(bf16_t, WS_ST), (size_t)16 * 128 * 16384 - 16384, false); DFF_(WSP(float, WS_DL), (size_t)16 * 128 * 128 - 128, true));
            DG(for (int q_ = 0; q_ < 16; ++q_) DB(WSP(bf16_t, WS_ST) + (size_t)q_ * 128 * 16384, (size_t)127 * 16384, cb_ + 5); DF(WSP(float, WS_DL), (size_t)16 * 128 * 128 - 128, cb_ + 4));
#ifndef SKIP_H3
            { KArgs ka = KA(); unsigned char* ws = ka->ws; int tid = threadIdx.x; asm volatile("" : "+v"(tid)); hgrn_scan(WSP(bf16_t, WS_ST), WSP(float, WS_DL), bid * NTHREADS + tid, gthreads); }
#endif
        } else {
#ifndef SKIP_M1
            { KArgs ka = KA(); unsigned char* ws = ka->ws;
              epi::EpiMlaIn E{WSP(float, WS_SSQ) + (size_t)(2 * layer) * 4 * M, WSP(bf16_t, WS_CQ), WSP(bf16_t, WS_CKV), WSP(float, WS_KR), WSP(float, WS_SSQCQ) + (size_t)j * M, WSP(float, WS_SSQCKV) + (size_t)j * M, WSP(float, WS_SSQKR) + (size_t)j * M, (LAS float*)(lds + HALO_OFF)};
              run_gemm(lds, WSP(bf16_t, WS_XB), 256, WSP(bf16_t, WS_WMIN) + (size_t)j * 768 * 1024, 64, 3, 1024, G, bid, E); }
#endif
            XSYNC();
            STOP(1, DBF(WSP(bf16_t, WS_CQ), (size_t)M * 256, false); DBF(WSP(bf16_t, WS_CKV), (size_t)M * 256, true); DFF_(WSP(float, WS_KR), (size_t)M * 64, true); DFF_(WSP(float, WS_SSQCQ) + (size_t)j * M, (size_t)4 * M, true));
            DG(DB(WSP(bf16_t, WS_CQ), (size_t)M * 256, cb_ + 2); DB(WSP(bf16_t, WS_CKV), (size_t)M * 256, cb_ + 2); DF(WSP(float, WS_KR), (size_t)M * 64, cb_ + 2); DF(WSP(float, WS_SSQCQ) + (size_t)j * M, (size_t)4 * M, cb_ + 2));
#ifndef SKIP_M2A
            { KArgs ka = KA(); unsigned char* ws = ka->ws;
              epi::EpiScale<true> E{WSP(float, WS_SSQCQ) + (size_t)j * M, 1.f / 256.f, WSP(bf16_t, WS_QF), 1536}; run_gemm(lds, WSP(bf16_t, WS_CQ), 256, WSP(bf16_t, WS_WQ) + (size_t)j * 1536 * 256, 64, 6, 256, G, bid, E); }
#endif
#ifndef SKIP_M2B
            { KArgs ka = KA(); unsigned char* ws = ka->ws;
              epi::EpiKFinal E{WSP(float, WS_SSQCKV) + (size_t)j * M, WSP(float, WS_SSQKR) + (size_t)j * M, WSP(float, WS_KR), (const int*)ka->in[1], WSP(float, WS_INVF), INF(14) + j * 192, WSP(bf16_t, WS_KF), (LAS float*)(lds + HALO_OFF)};
              run_gemm(lds, WSP(bf16_t, WS_CKV), 256, WSP(bf16_t, WS_WKN) + (size_t)j * 1024 * 256, 64, 4, 256, G, (bid + 128) % G, E); }
#endif
#ifndef SKIP_M2C
            { KArgs ka = KA(); unsigned char* ws = ka->ws;
              epi::EpiScale<false> E{WSP(float, WS_SSQCKV) + (size_t)j * M, 1.f / 256.f, WSP(bf16_t, WS_VT), M}; run_gemm(lds, WSP(bf16_t, WS_WV) + (size_t)j * 1024 * 256, 256, WSP(bf16_t, WS_CKV), 4, 64, 256, G, (bid + 128) % G, E); }
#endif
        }
        {
            KArgs ka = KA(); unsigned char* ws = ka->ws; int tid = threadIdx.x; asm volatile("" : "+v"(tid));
            const int wave = __builtin_amdgcn_readfirstlane(tid >> 6);
            LAS float* scr = (LAS float*)(lds + wave * 17408);
            __syncthreads();
            int rot = 0;
            cvt_job(INF(16) + (size_t)layer * 1024 * DFF2, 1024, DFF2, INF(3) + layer * 1024, WSP(bf16_t, WS_WUP), DFF2, 3, rot, vcu * NWAVES + wave, NGW, scr, tid & 63);
            cvt_job(INF(19) + (size_t)layer * DFF * 1024, DFF, 1024, nullptr, WSP(bf16_t, WS_WDN), 1024, 0, rot, vcu * NWAVES + wave, NGW, scr, tid & 63);
        }
        XSYNC();
        STOP(3, DBF(WSP(bf16_t, WS_WUP), (size_t)DFF2 * 1024, false); DBF(WSP(bf16_t, WS_WDN), (size_t)DFF * 1024, true); if ((layer & 1) == 0) { DBF(WSP(bf16_t, WS_ST), (size_t)16 * 128 * 16384 - 16384, true); } else { DBF(WSP(bf16_t, WS_QF), (size_t)M * 1536, true); DBF(WSP(bf16_t, WS_KF), (size_t)M * 1536, true); });
        DG(DB(WSP(bf16_t, WS_WUP), (size_t)DFF2 * 1024, cb_ + 6); DB(WSP(bf16_t, WS_WDN), (size_t)DFF * 1024, cb_ + 6);
           if ((layer & 1) == 0) { for (int q_ = 0; q_ < 16; ++q_) DB(WSP(bf16_t, WS_ST) + (size_t)q_ * 128 * 16384, (size_t)127 * 16384, cb_ + 7); } else { DB(WSP(bf16_t, WS_QF), (size_t)M * 1536, cb_ + 7); DB(WSP(bf16_t, WS_KF), (size_t)M * 1536, cb_ + 7); });
        if ((layer & 1) == 0) {
#ifndef SKIP_H4
            { KArgs ka = KA(); unsigned char* ws = ka->ws;
              hgrn_out(lds, WSP(bf16_t, WS_QH), WSP(bf16_t, WS_VH), WSP(bf16_t, WS_GH), WSP(float, WS_LF), WSP(bf16_t, WS_ST), INF(6) + j * 128, WSP(bf16_t, WS_QH), G, bid); }
#endif
            XSYNC();
            STOP(4, DBF(WSP(bf16_t, WS_QH), (size_t)M * 1024, false));
            DG(DB(WSP(bf16_t, WS_QH), (size_t)M * 1024, cb_ + 8));
#ifndef SKIP_H5
            { KArgs ka = KA(); unsigned char* ws = ka->ws;
              epi::EpiResid E{layer == 0 ? INF(0) : (const float*)ka->out, ka->out, WSP(bf16_t, WS_XB), WSP(float, WS_SSQ) + (size_t)(2 * layer + 1) * 4 * M, (LAS float*)(lds + HALO_OFF)};
              run_gemm(lds, WSP(bf16_t, WS_QH), 256, WSP(bf16_t, WS_WHOUT) + (size_t)j * 1024 * 1024, 64, 4, 1024, G, bid, E); }
#endif
        } else {
#ifndef SKIP_M4
            { KArgs ka = KA(); unsigned char* ws = ka->ws;
              for (int pu = vcu; pu < 256; pu += G) {
                  const int bh = pu >> 4, s = pu & 15;
                  attn_unit(lds, WSP(bf16_t, WS_QF), WSP(bf16_t, WS_KF), WSP(bf16_t, WS_VT), WSP(bf16_t, WS_KN), (const int*)ka->in[1], WSP(float, WS_INVF), INF(13) + j * 192, bh >> 3, bh & 7, 31 - s);
                  attn_unit(lds, WSP(bf16_t, WS_QF), WSP(bf16_t, WS_KF), WSP(bf16_t, WS_VT), WSP(bf16_t, WS_KN), (const int*)ka->in[1], WSP(float, WS_INVF), INF(13) + j * 192, bh >> 3, bh & 7, s);
              } }
#endif
            XSYNC();
            STOP(4, DBF(WSP(bf16_t, WS_KN), (size_t)M * 1024, false));
            DG(DB(WSP(bf16_t, WS_KN), (size_t)M * 1024, cb_ + 8));
#ifndef SKIP_M5
            { KArgs ka = KA(); unsigned char* ws = ka->ws;
              epi::EpiResid E{(const float*)ka->out, ka->out, WSP(bf16_t, WS_XB), WSP(float, WS_SSQ) + (size_t)(2 * layer + 1) * 4 * M, (LAS float*)(lds + HALO_OFF)};
              run_gemm(lds, WSP(bf16_t, WS_KN), 256, WSP(bf16_t, WS_WMOUT) + (size_t)j * 1024 * 1024, 64, 4, 1024, G, bid, E); }
#endif
        }
        XSYNC();
        STOP(5, DBF(WSP(bf16_t, WS_XB), (size_t)M * 1024, true); DFF_(WSP(float, WS_SSQ) + (size_t)(2 * layer + 1) * 4 * M, (size_t)4 * M, true));
        DG(DF(ka->out, (size_t)M * 1024, cb_ + 9); DB(WSP(bf16_t, WS_XB), (size_t)M * 1024, cb_ + 9); DF(WSP(float, WS_SSQ) + (size_t)(2 * layer + 1) * 4 * M, (size_t)4 * M, cb_ + 9));
#ifndef SKIP_F1
        { KArgs ka = KA(); unsigned char* ws = ka->ws;
          epi::EpiFfnUp E{WSP(float, WS_SSQ) + (size_t)(2 * layer + 1) * 4 * M, INF(17) + (size_t)layer * 3 * DFF2, INF(18) + (size_t)layer * DFF2, WSP(bf16_t, WS_HF), (LAS float*)(lds + HALO_OFF)};
          run_gemm(lds, WSP(bf16_t, WS_XB) - 2 * 1024, 254, WSP(bf16_t, WS_WUP), 65, 22, 1024, G, bid, E); }
#endif
        XSYNC();
        STOP(6, DBF(WSP(bf16_t, WS_HF), (size_t)M * DFF, false));
        DG(DB(WSP(bf16_t, WS_HF), (size_t)M * DFF, cb_ + 10));
#ifndef SKIP_F2
        { KArgs ka = KA(); unsigned char* ws = ka->ws;
          epi::EpiResid E{(const float*)ka->out, ka->out, (layer < 3) ? WSP(bf16_t, WS_XB) : nullptr, (layer < 3) ? WSP(float, WS_SSQ) + (size_t)(2 * layer + 2) * 4 * M : nullptr, (LAS float*)(lds + HALO_OFF)};
          run_gemm(lds, WSP(bf16_t, WS_HF), 256, WSP(bf16_t, WS_WDN), 64, 4, DFF, G, bid, E); }
#endif
        if (layer < 3) XSYNC();
        STOP(7, (void)0);
    }
#ifdef DIAG_BISECT
    XSYNC();
    DG(DF(ka->out, (size_t)M * 1024, 89));
    XSYNC();
    { KArgs ka = KA(); float* o = ka->out; int tid = threadIdx.x; asm volatile("" : "+v"(tid)); const unsigned dv = *(volatile unsigned*)(ka->ws + 32768);
      for (int i = bid * NTHREADS + tid; i < M * DM; i += gthreads) o[i] = (i == 0) ? 100.f * (float)dv : 0.f; }
#endif
#ifdef DIAG_SANITIZE
    XSYNC();
    { KArgs ka = KA(); float* o = ka->out; int tid = threadIdx.x; asm volatile("" : "+v"(tid));
      for (int i = bid * NTHREADS + tid; i < M * DM; i += gthreads) { const float v = o[i]; if (!(fabsf(v) < 1e30f)) o[i] = 1e30f; } }
#endif
}

extern "C" void kernel_launch(void* const* d_in, const int* in_sizes, int n_in, void* d_out, int out_size, void* d_ws, size_t ws_size, hipStream_t stream) {
    static int grid = 0;
    if (grid == 0) {
        if (n_in != 20 || out_size != M * DM || ws_size < WS_NEED) { fprintf(stderr, "kernel_launch: unexpected problem (n_in %d, out %d, ws %zu, need %zu)\n", n_in, out_size, ws_size, (size_t)WS_NEED); grid = -1; return; }
        int dev = 0, cus = 0, per_cu = 0;
        if (hipGetDevice(&dev) != hipSuccess || hipDeviceGetAttribute(&cus, hipDeviceAttributeMultiprocessorCount, dev) != hipSuccess) { grid = -1; return; }
        if (hipFuncSetAttribute((const void*)trunk_fwd, hipFuncAttributeMaxDynamicSharedMemorySize, LDS_BYTES) != hipSuccess) { fprintf(stderr, "kernel_launch: hipFuncSetAttribute failed\n"); grid = -1; return; }
        if (hipOccupancyMaxActiveBlocksPerMultiprocessor(&per_cu, (const void*)trunk_fwd, NTHREADS, LDS_BYTES) != hipSuccess || per_cu < 1) { fprintf(stderr, "kernel_launch: occupancy query failed (%d)\n", per_cu); (void)hipGetLastError(); per_cu = 1; }
        grid = cus * per_cu;
    }
    if (grid < 0) return;
    if (hipMemsetAsync((char*)d_ws + WS_BAR, 0, WS_BAR_BYTES, stream) != hipSuccess) { fprintf(stderr, "kernel_launch: memset of the barrier words failed\n"); return; }
    Args a{};
    for (int i = 0; i < 20; ++i) a.in[i] = d_in[i];
    a.out = (float*)d_out; a.ws = (unsigned char*)d_ws;
    void* kargs[] = {&a};
    hipError_t e = hipLaunchCooperativeKernel((const void*)trunk_fwd, dim3(grid), dim3(NTHREADS), kargs, LDS_BYTES, stream);
    if (e != hipSuccess) fprintf(stderr, "kernel_launch: cooperative launch failed: %s (grid %d)\n", hipGetErrorString(e), grid);
}
```

```cpp
#include <hip/hip_runtime.h>
#include <hip/hip_cooperative_groups.h>
#include <cstdio>
#include <cstdint>
namespace cg = cooperative_groups;
namespace pg8 {
#define PG8_LAS __attribute__((address_space(3)))
typedef unsigned short bf16_t;
typedef short bf16x8 __attribute__((ext_vector_type(8)));
typedef float f32x4 __attribute__((ext_vector_type(4)));
typedef unsigned u32x4 __attribute__((ext_vector_type(4)));
constexpr int BM = 256, BK = 64, HALF = 128, HTB = HALF * BK * 2  , STAGE_BYTES = 8 * HTB, NXCD = 8, WGM = 8;

__host__ __device__ __forceinline__ int lds_byte(int r, int c) { const int st = (r >> 4) * 2 + (c >> 5), rr = r & 15, cc = c & 31, ob = rr * 64 + cc * 2; return st * 1024 + (ob ^ (((ob >> 9) & 1) << 5)); }
__host__ __device__ __forceinline__ void stage_rc(int b, int& R, int& C) { const int st = b / 1024, sb = b % 1024, swz = sb ^ (((sb >> 9) & 1) << 5); R = (st >> 1) * 16 + swz / 64; C = (st & 1) * 32 + (swz % 64) / 2; }
__host__ __device__ __forceinline__ int perm32(int rho) { const int n = rho >> 4, i = rho & 15; return 8 * (i >> 2) + 4 * n + (i & 3); }

struct Unit { int pm, pn; };
struct Gemm { const bf16_t* A; const bf16_t* Bt; int M, N, K; int arows; };

struct StaticOrder {
    int nM, nN, nwg, G, c;
    __host__ __device__ void init(int M, int N, int G_, int c_) { nM = M / BM; nN = N / BM; nwg = nM * nN; G = G_; c = c_; }
    __host__ __device__ void init2(int nM_, int nN_, int G_, int c_) { nM = nM_; nN = nN_; nwg = nM * nN; G = G_; c = c_; }
    __host__ __device__ bool next(int i, Unit& u) const {
        const long L = (long)i * G + c; if (L >= nwg) return false;
        int wgid = (int)L; { const int q = nwg / NXCD, r = nwg % NXCD, xcd = wgid % NXCD, off = wgid / NXCD; wgid = (xcd < r ? xcd * (q + 1) : r * (q + 1) + (xcd - r) * q) + off; }
        const int nig = WGM * nN, gid = wgid / nig, fm = gid * WGM, gsz = (nM - fm) < WGM ? (nM - fm) : WGM;
        u.pm = fm + ((wgid % nig) % gsz); u.pn = (wgid % nig) / gsz; return true;
    }
    __device__ __forceinline__ void a_ready(const Unit&) const {}
    __device__ __forceinline__ void done(const Unit&) const {}
};

__device__ __forceinline__ unsigned cvt_pk_bf16(float lo, float hi) { unsigned r; asm volatile("v_cvt_pk_bf16_f32 %0, %1, %2" : "=v"(r) : "v"(lo), "v"(hi)); return r; }
typedef float f32x2 __attribute__((ext_vector_type(2)));
__device__ __forceinline__ f32x2 gelu_pk(f32x2 v) {
    const f32x2 av = __builtin_elementwise_abs(v), d = av * 0.2316418882f + 1.0f;
    f32x2 t; t.x = __builtin_amdgcn_rcpf(d.x); t.y = __builtin_amdgcn_rcpf(d.y);
    f32x2 q = t * 0.5307027145f + (-0.7265760135f); q = q * t + 0.7107068705f; q = q * t + (-0.142248368f); q = q * t + 0.127414796f; q = q * t;
    const f32x2 s = (v * v) * (-0.72134752044f);
    f32x2 e; e.x = __builtin_amdgcn_exp2f(s.x); e.y = __builtin_amdgcn_exp2f(s.y);
    const f32x2 m = v * (q * e), r = v - m;
    f32x2 o; o.x = v.x < 0.f ? m.x : r.x; o.y = v.y < 0.f ? m.y : r.y; return o;
}

template <int ACT  > struct EpiBf16 {
    static constexpr bool PERM = true, AFTER_DRAIN = false; static_assert(ACT == 0 || ACT == 1, "EpiBf16: ACT is 0 (none) or 1 (gelu_pk)");
    bf16_t* O; int ldc; const float* bias; int split_cols; size_t split_stride; float scale0;
    __device__ __forceinline__ void operator()(const f32x4 (&acc)[2][2][4][2], const Unit& u, int wr, int wc, int fr, int fq) const {
        const int row0 = u.pm * BM + wr * 64 + fr; int colt = u.pn * BM; bf16_t* base = O;
        float sc = 1.f; if (split_cols) { const int t = colt / split_cols; base += (size_t)t * split_stride; colt -= t * split_cols; if (t == 0) sc = scale0; }
        const int col0 = colt + wc * 32 + 8 * fq, bcol0 = u.pn * BM + wc * 32 + 8 * fq;
        f32x4 bv[2][2];
#pragma unroll
        for (int bj = 0; bj < 2; ++bj)
#pragma unroll
            for (int n = 0; n < 2; ++n) bv[bj][n] = bias ? *(const f32x4*)(bias + bcol0 + bj * HALF + 4 * n) : (f32x4){0.f, 0.f, 0.f, 0.f};
#pragma unroll
        for (int ai = 0; ai < 2; ++ai)
#pragma unroll
            for (int m = 0; m < 4; ++m) { bf16_t* rowp = base + (size_t)(row0 + ai * HALF + m * 16) * ldc + col0;
#pragma unroll
                for (int bj = 0; bj < 2; ++bj) { f32x4 v0 = acc[ai][bj][m][0] + bv[bj][0], v1 = acc[ai][bj][m][1] + bv[bj][1];
                    if (ACT == 1) { f32x2 a = gelu_pk((f32x2){v0[0], v0[1]}), b = gelu_pk((f32x2){v0[2], v0[3]}), c = gelu_pk((f32x2){v1[0], v1[1]}), d = gelu_pk((f32x2){v1[2], v1[3]});
                        v0 = (f32x4){a.x, a.y, b.x, b.y}; v1 = (f32x4){c.x, c.y, d.x, d.y}; }
                    v0 = v0 * sc; v1 = v1 * sc; u32x4 w; w.x = cvt_pk_bf16(v0[0], v0[1]); w.y = cvt_pk_bf16(v0[2], v0[3]); w.z = cvt_pk_bf16(v1[0], v1[1]); w.w = cvt_pk_bf16(v1[2], v1[3]);
                    *(u32x4*)(rowp + bj * HALF) = w; } }
    }
};

struct PanelStats {
    unsigned* xbuf;
    unsigned* cnt;
    unsigned* tmo;
    int ntn; float eps;
    unsigned code;
    __device__ __forceinline__ bool run(const f32x4 (&v)[2][2][4][2], const Unit& u, int wr, int wc, int fr, int fq, PG8_LAS unsigned char* lds, int wid, int lane) const {
        typedef float f32x2v __attribute__((ext_vector_type(2)));
        PG8_LAS f32x2v* P = (PG8_LAS f32x2v*)lds;
        PG8_LAS f32x2v* S = (PG8_LAS f32x2v*)(lds + 8192);
        PG8_LAS unsigned* flag = (PG8_LAS unsigned*)(lds + 8192 + 2048);
#pragma unroll
        for (int ai = 0; ai < 2; ++ai)
#pragma unroll
            for (int m = 0; m < 4; ++m) {
                float s = 0.f;
#pragma unroll
                for (int bj = 0; bj < 2; ++bj)
#pragma unroll
                    for (int n = 0; n < 2; ++n) { const f32x4 x = v[ai][bj][m][n]; s += (x[0] + x[1]) + (x[2] + x[3]); }
                s += __shfl_xor(s, 16); s += __shfl_xor(s, 32);
                const float mw = s * (1.0f / 64.0f); float q = 0.f;
#pragma unroll
                for (int bj = 0; bj < 2; ++bj)
#pragma unroll
                    for (int n = 0; n < 2; ++n) { const f32x4 d = v[ai][bj][m][n] - mw; q += (d[0] * d[0] + d[1] * d[1]) + (d[2] * d[2] + d[3] * d[3]); }
                q += __shfl_xor(q, 16); q += __shfl_xor(q, 32);
                if (fq == 0) P[(ai * HALF + wr * 64 + m * 16 + fr) * 4 + wc] = (f32x2v){mw, q};
            }
        asm volatile("s_waitcnt lgkmcnt(0)" ::: "memory"); __builtin_amdgcn_s_barrier(); asm volatile("" ::: "memory");
#if defined(BROKEN_EXCHANGE_NO_WAIT)
#warning BROKEN CONTROL BUILD: the row-statistics exchange does not wait; results are wrong by design
        if (blockIdx.x >= 64) { const long long t0_ = clock64(); while (clock64() - t0_ < 60000) __builtin_amdgcn_s_sleep(8); }
#endif
        const int row = wid * 32 + (lane & 31);
        if (lane < 32) {
            const f32x2v a = P[row * 4 + 0], b = P[row * 4 + 1], c = P[row * 4 + 2], d = P[row * 4 + 3];
            const float mt = (a.x + b.x + c.x + d.x) * 0.25f;
            const float da = a.x - mt, db = b.x - mt, dc = c.x - mt, dd = d.x - mt;
            const float m2 = (a.y + b.y) + (c.y + d.y) + 64.0f * ((da * da + db * db) + (dc * dc + dd * dd));
            unsigned long long* slot = (unsigned long long*)xbuf + ((size_t)(u.pm * BM + row) * 4 + u.pn);
            __hip_atomic_store(slot, ((unsigned long long)__float_as_uint(m2) << 32) | __float_as_uint(mt), __ATOMIC_RELAXED, __HIP_MEMORY_SCOPE_AGENT);
        }
        asm volatile("s_waitcnt vmcnt(0)" ::: "memory");
        if (lane == 0) __hip_atomic_fetch_add(cnt + 64 * u.pm, 1u, __ATOMIC_RELAXED, __HIP_MEMORY_SCOPE_AGENT);
        if (wid == 0) {
            bool dead = false; const unsigned long long t0 = __builtin_amdgcn_s_memrealtime(); const unsigned want = 8u * (unsigned)ntn;
            for (;;) {
#if defined(BROKEN_EXCHANGE_NO_WAIT)
                break;
#endif
                if ((unsigned)__builtin_amdgcn_readfirstlane(__hip_atomic_load(cnt + 64 * u.pm, __ATOMIC_RELAXED, __HIP_MEMORY_SCOPE_AGENT)) >= want) break;
                if (__builtin_amdgcn_s_memrealtime() - t0 > 2000000ull) {
                    if (lane == 0) { unsigned expect = 0u; __hip_atomic_compare_exchange_strong(tmo + 1, &expect, code | (unsigned)(u.pm & 0xff), __ATOMIC_RELAXED, __ATOMIC_RELAXED, __HIP_MEMORY_SCOPE_AGENT);
                                     __hip_atomic_store(tmo, 1u, __ATOMIC_RELAXED, __HIP_MEMORY_SCOPE_AGENT); }
                    dead = true; break; }
                __builtin_amdgcn_s_sleep(2);
            }
            __builtin_amdgcn_fence(__ATOMIC_ACQUIRE, "agent");
            if (lane == 0) flag[0] = dead ? 1u : 0u;
        }
        asm volatile("s_waitcnt vmcnt(0) lgkmcnt(0)" ::: "memory"); __builtin_amdgcn_s_barrier(); asm volatile("" ::: "memory");
        const bool bad = flag[0] != 0u;
        if (lane < 32) {
            const unsigned long long* slot = (const unsigned long long*)xbuf + (size_t)(u.pm * BM + row) * 4; float mt[4], m2[4]; float ms = 0.f;
#pragma unroll
            for (int t = 0; t < 4; ++t) { if (t < ntn) { const unsigned long long w = __hip_atomic_load(slot + t, __ATOMIC_RELAXED, __HIP_MEMORY_SCOPE_AGENT); mt[t] = __uint_as_float((unsigned)w); m2[t] = __uint_as_float((unsigned)(w >> 32)); } else { mt[t] = 0.f; m2[t] = 0.f; } ms += mt[t]; }
            const float mean = ms / (float)ntn; float q = 0.f;
#pragma unroll
            for (int t = 0; t < 4; ++t) if (t < ntn) { const float dm = mt[t] - mean; q += m2[t] + 256.0f * dm * dm; }
            S[row] = (f32x2v){mean, 1.0f / sqrtf(q / (256.0f * (float)ntn) + eps)};
        }
        asm volatile("s_waitcnt lgkmcnt(0)" ::: "memory"); __builtin_amdgcn_s_barrier(); asm volatile("" ::: "memory");
        return bad;
    }
};
struct EpiLnRes {
    static constexpr bool PERM = false, AFTER_DRAIN = true;
    const float* base; float* out; int ldc; const float* bias; PanelStats st; unsigned poison;
    __device__ __forceinline__ void fused(f32x4 (&acc)[2][2][4][2], const Unit& u, int wr, int wc, int fr, int fq, PG8_LAS unsigned char* lds, int wid, int lane) const {
        typedef float f32x2v __attribute__((ext_vector_type(2)));
        const PG8_LAS f32x2v* S = (const PG8_LAS f32x2v*)(lds + 8192);
        const int col0 = u.pn * BM + wc * 32 + 4 * fq;
#pragma unroll
        for (int bj = 0; bj < 2; ++bj)
#pragma unroll
            for (int n = 0; n < 2; ++n) { const f32x4 bv = bias ? *(const f32x4*)(bias + col0 + bj * HALF + n * 16) : (f32x4){0.f, 0.f, 0.f, 0.f};
#pragma unroll
                for (int ai = 0; ai < 2; ++ai)
#pragma unroll
                    for (int m = 0; m < 4; ++m) acc[ai][bj][m][n] += bv; }
        f32x4 pre[4][2][2];
#pragma unroll
        for (int m = 0; m < 4; ++m) { const size_t off = (size_t)(u.pm * BM + wr * 64 + m * 16 + fr) * ldc + col0;
#pragma unroll
            for (int bj = 0; bj < 2; ++bj)
#pragma unroll
                for (int n = 0; n < 2; ++n) pre[m][bj][n] = *(const f32x4*)(base + off + bj * HALF + n * 16); }
        const bool bad = st.run(acc, u, wr, wc, fr, fq, lds, wid, lane) || poison != 0u;
        const float qnan = __builtin_nanf("");
#pragma unroll
        for (int ai = 0; ai < 2; ++ai)
#pragma unroll
            for (int m = 0; m < 4; ++m) { const int r = ai * HALF + wr * 64 + m * 16 + fr; const f32x2v sr = S[r]; const size_t off = (size_t)(u.pm * BM + r) * ldc + col0;
#pragma unroll
                for (int bj = 0; bj < 2; ++bj)
#pragma unroll
                    for (int n = 0; n < 2; ++n) { const f32x4 bs = ai == 0 ? pre[m][bj][n] : *(const f32x4*)(base + off + bj * HALF + n * 16); f32x4 o = bs + (acc[ai][bj][m][n] - sr.x) * sr.y;
                        if (bad) o = (f32x4){qnan, qnan, qnan, qnan}; *(f32x4*)(out + off + bj * HALF + n * 16) = o; }
                if (m & 1) asm volatile("" ::: "memory"); }
    }
};
struct EpiLnResLn {
    static constexpr bool PERM = false, AFTER_DRAIN = true;
    const float* base; float* out; bf16_t* xn; int ldc; const float* bias; PanelStats st1, st2; unsigned poison;
    __device__ __forceinline__ void fused(f32x4 (&acc)[2][2][4][2], const Unit& u, int wr, int wc, int fr, int fq, PG8_LAS unsigned char* lds, int wid, int lane) const {
        typedef float f32x2v __attribute__((ext_vector_type(2))); typedef unsigned u32x2v __attribute__((ext_vector_type(2)));
        const PG8_LAS f32x2v* S = (const PG8_LAS f32x2v*)(lds + 8192);
        const int col0 = u.pn * BM + wc * 32 + 4 * fq;
#pragma unroll
        for (int bj = 0; bj < 2; ++bj)
#pragma unroll
            for (int n = 0; n < 2; ++n) { const f32x4 bv = bias ? *(const f32x4*)(bias + col0 + bj * HALF + n * 16) : (f32x4){0.f, 0.f, 0.f, 0.f};
#pragma unroll
                for (int ai = 0; ai < 2; ++ai)
#pragma unroll
                    for (int m = 0; m < 4; ++m) acc[ai][bj][m][n] += bv; }
        bool bad = st1.run(acc, u, wr, wc, fr, fq, lds, wid, lane) || poison != 0u;
        const float qnan = __builtin_nanf("");
#pragma unroll
        for (int ai = 0; ai < 2; ++ai)
#pragma unroll
            for (int m = 0; m < 4; ++m) { const int r = ai * HALF + wr * 64 + m * 16 + fr; const f32x2v sr = S[r]; const size_t off = (size_t)(u.pm * BM + r) * ldc + col0;
#pragma unroll
                for (int bj = 0; bj < 2; ++bj)
#pragma unroll
                    for (int n = 0; n < 2; ++n) { const f32x4 bs = *(const f32x4*)(base + off + bj * HALF + n * 16); acc[ai][bj][m][n] = bs + (acc[ai][bj][m][n] - sr.x) * sr.y; }
                asm volatile("" : "+v"(acc[ai][0][m][0]), "+v"(acc[ai][0][m][1]), "+v"(acc[ai][1][m][0]), "+v"(acc[ai][1][m][1]));
                if (m & 1) asm volatile("" ::: "memory"); }
        const bool bad1 = bad;
        bad = st2.run(acc, u, wr, wc, fr, fq, lds, wid, lane) || bad;
#pragma unroll
        for (int ai = 0; ai < 2; ++ai)
#pragma unroll
            for (int m = 0; m < 4; ++m) { const int r = ai * HALF + wr * 64 + m * 16 + fr; const f32x2v sr = S[r]; const size_t off = (size_t)(u.pm * BM + r) * ldc + col0;
#pragma unroll
                for (int bj = 0; bj < 2; ++bj)
#pragma unroll
                    for (int n = 0; n < 2; ++n) { const f32x4 x1 = acc[ai][bj][m][n]; *(f32x4*)(out + off + bj * HALF + n * 16) = bad1 ? (f32x4){qnan, qnan, qnan, qnan} : x1;
                        const f32x4 o = (x1 - sr.x) * sr.y; u32x2v w; w.x = cvt_pk_bf16(o[0], o[1]); w.y = cvt_pk_bf16(o[2], o[3]);
                        if (bad) { w.x = 0x7fc07fc0u; w.y = 0x7fc07fc0u; } *(u32x2v*)(xn + off + bj * HALF + n * 16) = w; }
                asm volatile("" ::: "memory"); }
    }
};

template <class Epi, class Sched, bool ALIGN_EPI = false, bool SP2 = false>
__device__ __forceinline__ void gemm_phase(PG8_LAS unsigned char* lds, const Gemm g, const Sched& S, const Epi& E) {
    int tid = threadIdx.x; asm volatile("" : "+v"(tid));
    const int wid = __builtin_amdgcn_readfirstlane(tid >> 6), lane = tid & 63, wr = wid >> 2, wc = wid & 3, fr = lane & 15, fq = lane >> 4;
    const int K = g.K, nt = K / BK;
    unsigned voffA[2], voffB[2];
#pragma unroll
    for (int i = 0; i < 2; ++i) { int R, C; stage_rc(tid * 16 + i * 8192, R, C); const int Rb = Epi::PERM ? ((R & ~31) + perm32(R & 31)) : R;
        voffA[i] = (unsigned)(R * K + C) * 2u; voffB[i] = (unsigned)(Rb * K + C) * 2u; }
    const size_t kstep = (size_t)(BK * 2);
    const size_t hstep = (size_t)HALF * K * 2;
    const size_t tstep = 2 * hstep;
    const size_t tstepA = (size_t)g.arows * K * 2;
    const unsigned lds_u32 = (unsigned)(__UINTPTR_TYPE__)lds;
    const unsigned ldsw = (unsigned)wid * 1024u;
    const int aoff = lds_byte(wr * 64 + fr, fq * 8), boff = lds_byte(wc * 32 + fr, fq * 8);
#define PG8_SA(b, h) (((b) * 2 + (h)) * HTB)
#define PG8_SB(b, h) ((4 + (b) * 2 + (h)) * HTB)
#define PG8_STAGE(bufoff, gbase, voff) do { _Pragma("unroll") for (int _i = 0; _i < 2; ++_i) { \
        const unsigned _m0 = lds_u32 + (unsigned)(bufoff) + ldsw + (unsigned)_i * 8192u; const char* _gb = (const char*)(gbase); \
        unsigned _keep; asm volatile("s_mov_b32 %0, m0\n\ts_mov_b32 m0, %1\n\ts_nop 0\n\tglobal_load_lds_dwordx4 %2, %3\n\ts_mov_b32 m0, %0" : "=&s"(_keep) : "s"(_m0), "v"((voff)[_i]), "s"(_gb) : "memory"); } } while (0)
#define PG8_LDA(dst, b, h) do { _Pragma("unroll") for (int m = 0; m < 4; ++m) _Pragma("unroll") for (int k = 0; k < 2; ++k) dst[m][k] = *(const PG8_LAS bf16x8*)(lds + PG8_SA(b, h) + aoff + m * 2048 + k * 1024); } while (0)
#define PG8_LDB(dst, b, h) do { _Pragma("unroll") for (int n = 0; n < 2; ++n) _Pragma("unroll") for (int k = 0; k < 2; ++k) dst[n][k] = *(const PG8_LAS bf16x8*)(lds + PG8_SB(b, h) + boff + n * 2048 + k * 1024); } while (0)
#define PG8_MMA(ai, bj, At, Bt) do { __builtin_amdgcn_s_setprio(1); _Pragma("unroll") for (int m = 0; m < 4; ++m) _Pragma("unroll") for (int n = 0; n < 2; ++n) _Pragma("unroll") for (int k = 0; k < 2; ++k) \
        acc[ai][bj][m][n] = __builtin_amdgcn_mfma_f32_16x16x32_bf16(Bt[n][k], At[m][k], acc[ai][bj][m][n], 0, 0, 0); __builtin_amdgcn_s_setprio(0); } while (0)
#define PG8_WAIT_V(n) asm volatile("s_waitcnt vmcnt(" #n ")" ::: "memory")
#define PG8_WAIT_L(n) asm volatile("s_waitcnt lgkmcnt(" #n ")" ::: "memory")
#define PG8_BAR __builtin_amdgcn_s_barrier()
#define PG8_SCHED __builtin_amdgcn_sched_barrier(0)
    Unit cur, nxt; int ui = 0;
    if (!S.next(0, cur)) return;
    f32x4 acc[2][2][4][2];
#pragma unroll
    for (int a = 0; a < 2; ++a)
#pragma unroll
        for (int b = 0; b < 2; ++b)
#pragma unroll
            for (int m = 0; m < 4; ++m)
#pragma unroll
                for (int n = 0; n < 2; ++n) acc[a][b][m][n] = (f32x4){0.f, 0.f, 0.f, 0.f};
    bf16x8 At[4][2], B0[2][2], B1[2][2];
    const char* cA = (const char*)g.A + (size_t)cur.pm * tstepA; const char* cB = (const char*)g.Bt + (size_t)cur.pn * tstep;
    S.a_ready(cur);
    if constexpr (SP2) {
        PG8_STAGE(PG8_SB(0, 0), cB, voffB); PG8_STAGE(PG8_SB(0, 1), cB + hstep, voffB); PG8_STAGE(PG8_SA(0, 0), cA, voffA); PG8_STAGE(PG8_SA(0, 1), cA + hstep, voffA);
        if (wr == 1) PG8_BAR;
        PG8_WAIT_V(2); PG8_BAR;
        PG8_STAGE(PG8_SB(1, 0), cB + kstep, voffB); PG8_STAGE(PG8_SA(1, 0), cA + kstep, voffA); PG8_STAGE(PG8_SB(1, 1), cB + hstep + kstep, voffB);
        PG8_WAIT_V(6); PG8_BAR;
    } else {
        PG8_STAGE(PG8_SB(0, 0), cB, voffB); PG8_STAGE(PG8_SA(0, 0), cA, voffA); PG8_STAGE(PG8_SB(0, 1), cB + hstep, voffB); PG8_STAGE(PG8_SA(0, 1), cA + hstep, voffA);
        if (wr == 1) PG8_BAR;
        PG8_WAIT_V(4); PG8_BAR;
        PG8_STAGE(PG8_SB(1, 0), cB + kstep, voffB); PG8_STAGE(PG8_SA(1, 0), cA + kstep, voffA); PG8_STAGE(PG8_SB(1, 1), cB + hstep + kstep, voffB);
        PG8_WAIT_V(6); PG8_BAR;
    }
    for (;;) {
        const bool has_next = S.next(ui + 1, nxt);
        const char* nA = has_next ? (const char*)g.A + (size_t)nxt.pm * tstepA : cA; const char* nB = has_next ? (const char*)g.Bt + (size_t)nxt.pn * tstep : cB;
        _Pragma("nounroll") for (int t = 0; t < nt; t += 2) {
            const bool last = (t == nt - 2);
            const char* a1 = cA + (size_t)(t + 1) * kstep;
            const char* a2 = last ? nA : cA + (size_t)(t + 2) * kstep; const char* b2 = last ? nB : cB + (size_t)(t + 2) * kstep;
            const char* a3 = a2 + kstep; const char* b3 = b2 + kstep;
            if (last && has_next) S.a_ready(nxt);
            if constexpr (SP2) {
            PG8_LDB(B0, 0, 0); PG8_LDB(B1, 0, 1); PG8_SCHED; PG8_LDA(At, 0, 0); PG8_STAGE(PG8_SA(1, 1), a1 + hstep, voffA);
            PG8_WAIT_V(8); PG8_WAIT_L(0); PG8_BAR; PG8_MMA(0, 0, At, B0); PG8_MMA(0, 1, At, B1); PG8_BAR; PG8_SCHED;
            PG8_LDA(At, 0, 1); PG8_STAGE(PG8_SB(0, 0), b2, voffB); PG8_STAGE(PG8_SB(0, 1), b2 + hstep, voffB); PG8_STAGE(PG8_SA(0, 0), a2, voffA);
            PG8_WAIT_V(8); PG8_WAIT_L(0); PG8_BAR; PG8_MMA(1, 0, At, B0); PG8_MMA(1, 1, At, B1); PG8_BAR; PG8_SCHED;
            PG8_LDB(B0, 1, 0); PG8_LDB(B1, 1, 1); PG8_SCHED; PG8_LDA(At, 1, 0); PG8_STAGE(PG8_SA(0, 1), a2 + hstep, voffA);
            PG8_WAIT_V(8); PG8_WAIT_L(0); PG8_BAR; PG8_MMA(0, 0, At, B0); PG8_MMA(0, 1, At, B1); PG8_BAR; PG8_SCHED;
            PG8_LDA(At, 1, 1); PG8_STAGE(PG8_SB(1, 0), b3, voffB); PG8_STAGE(PG8_SB(1, 1), b3 + hstep, voffB); PG8_STAGE(PG8_SA(1, 0), a3, voffA);
            PG8_WAIT_V(8); PG8_WAIT_L(0); PG8_BAR; PG8_MMA(1, 0, At, B0); PG8_MMA(1, 1, At, B1); PG8_BAR; PG8_SCHED;
            } else {
            PG8_LDB(B0, 0, 0); PG8_SCHED; PG8_LDA(At, 0, 0); PG8_STAGE(PG8_SA(1, 1), a1 + hstep, voffA);
            PG8_WAIT_L(8); PG8_BAR; PG8_WAIT_L(0); PG8_MMA(0, 0, At, B0); PG8_BAR; PG8_SCHED;
            PG8_LDB(B1, 0, 1); PG8_STAGE(PG8_SB(0, 0), b2, voffB);
            PG8_BAR; PG8_WAIT_L(0); PG8_MMA(0, 1, At, B1); PG8_BAR;
            PG8_LDA(At, 0, 1); PG8_STAGE(PG8_SA(0, 0), a2, voffA);
            PG8_BAR; PG8_WAIT_L(0); PG8_MMA(1, 0, At, B0); PG8_BAR; PG8_SCHED;
            PG8_STAGE(PG8_SB(0, 1), b2 + hstep, voffB);
            PG8_WAIT_V(6); PG8_BAR; PG8_MMA(1, 1, At, B1); PG8_BAR;
            PG8_LDB(B0, 1, 0); PG8_SCHED; PG8_LDA(At, 1, 0); PG8_STAGE(PG8_SA(0, 1), a2 + hstep, voffA);
            PG8_WAIT_L(8); PG8_BAR; PG8_WAIT_L(0); PG8_MMA(0, 0, At, B0); PG8_BAR; PG8_SCHED;
            PG8_LDB(B1, 1, 1); PG8_STAGE(PG8_SB(1, 0), b3, voffB);
            PG8_BAR; PG8_WAIT_L(0); PG8_MMA(0, 1, At, B1); PG8_BAR;
            PG8_LDA(At, 1, 1); PG8_STAGE(PG8_SA(1, 0), a3, voffA);
            PG8_BAR; PG8_WAIT_L(0); PG8_MMA(1, 0, At, B0); PG8_BAR; PG8_SCHED;
            PG8_STAGE(PG8_SB(1, 1), b3 + hstep, voffB);
            PG8_WAIT_V(6); PG8_BAR; PG8_MMA(1, 1, At, B1); PG8_BAR;
            }
        }
        if constexpr (ALIGN_EPI) { if (wr == 0) PG8_BAR; }
        if constexpr (!Epi::AFTER_DRAIN) { E(acc, cur, wr, wc, fr, fq); S.done(cur); }
        if (!has_next) break;
#pragma unroll
        for (int a = 0; a < 2; ++a)
#pragma unroll
            for (int b = 0; b < 2; ++b)
#pragma unroll
                for (int m = 0; m < 4; ++m)
#pragma unroll
                    for (int n = 0; n < 2; ++n) acc[a][b][m][n] = (f32x4){0.f, 0.f, 0.f, 0.f};
        cur = nxt; cA = nA; cB = nB; ++ui;
        if constexpr (ALIGN_EPI) { if (wr == 1) PG8_BAR; }
    }
    PG8_WAIT_V(0);
    if constexpr (!ALIGN_EPI) { if (wr == 0) PG8_BAR; }
    PG8_BAR;
    if constexpr (Epi::AFTER_DRAIN) { E.fused(acc, cur, wr, wc, fr, fq, lds, wid, lane); S.done(cur); }
#undef PG8_SA
#undef PG8_SB
#undef PG8_STAGE
#undef PG8_LDA
#undef PG8_LDB
#undef PG8_MMA
#undef PG8_WAIT_V
#undef PG8_WAIT_L
#undef PG8_BAR
#undef PG8_SCHED
}
}

#define LAS __attribute__((address_space(3)))
using pg8::bf16_t; using pg8::f32x4; using pg8::u32x4; using pg8::bf16x8; using pg8::Unit;
typedef float f32x16 __attribute__((ext_vector_type(16)));
typedef unsigned u32x2 __attribute__((ext_vector_type(2)));

constexpr int M = 16384, SEQ = 8192, DM = 1024, DFF = 2816, DFF2 = 5632;
constexpr float EPS = 1e-6f;
constexpr int NTHREADS = 512, NWAVES = 8;
constexpr int LDS_BYTES = 147456;
constexpr int HALO_OFF = 131072;
constexpr int XMISC_OFF = 131072 + 12288;
constexpr float QSCALE = 0.07216878364870323f * 1.4426950408889634f;

constexpr size_t MiB = 1u << 20;
constexpr size_t WS_LBT = 0;
constexpr size_t WS_INVF = 16384;
constexpr size_t WS_BAR = 32768, WS_BAR_BYTES = 16384;
constexpr size_t WS_WHIN = 2 * MiB;
constexpr size_t WS_WHOUT = 18 * MiB;
constexpr size_t WS_WMIN = 22 * MiB;
constexpr size_t WS_WQ = 25 * MiB;
constexpr size_t WS_WKN = 27 * MiB;
constexpr size_t WS_WV = 28 * MiB;
constexpr size_t WS_WMOUT = 29 * MiB;
constexpr size_t WS_WUP = 33 * MiB;
constexpr size_t WS_WDN = 44 * MiB;
constexpr size_t WS_XB = 50 * MiB + 65536;
constexpr size_t WS_R = 83 * MiB;
constexpr size_t WS_QH = WS_R, WS_VH = WS_R + 32 * MiB, WS_GH = WS_R + 64 * MiB, WS_LF = WS_R + 96 * MiB, WS_ST = WS_R + 160 * MiB, WS_DL = WS_R + 224 * MiB;
constexpr size_t WS_CQ = WS_R, WS_CKV = WS_R + 8 * MiB, WS_KR = WS_R + 16 * MiB, WS_QF = WS_R + 20 * MiB, WS_KN = WS_R + 68 * MiB, WS_VT = WS_R + 100 * MiB, WS_KF = WS_R + 132 * MiB;
constexpr size_t WS_HF = WS_R;
constexpr size_t WS_SSQ = WS_R + 226 * MiB;
constexpr size_t WS_SSQCQ = WS_SSQ + 9 * 16 * (size_t)M * 4;
constexpr size_t WS_SSQCKV = WS_SSQCQ + 2 * 4 * (size_t)M * 4;
constexpr size_t WS_SSQKR = WS_SSQCKV + 2 * (size_t)M * 4;
constexpr size_t WS_NEED = WS_R + 238 * MiB;
static_assert(WS_SSQCKV + 2 * 4 * (size_t)M * 4 <= WS_NEED && WS_SSQCKV == WS_SSQCQ + 8 * (size_t)M * 4 && WS_SSQKR == WS_SSQCQ + 10 * (size_t)M * 4, "ws map");

struct Args { const void* in[20]; float* out; unsigned char* ws; };

__device__ __forceinline__ float bf2f(unsigned v) { return __uint_as_float(v << 16); }
__device__ __forceinline__ float bflo(unsigned w) { return __uint_as_float(w << 16); }
__device__ __forceinline__ float bfhi(unsigned w) { return __uint_as_float(w & 0xffff0000u); }
typedef float f32x2_t __attribute__((ext_vector_type(2))); typedef __bf16 bf16x2_t __attribute__((ext_vector_type(2)));
__device__ __forceinline__ unsigned pk2c(float lo, float hi) { f32x2_t v = {lo, hi}; bf16x2_t b = __builtin_convertvector(v, bf16x2_t); return __builtin_bit_cast(unsigned, b); }
__device__ __forceinline__ unsigned pk2(float lo, float hi) { return pk2c(lo, hi); }
__device__ __forceinline__ u32x4 pack8(const f32x4& a, const f32x4& b) { u32x4 w; w.x = pk2(a[0], a[1]); w.y = pk2(a[2], a[3]); w.z = pk2(b[0], b[1]); w.w = pk2(b[2], b[3]); return w; }
__device__ __forceinline__ float sigm_f(float x) { return __builtin_amdgcn_rcpf(1.f + __expf(-x)); }
__device__ __forceinline__ float silu_f(float x) { return x * sigm_f(x); }
__device__ __forceinline__ float wave_sum(float v) {
#pragma unroll
    for (int o = 1; o < 64; o <<= 1) v += __shfl_xor(v, o);
    return v;
}
#define LDS_WAIT() asm volatile("s_waitcnt lgkmcnt(0)" ::: "memory")
template <int NS> __device__ __forceinline__ float ssq_sum(const float* p, int r) {
    float s = 0.f;
#pragma unroll
    for (int k = 0; k < NS; ++k) s += p[(size_t)k * M + r];
    return s;
}

__device__ __forceinline__ void rope_cs(float ang, float& c, float& s) {
    const float n = rintf(ang * 0.15915494309189535f);
    float r = fmaf(-n, 6.2831855f, ang); r = fmaf(-n, -1.7484555e-7f, r);
    c = __cosf(r); s = __sinf(r);
}
namespace epi {
using namespace pg8;

__device__ __forceinline__ void wg_row_ssq(LAS float* part, const float (&ss)[2][4], int wr, int wc, int fr, int fq, float* dst, int rowbase) {
    if (fq == 0) {
#pragma unroll
        for (int ai = 0; ai < 2; ++ai)
#pragma unroll
            for (int m = 0; m < 4; ++m) part[(ai * 128 + wr * 64 + m * 16 + fr) * 4 + wc] = ss[ai][m];
    }
    asm volatile("s_waitcnt lgkmcnt(0)" ::: "memory"); __builtin_amdgcn_s_barrier(); asm volatile("" ::: "memory");
    if (wc == 0 && fq == 0) {
#pragma unroll
        for (int ai = 0; ai < 2; ++ai)
#pragma unroll
            for (int m = 0; m < 4; ++m) { const int row = ai * 128 + wr * 64 + m * 16 + fr; const f32x4 v = *(const LAS f32x4*)(part + row * 4); dst[rowbase + row] = (v[0] + v[1]) + (v[2] + v[3]); }
    }
}

struct EpiResid {
    static constexpr bool PERM = true, AFTER_DRAIN = false;
    const float* xin; float* xout; bf16_t* xb; float* ssq; LAS float* part;
    __device__ __forceinline__ void operator()(f32x4 (&acc)[2][2][4][2], const Unit& u, int wr, int wc, int fr, int fq) const {
        int row0 = u.pm * 256 + wr * 64 + fr, col0 = u.pn * 256 + wc * 32 + 8 * fq;
        asm volatile("" : "+v"(row0), "+v"(col0));
        float ssv[2][4];
#pragma unroll
        for (int ai = 0; ai < 2; ++ai)
#pragma unroll
            for (int m = 0; m < 4; ++m) {
                const int r = row0 + ai * 128 + m * 16; float ss = 0.f;
#pragma unroll
                for (int bj = 0; bj < 2; ++bj) {
                    const size_t off = (size_t)r * 1024 + col0 + bj * 128;
                    f32x4 a = *(const f32x4*)(xin + off), b = *(const f32x4*)(xin + off + 4);
                    a += acc[ai][bj][m][0]; b += acc[ai][bj][m][1];
                    *(f32x4*)(xout + off) = a; *(f32x4*)(xout + off + 4) = b;
                    ss += ((a[0] * a[0] + a[1] * a[1]) + (a[2] * a[2] + a[3] * a[3])) + ((b[0] * b[0] + b[1] * b[1]) + (b[2] * b[2] + b[3] * b[3]));
                    if (xb) *(u32x4*)(xb + off) = pack8(a, b);
                }
                ss += __shfl_xor(ss, 16); ss += __shfl_xor(ss, 32); ssv[ai][m] = ss;
                if (m & 1) asm volatile("" ::: "memory");
            }
        if (ssq) wg_row_ssq(part, ssv, wr, wc, fr, fq, ssq + (size_t)u.pn * M, u.pm * 256);
    }
};

struct EpiHgrnIn {
    static constexpr bool PERM = true, AFTER_DRAIN = false;
    const float* ssq; const float* lb; bf16_t* Q; bf16_t* V; bf16_t* G; float* LF;
    __device__ __forceinline__ void operator()(f32x4 (&acc)[2][2][4][2], const Unit& u, int wr, int wc, int fr, int fq) const {
        const int sec = u.pn >> 2;
        int row0 = u.pm * 256 + wr * 64 + fr, c0 = (u.pn & 3) * 256 + wc * 32 + 8 * fq;
        asm volatile("" : "+v"(row0), "+v"(c0));
        f32x4 l0[2], l1[2];
#pragma unroll
        for (int bj = 0; bj < 2; ++bj) { l0[bj] = *(const f32x4*)(lb + c0 + bj * 128); l1[bj] = *(const f32x4*)(lb + c0 + bj * 128 + 4); }
#pragma unroll
        for (int ai = 0; ai < 2; ++ai)
#pragma unroll
            for (int m = 0; m < 4; ++m) {
                const int r = row0 + ai * 128 + m * 16; const float rs = rsqrtf(ssq_sum<4>(ssq, r) * (1.f / 1024.f) + EPS);
#pragma unroll
                for (int bj = 0; bj < 2; ++bj) {
                    const size_t off = (size_t)r * 1024 + c0 + bj * 128;
                    f32x4 a = acc[ai][bj][m][0] * rs, b = acc[ai][bj][m][1] * rs;
                    if (sec == 1) {
#pragma unroll
                        for (int j = 0; j < 4; ++j) {
                            const float sa = sigm_f(a[j]), sb = sigm_f(b[j]);
                            a[j] = __logf(l0[bj][j] + (1.f - l0[bj][j]) * sa); b[j] = __logf(l1[bj][j] + (1.f - l1[bj][j]) * sb);
                        }
                        *(f32x4*)(LF + off) = a; *(f32x4*)(LF + off + 4) = b;
                    } else if (sec == 2) {
                        *(u32x4*)(V + off) = pack8(a, b);
                    } else {
#pragma unroll
                        for (int j = 0; j < 4; ++j) { a[j] = silu_f(a[j]); b[j] = silu_f(b[j]); }
                        *(u32x4*)((sec == 0 ? Q : G) + off) = pack8(a, b);
                    }
                }
            }
    }
};

struct EpiMlaIn {
    static constexpr bool PERM = true, AFTER_DRAIN = false;
    const float* ssq; bf16_t* CQ; bf16_t* CKV; float* KR; float* ssq_cq; float* ssq_ckv; float* ssq_kr; LAS float* part;
    __device__ __forceinline__ void operator()(f32x4 (&acc)[2][2][4][2], const Unit& u, int wr, int wc, int fr, int fq) const {
        int row0 = u.pm * 256 + wr * 64 + fr, cl = wc * 32 + 8 * fq;
        asm volatile("" : "+v"(row0), "+v"(cl));
        float ssv[2][4];
#pragma unroll
        for (int ai = 0; ai < 2; ++ai)
#pragma unroll
            for (int m = 0; m < 4; ++m) {
                const int r = row0 + ai * 128 + m * 16; const float rs = rsqrtf(ssq_sum<4>(ssq, r) * (1.f / 1024.f) + EPS);
                ssv[ai][m] = 0.f;
                if (u.pn < 2) {
                    bf16_t* dst = u.pn == 0 ? CQ : CKV; float ss = 0.f;
#pragma unroll
                    for (int bj = 0; bj < 2; ++bj) {
                        const f32x4 a = acc[ai][bj][m][0] * rs, b = acc[ai][bj][m][1] * rs;
                        ss += ((a[0] * a[0] + a[1] * a[1]) + (a[2] * a[2] + a[3] * a[3])) + ((b[0] * b[0] + b[1] * b[1]) + (b[2] * b[2] + b[3] * b[3]));
                        *(u32x4*)(dst + (size_t)r * 256 + cl + bj * 128) = pack8(a, b);
                    }
                    ss += __shfl_xor(ss, 16); ss += __shfl_xor(ss, 32); ssv[ai][m] = ss;
                } else if (cl < 64) {
                    const f32x4 a = acc[ai][0][m][0] * rs, b = acc[ai][0][m][1] * rs;
                    *(f32x4*)(KR + (size_t)r * 64 + cl) = a; *(f32x4*)(KR + (size_t)r * 64 + cl + 4) = b;
                    float ss = ((a[0] * a[0] + a[1] * a[1]) + (a[2] * a[2] + a[3] * a[3])) + ((b[0] * b[0] + b[1] * b[1]) + (b[2] * b[2] + b[3] * b[3]));
                    ss += __shfl_xor(ss, 16); ss += __shfl_xor(ss, 32); ssv[ai][m] = ss;
                }
            }
        wg_row_ssq(part, ssv, wr, wc, fr, fq, ssq_cq + (u.pn == 0 ? 0 : (u.pn == 1 ? 8 * M : 10 * M)), u.pm * 256);
    }
};

struct EpiKFinal {
    static constexpr bool PERM = true, AFTER_DRAIN = false;
    const float* ssq_ckv; const float* ssq_kr; const float* KR; const int* pos; const float* invf; const float* kg; bf16_t* KF; LAS float* part;
    __device__ __forceinline__ void operator()(f32x4 (&acc)[2][2][4][2], const Unit& u, int wr, int wc, int fr, int fq) const {
        int row0 = u.pm * 256 + wr * 64 + fr, cl = wc * 32 + 8 * fq;
        asm volatile("" : "+v"(row0), "+v"(cl));
#pragma unroll
        for (int ai = 0; ai < 2; ++ai)
#pragma unroll
            for (int m = 0; m < 4; ++m) {
                const int r = row0 + ai * 128 + m * 16; const float rs = rsqrtf(ssq_ckv[r] * (1.f / 256.f) + EPS);
#pragma unroll
                for (int bj = 0; bj < 2; ++bj) {
                    acc[ai][bj][m][0] *= rs; acc[ai][bj][m][1] *= rs;
                    const f32x4 a = acc[ai][bj][m][0], b = acc[ai][bj][m][1];
                    float ss = ((a[0] * a[0] + a[1] * a[1]) + (a[2] * a[2] + a[3] * a[3])) + ((b[0] * b[0] + b[1] * b[1]) + (b[2] * b[2] + b[3] * b[3]));
                    ss += __shfl_xor(ss, 16); ss += __shfl_xor(ss, 32);
                    if (fq == 0) part[((ai * 128 + wr * 64 + m * 16 + fr) * 2 + bj) * 4 + wc] = ss;
                }
            }
        asm volatile("s_waitcnt lgkmcnt(0)" ::: "memory"); __builtin_amdgcn_s_barrier(); asm volatile("" ::: "memory");
        const int i0 = 2 * (4 * wc + fq);
        const f32x4 g0 = *(const f32x4*)(kg + cl), g1 = *(const f32x4*)(kg + cl + 4);
        const float ga0 = kg[128 + i0], ga1 = kg[129 + i0], gb0 = kg[160 + i0], gb1 = kg[161 + i0], f0 = invf[i0], f1 = invf[i0 + 1];
#pragma unroll
        for (int ai = 0; ai < 2; ++ai)
#pragma unroll
            for (int m = 0; m < 4; ++m) {
                const int rl = ai * 128 + wr * 64 + m * 16 + fr, r = u.pm * 256 + rl;
                const float skr = ssq_kr[r]; const float pf = (float)pos[r];
                const f32x2_t x1 = *(const f32x2_t*)(KR + (size_t)r * 64 + i0), x2 = *(const f32x2_t*)(KR + (size_t)r * 64 + 32 + i0);
                float c0, s0, c1, s1; rope_cs(pf * f0, c0, s0); rope_cs(pf * f1, c1, s1);
#pragma unroll
                for (int bj = 0; bj < 2; ++bj) {
                    const f32x4 v = *(const LAS f32x4*)(part + (rl * 2 + bj) * 4);
                    const float rstd = rsqrtf((((v[0] + v[1]) + (v[2] + v[3])) + skr) * (1.f / 192.f) + EPS);
                    bf16_t* kp = KF + (size_t)r * 1536 + (2 * u.pn + bj) * 192;
                    const f32x4 a = acc[ai][bj][m][0] * rstd * g0, b = acc[ai][bj][m][1] * rstd * g1;
                    *(u32x4*)(kp + cl) = pack8(a, b);
                    const float y10 = x1.x * rstd * ga0, y11 = x1.y * rstd * ga1, y20 = x2.x * rstd * gb0, y21 = x2.y * rstd * gb1;
                    *(unsigned*)(kp + 128 + i0) = pk2(y10 * c0 - y20 * s0, y11 * c1 - y21 * s1);
                    *(unsigned*)(kp + 160 + i0) = pk2(y20 * c0 + y10 * s0, y21 * c1 + y11 * s1);
                }
            }
    }
};

template <bool ROW> struct EpiScale {
    static constexpr bool PERM = true, AFTER_DRAIN = false;
    const float* ssq; float inv_n; bf16_t* O; int ldc;
    __device__ __forceinline__ void operator()(f32x4 (&acc)[2][2][4][2], const Unit& u, int wr, int wc, int fr, int fq) const {
        int row0 = u.pm * 256 + wr * 64 + fr, col0 = u.pn * 256 + wc * 32 + 8 * fq;
        asm volatile("" : "+v"(row0), "+v"(col0));
        f32x4 c0[2], c1[2];
#pragma unroll
        for (int bj = 0; bj < 2; ++bj) {
            if (!ROW) {
                const f32x4 s0 = *(const f32x4*)(ssq + col0 + bj * 128), s1 = *(const f32x4*)(ssq + col0 + bj * 128 + 4);
#pragma unroll
                for (int j = 0; j < 4; ++j) { c0[bj][j] = rsqrtf(s0[j] * inv_n + EPS); c1[bj][j] = rsqrtf(s1[j] * inv_n + EPS); }
            } else { c0[bj] = (f32x4){1.f, 1.f, 1.f, 1.f}; c1[bj] = c0[bj]; }
        }
#pragma unroll
        for (int ai = 0; ai < 2; ++ai)
#pragma unroll
            for (int m = 0; m < 4; ++m) {
                const int r = row0 + ai * 128 + m * 16; const float rs = ROW ? rsqrtf(ssq[r] * inv_n + EPS) : 1.f;
#pragma unroll
                for (int bj = 0; bj < 2; ++bj) {
                    const f32x4 a = acc[ai][bj][m][0] * rs * c0[bj], b = acc[ai][bj][m][1] * rs * c1[bj];
                    *(u32x4*)(O + (size_t)r * ldc + col0 + bj * 128) = pack8(a, b);
                }
            }
    }
};

template <int CTRL> __device__ __forceinline__ float dpp_mov(float old, float src) {
    return __builtin_bit_cast(float, __builtin_amdgcn_update_dpp(__builtin_bit_cast(int, old), __builtin_bit_cast(int, src), CTRL, 0xf, 0xf, false));
}

struct EpiFfnUp {
    static constexpr bool PERM = true, AFTER_DRAIN = false;
    const float* ssq; const float* cw; const float* cb; bf16_t* HF; LAS float* halo;
    __device__ __forceinline__ void operator()(f32x4 (&acc)[2][2][4][2], const Unit& u, int wr, int wc, int fr, int fq) const {
        int gr0 = u.pm * 254 - 2 + wr * 64 + fr;
        int cl = wc * 32 + 8 * fq;
        asm volatile("" : "+v"(gr0), "+v"(cl));
#pragma unroll
        for (int ai = 0; ai < 2; ++ai)
#pragma unroll
            for (int m = 0; m < 4; ++m) {
                const int gr = gr0 + ai * 128 + m * 16;
                const bool vr = (gr >= 0 && gr < M);
                const float rs = rsqrtf(ssq_sum<4>(ssq, vr ? gr : 0) * (1.f / 1024.f) + EPS);
#pragma unroll
                for (int bj = 0; bj < 2; ++bj)
#pragma unroll
                    for (int n = 0; n < 2; ++n) acc[ai][bj][m][n] = vr ? acc[ai][bj][m][n] * rs : (f32x4){0.f, 0.f, 0.f, 0.f};
                asm volatile("" ::: "memory");
            }
        if (fr >= 14) {
#pragma unroll
            for (int ai = 0; ai < 2; ++ai)
#pragma unroll
                for (int bj = 0; bj < 2; ++bj)
#pragma unroll
                    for (int n = 0; n < 2; ++n) *(LAS f32x4*)(halo + (((2 * ai + wr) * 2 + (fr - 14)) * 256 + bj * 128 + cl + 4 * n)) = acc[ai][bj][3][n];
        }
        asm volatile("s_waitcnt lgkmcnt(0)" ::: "memory"); __builtin_amdgcn_s_barrier(); asm volatile("" ::: "memory");
        const int ch = u.pn * 128 + cl;
#pragma unroll
        for (int n = 0; n < 2; ++n) {
            f32x4 w0[2], w1[2], w2[2], bb[2];
#pragma unroll
            for (int bj = 0; bj < 2; ++bj) {
                const int ci = bj * DFF + ch + 4 * n;
                w0[bj] = *(const f32x4*)(cw + ci); w1[bj] = *(const f32x4*)(cw + DFF2 + ci); w2[bj] = *(const f32x4*)(cw + 2 * DFF2 + ci); bb[bj] = *(const f32x4*)(cb + ci);
            }
#pragma unroll
            for (int ai = 0; ai < 2; ++ai) {
                asm volatile("" : "+v"(gr0));
                const int g = 2 * ai + wr;
                f32x4 pm[2];
#pragma unroll
                for (int bj = 0; bj < 2; ++bj) {
                    pm[bj] = (f32x4){0.f, 0.f, 0.f, 0.f};
                    if (g > 0 && fr >= 14) pm[bj] = *(const LAS f32x4*)(halo + ((((g - 1) * 2) + (fr - 14)) * 256 + bj * 128 + cl + 4 * n));
                }
#pragma unroll
                for (int m = 0; m < 4; ++m) {
                    const int gr = gr0 + ai * 128 + m * 16; const int t = gr & (SEQ - 1);
                    const float k1 = (t >= 1) ? 1.f : 0.f, k2 = (t >= 2) ? 1.f : 0.f;
                    f32x4 y[2];
#pragma unroll
                    for (int bj = 0; bj < 2; ++bj)
#pragma unroll
                        for (int j = 0; j < 4; ++j) {
                            const float cur = acc[ai][bj][m][n][j], pv = pm[bj][j];
                            const float p1 = dpp_mov<0x111>(dpp_mov<0x121>(0.f, pv), cur);
                            const float p2 = dpp_mov<0x112>(dpp_mov<0x122>(0.f, pv), cur);
                            y[bj][j] = bb[bj][j] + w0[bj][j] * (k2 != 0.f ? p2 : 0.f) + w1[bj][j] * (k1 != 0.f ? p1 : 0.f) + w2[bj][j] * cur;
                        }
                    f32x4 h0;
#pragma unroll
                    for (int j = 0; j < 4; ++j) h0[j] = silu_f(y[0][j]) * y[1][j];
                    const bool owned = !(ai == 0 && wr == 0 && m == 0 && fr < 2) && gr < M;
                    if (owned) { u32x2 w; w.x = pk2(h0[0], h0[1]); w.y = pk2(h0[2], h0[3]); *(u32x2*)(HF + (size_t)gr * DFF + ch + 4 * n) = w; }
#pragma unroll
                    for (int bj = 0; bj < 2; ++bj) pm[bj] = acc[ai][bj][m][n];
                    if (m & 1) asm volatile("" ::: "memory");
                }
            }
        }
    }
};
}

__device__ __forceinline__ void cvt_item(const float* W, int ldn, int scol0, int k0, const float* gain, bf16_t* WT, int K, int drow0, LAS float* scr, int lane) {
#pragma unroll 8
    for (int i = 0; i < 32; ++i) {
        const int kk = 2 * i + (lane >> 5);
        float v = W[(size_t)(k0 + kk) * ldn + scol0 + (lane & 31)];
        if (gain) v *= gain[k0 + kk];
        scr[kk * 33 + (lane & 31)] = v;
    }
    LDS_WAIT(); asm volatile("" ::: "memory");
    const int c = lane & 7;
#pragma unroll
    for (int j = 0; j < 4; ++j) {
        const int n = (lane >> 3) + 8 * j; const LAS float* s = scr + (8 * c) * 33 + n;
        u32x4 o; o.x = pk2(s[0 * 33], s[1 * 33]); o.y = pk2(s[2 * 33], s[3 * 33]); o.z = pk2(s[4 * 33], s[5 * 33]); o.w = pk2(s[6 * 33], s[7 * 33]);
        *(u32x4*)(WT + (size_t)(drow0 + n) * K + k0 + 8 * c) = o;
    }
    LDS_WAIT(); asm volatile("" ::: "memory");
}
__device__ __forceinline__ int cvt_map(int map, int drow0) {
    if (map == 1) return (drow0 >> 7) * 256 + (drow0 & 127);
    if (map == 2) return (drow0 >> 7) * 256 + 128 + (drow0 & 127);
    if (map == 3) return ((drow0 >> 7) & 1) * DFF + (drow0 >> 8) * 128 + (drow0 & 127);
    return drow0;
}
__device__ __forceinline__ void cvt_item2(const float* W, int ldn, int scolA, int kA, int scolB, int kB, bool hasB, const float* gain, bf16_t* WT, int K, int drowA, int drowB, LAS float* scr, int lane) {
    LAS float* scrB = scr + 64 * 33;
    float va[32], vb[32];
#pragma unroll
    for (int i = 0; i < 32; ++i) { const int kk = 2 * i + (lane >> 5); va[i] = W[(size_t)(kA + kk) * ldn + scolA + (lane & 31)]; }
    if (hasB) {
#pragma unroll
        for (int i = 0; i < 32; ++i) { const int kk = 2 * i + (lane >> 5); vb[i] = W[(size_t)(kB + kk) * ldn + scolB + (lane & 31)]; }
    }
#pragma unroll
    for (int i = 0; i < 32; ++i) { const int kk = 2 * i + (lane >> 5); float v = va[i]; if (gain) v *= gain[kA + kk]; scr[kk * 33 + (lane & 31)] = v; }
    if (hasB) {
#pragma unroll
        for (int i = 0; i < 32; ++i) { const int kk = 2 * i + (lane >> 5); float v = vb[i]; if (gain) v *= gain[kB + kk]; scrB[kk * 33 + (lane & 31)] = v; }
    }
    LDS_WAIT(); asm volatile("" ::: "memory");
    const int c = lane & 7;
#pragma unroll
    for (int j = 0; j < 4; ++j) {
        const int n = (lane >> 3) + 8 * j; const LAS float* s = scr + (8 * c) * 33 + n;
        u32x4 o; o.x = pk2(s[0 * 33], s[1 * 33]); o.y = pk2(s[2 * 33], s[3 * 33]); o.z = pk2(s[4 * 33], s[5 * 33]); o.w = pk2(s[6 * 33], s[7 * 33]);
        *(u32x4*)(WT + (size_t)(drowA + n) * K + kA + 8 * c) = o;
    }
    if (hasB) {
#pragma unroll
        for (int j = 0; j < 4; ++j) {
            const int n = (lane >> 3) + 8 * j; const LAS float* s = scrB + (8 * c) * 33 + n;
            u32x4 o; o.x = pk2(s[0 * 33], s[1 * 33]); o.y = pk2(s[2 * 33], s[3 * 33]); o.z = pk2(s[4 * 33], s[5 * 33]); o.w = pk2(s[6 * 33], s[7 * 33]);
            *(u32x4*)(WT + (size_t)(drowB + n) * K + kB + 8 * c) = o;
        }
    }
    LDS_WAIT(); asm volatile("" ::: "memory");
}
__device__ __forceinline__ void cvt_job(const float* W, int K, int ldn, const float* gain, bf16_t* WT, int nrows, int map, int& rot, int gw, int NGW, LAS float* scr, int lane) {
    const int nb = nrows / 32, nitems = (K / 64) * nb;
    int start = gw - (rot % NGW); if (start < 0) start += NGW;
    for (int it = start; it < nitems; it += 2 * NGW) {
        const int it2 = it + NGW; const bool hasB = it2 < nitems; const int itb = hasB ? it2 : it;
        const int kbA = it / nb, bA = it % nb, kbB = itb / nb, bB = itb % nb;
        cvt_item2(W, ldn, cvt_map(map, 32 * bA), 64 * kbA, cvt_map(map, 32 * bB), 64 * kbB, hasB, gain, WT, K, 32 * bA, 32 * bB, scr, lane);
    }
    rot += nitems;
}

__device__ __forceinline__ void hgrn_local(LAS unsigned char* lds, const bf16_t* V, const float* LF, bf16_t* ST, float* DL, int G, int bid, unsigned* dgp = nullptr) {
    int tid = threadIdx.x; asm volatile("" : "+v"(tid));
    const int lane = tid & 63, wid = __builtin_amdgcn_readfirstlane(tid >> 6);
    LAS bf16_t* KdT = (LAS bf16_t*)lds;
    LAS bf16_t* VT = (LAS bf16_t*)(lds + 18432);
    LAS float* tot = (LAS float*)(lds + 36864);
    const int d = tid & 127, part = tid >> 7, l15 = lane & 15, q4 = lane >> 4;
    for (int unit = bid; unit < 16 * 127; unit += G) {
        const int bh = unit / 127, n = unit % 127, b = bh >> 3, h = bh & 7;
        const size_t row0 = (size_t)b * SEQ + n * 64 + part * 16;
        const float* lfp = LF + row0 * 1024 + h * 128 + d;
        const bf16_t* vp = V + row0 * 1024 + h * 128 + d;
        float g[16], kk[16]; unsigned vv[16];
#pragma unroll
        for (int j = 0; j < 16; ++j) { g[j] = lfp[(size_t)j * 1024]; vv[j] = vp[(size_t)j * 1024]; }
        float run = 0.f;
#pragma unroll
        for (int j = 0; j < 16; ++j) { kk[j] = 1.f - __expf(g[j]); run += g[j]; g[j] = run; }
        tot[part * 128 + d] = run;
        __syncthreads();
        const float t0 = tot[d], t1 = tot[128 + d], t2 = tot[256 + d], t3 = tot[384 + d];
        const float off = part == 0 ? 0.f : (part == 1 ? t0 : (part == 2 ? t0 + t1 : t0 + t1 + t2));
        const float gl = (t0 + t1) + (t2 + t3);
#pragma unroll
        for (int j = 0; j < 16; ++j) kk[j] *= __expf(gl - (off + g[j]));
#ifdef DIAG_SUBCHK
        { bool bk = false, bv = false;
#pragma unroll
          for (int j = 0; j < 16; ++j) { if (!(fabsf(kk[j]) < 1.01f)) bk = true; if (!(fabsf(bf2f(vv[j])) < 100.f)) bv = true; }
          if (bk) atomicMin(dgp, 51u); if (bv) atomicMin(dgp, 52u); }
#endif
        u32x4 w0, w1, x0, x1;
        w0.x = pk2(kk[0], kk[1]); w0.y = pk2(kk[2], kk[3]); w0.z = pk2(kk[4], kk[5]); w0.w = pk2(kk[6], kk[7]);
        w1.x = pk2(kk[8], kk[9]); w1.y = pk2(kk[10], kk[11]); w1.z = pk2(kk[12], kk[13]); w1.w = pk2(kk[14], kk[15]);
        x0.x = vv[0] | (vv[1] << 16); x0.y = vv[2] | (vv[3] << 16); x0.z = vv[4] | (vv[5] << 16); x0.w = vv[6] | (vv[7] << 16);
        x1.x = vv[8] | (vv[9] << 16); x1.y = vv[10] | (vv[11] << 16); x1.z = vv[12] | (vv[13] << 16); x1.w = vv[14] | (vv[15] << 16);
        *(LAS u32x4*)(KdT + d * 72 + part * 16) = w0; *(LAS u32x4*)(KdT + d * 72 + part * 16 + 8) = w1;
        *(LAS u32x4*)(VT + d * 72 + part * 16) = x0; *(LAS u32x4*)(VT + d * 72 + part * 16 + 8) = x1;
        if (part == 0) DL[(size_t)(bh * 128 + n) * 128 + d] = __expf(gl);
        __syncthreads();
        bf16x8 af[2];
#pragma unroll
        for (int ks = 0; ks < 2; ++ks) af[ks] = *(const LAS bf16x8*)(KdT + (16 * wid + l15) * 72 + 32 * ks + 8 * q4);
        bf16_t* dst = ST + (size_t)(bh * 128 + n) * 16384;
#pragma unroll
        for (int et = 0; et < 8; ++et) {
            f32x4 c = {0.f, 0.f, 0.f, 0.f};
#pragma unroll
            for (int ks = 0; ks < 2; ++ks) {
                const bf16x8 bfr = *(const LAS bf16x8*)(VT + (16 * et + l15) * 72 + 32 * ks + 8 * q4);
                c = __builtin_amdgcn_mfma_f32_16x16x32_bf16(af[ks], bfr, c, 0, 0, 0);
            }
#ifdef DIAG_SUBCHK
            { bool bc = false;
#pragma unroll
              for (int r = 0; r < 4; ++r) if (!(fabsf(c[r]) < 1e5f)) bc = true;
              if (bc) atomicMin(dgp, 53u); }
#endif
            u32x2 o; o.x = pk2c(c[0], c[1]); o.y = pk2c(c[2], c[3]);
            *(u32x2*)(dst + (size_t)(16 * et + l15) * 128 + 16 * wid + 4 * q4) = o;
        }
    }
}

__device__ __forceinline__ void hgrn_scan(bf16_t* ST, const float* DL, int gtid, int gthreads) {
    for (int item = gtid; item < 16 * 8192; item += gthreads) {
        const int bh = item >> 13, idx = (item & 8191) * 2, d = idx & 127;
        float s0 = 0.f, s1 = 0.f;
        unsigned* p = (unsigned*)(ST + (size_t)bh * 128 * 16384 + idx);
        const float* dl = DL + (size_t)bh * 128 * 128 + d;
        unsigned w[8], wn[8]; f32x2_t dd[8], dn[8];
#pragma unroll
        for (int i = 0; i < 8; ++i) { w[i] = p[(size_t)i * 8192]; dd[i] = *(const f32x2_t*)(dl + i * 128); }
#pragma unroll 1
        for (int n0 = 0; n0 < 120; n0 += 8) {
            const int m0 = n0 + 8;
#pragma unroll
            for (int i = 0; i < 8; ++i) { const int m = (m0 + i < 127) ? m0 + i : 126; wn[i] = p[(size_t)m * 8192]; dn[i] = *(const f32x2_t*)(dl + m * 128); }
            asm volatile("" ::: "memory");
#pragma unroll
            for (int i = 0; i < 8; ++i) { s0 = s0 * dd[i].x + bflo(w[i]); s1 = s1 * dd[i].y + bfhi(w[i]); p[(size_t)(n0 + i) * 8192] = pk2(s0, s1); }
#pragma unroll
            for (int i = 0; i < 8; ++i) { w[i] = wn[i]; dd[i] = dn[i]; }
        }
#pragma unroll
        for (int i = 0; i < 7; ++i) { s0 = s0 * dd[i].x + bflo(w[i]); s1 = s1 * dd[i].y + bfhi(w[i]); p[(size_t)(120 + i) * 8192] = pk2(s0, s1); }
    }
}

__device__ __forceinline__ void hgrn_out(LAS unsigned char* lds, const bf16_t* Q, const bf16_t* V, const bf16_t* Gt, const float* LF, const bf16_t* ST, const float* onorm, bf16_t* OH, int G, int bid) {
    int tid = threadIdx.x; asm volatile("" : "+v"(tid));
    const int lane = tid & 63, wid = __builtin_amdgcn_readfirstlane(tid >> 6);
    LAS bf16_t* QtS = (LAS bf16_t*)lds;
    LAS bf16_t* KtS = (LAS bf16_t*)(lds + 17408);
    LAS bf16_t* VT = (LAS bf16_t*)(lds + 34816);
    LAS bf16_t* STs = (LAS bf16_t*)(lds + 53248);
    LAS float* tot = (LAS float*)(lds + 88064);
    LAS float* eg = (LAS float*)(lds + 90112);
    LAS float* red = (LAS float*)(lds + 90624);
    const int d = tid & 127, part = tid >> 7, l15 = lane & 15, q4 = lane >> 4;
    const int tb = wid & 3, eh = wid >> 2;
    float rg[16]; unsigned rv[16], rq[16]; u32x4 rs[4];
#define HO_LOAD(unit_) do { const int bh_ = (unit_) >> 7, n_ = (unit_) & 127; const size_t c0_ = ((size_t)(bh_ >> 3) * SEQ + n_ * 64 + part * 16) * 1024 + (bh_ & 7) * 128 + d; \
        _Pragma("unroll") for (int j = 0; j < 16; ++j) { rg[j] = LF[c0_ + (size_t)j * 1024]; rv[j] = V[c0_ + (size_t)j * 1024]; rq[j] = Q[c0_ + (size_t)j * 1024]; } \
        if (n_ > 0) { const bf16_t* stp_ = ST + (size_t)(bh_ * 128 + n_ - 1) * 16384; _Pragma("unroll") for (int i = 0; i < 4; ++i) { const int p_ = tid + 512 * i; rs[i] = *(const u32x4*)(stp_ + (size_t)(p_ >> 4) * 128 + (p_ & 15) * 8); } } } while (0)
    if (bid < 16 * 128) HO_LOAD(bid);
    for (int unit = bid; unit < 16 * 128; unit += G) {
        const int bh = unit >> 7, n = unit & 127, b = bh >> 3, h = bh & 7;
        float g[16], kk[16], qq[16]; unsigned vv[16]; u32x4 sreg[4];
#pragma unroll
        for (int j = 0; j < 16; ++j) { g[j] = rg[j]; vv[j] = rv[j]; qq[j] = bf2f(rq[j]); }
#pragma unroll
        for (int i = 0; i < 4; ++i) sreg[i] = rs[i];
        if (unit + G < 16 * 128) HO_LOAD(unit + G);
        float run = 0.f;
#pragma unroll
        for (int j = 0; j < 16; ++j) { kk[j] = 1.f - __expf(g[j]); run += g[j]; g[j] = run; }
        tot[part * 128 + d] = run;
        __syncthreads();
        const float t0 = tot[d], t1 = tot[128 + d], t2 = tot[256 + d];
        const float off = part == 0 ? 0.f : (part == 1 ? t0 : (part == 2 ? t0 + t1 : t0 + t1 + t2));
        const float gref = t0 + t1;
#pragma unroll
        for (int j = 0; j < 16; ++j) {
            const float gs = off + g[j];
            QtS[(part * 16 + j) * 136 + d] = (bf16_t)(pk2(qq[j] * __expf(gs - gref), 0.f) & 0xffffu);
            KtS[(part * 16 + j) * 136 + d] = (bf16_t)(pk2(kk[j] * __expf(gref - gs), 0.f) & 0xffffu);
        }
        u32x4 x0, x1;
        x0.x = vv[0] | (vv[1] << 16); x0.y = vv[2] | (vv[3] << 16); x0.z = vv[4] | (vv[5] << 16); x0.w = vv[6] | (vv[7] << 16);
        x1.x = vv[8] | (vv[9] << 16); x1.y = vv[10] | (vv[11] << 16); x1.z = vv[12] | (vv[13] << 16); x1.w = vv[14] | (vv[15] << 16);
        *(LAS u32x4*)(VT + d * 72 + part * 16) = x0; *(LAS u32x4*)(VT + d * 72 + part * 16 + 8) = x1;
        if (part == 0) eg[d] = __expf(gref);
        __syncthreads();
        if (n > 0) {
#pragma unroll
            for (int i = 0; i < 4; ++i) {
                const int p = tid + 512 * i, e = p >> 4, c8 = (p & 15) * 8;
                const f32x4 ea = *(const LAS f32x4*)(eg + c8), eb = *(const LAS f32x4*)(eg + c8 + 4);
                u32x4 w = sreg[i], o;
                o.x = pk2(bflo(w.x) * ea[0], bfhi(w.x) * ea[1]); o.y = pk2(bflo(w.y) * ea[2], bfhi(w.y) * ea[3]);
                o.z = pk2(bflo(w.z) * eb[0], bfhi(w.z) * eb[1]); o.w = pk2(bflo(w.w) * eb[2], bfhi(w.w) * eb[3]);
                *(LAS u32x4*)(STs + e * 136 + c8) = o;
            }
        }
        __syncthreads();
        bf16x8 qfr[4];
#pragma unroll
        for (int k4 = 0; k4 < 4; ++k4) qfr[k4] = *(const LAS bf16x8*)(QtS + (16 * tb + l15) * 136 + 32 * k4 + 8 * q4);
        f32x4 sc[4];
#pragma unroll
        for (int si = 0; si < 4; ++si) {
            sc[si] = (f32x4){0.f, 0.f, 0.f, 0.f};
            if (si <= tb) {
#pragma unroll
                for (int k4 = 0; k4 < 4; ++k4) {
                    const bf16x8 kf = *(const LAS bf16x8*)(KtS + (16 * si + l15) * 136 + 32 * k4 + 8 * q4);
                    sc[si] = __builtin_amdgcn_mfma_f32_16x16x32_bf16(kf, qfr[k4], sc[si], 0, 0, 0);
                }
            }
#pragma unroll
            for (int r = 0; r < 4; ++r) if (!(16 * si + 4 * q4 + r <= 16 * tb + l15)) sc[si][r] = 0.f;
        }
        bf16x8 pf[2];
#pragma unroll
        for (int ks = 0; ks < 2; ++ks) {
            u32x4 w; w.x = pk2(sc[2 * ks][0], sc[2 * ks][1]); w.y = pk2(sc[2 * ks][2], sc[2 * ks][3]); w.z = pk2(sc[2 * ks + 1][0], sc[2 * ks + 1][1]); w.w = pk2(sc[2 * ks + 1][2], sc[2 * ks + 1][3]);
            pf[ks] = __builtin_bit_cast(bf16x8, w);
        }
        f32x4 oa[4]; float ss = 0.f;
#pragma unroll
        for (int et = 0; et < 4; ++et) {
            const int erow = 64 * eh + 16 * et + l15;
            oa[et] = (f32x4){0.f, 0.f, 0.f, 0.f};
#pragma unroll
            for (int ks = 0; ks < 2; ++ks) {
                if (ks == 0 || tb >= 2) {
                    const u32x2 lo = *(const LAS u32x2*)(VT + erow * 72 + 32 * ks + 4 * q4), hi = *(const LAS u32x2*)(VT + erow * 72 + 32 * ks + 16 + 4 * q4);
                    const u32x4 w = {lo.x, lo.y, hi.x, hi.y};
                    oa[et] = __builtin_amdgcn_mfma_f32_16x16x32_bf16(__builtin_bit_cast(bf16x8, w), pf[ks], oa[et], 0, 0, 0);
                }
            }
            if (n > 0) {
#pragma unroll
                for (int k4 = 0; k4 < 4; ++k4) {
                    const bf16x8 sf = *(const LAS bf16x8*)(STs + erow * 136 + 32 * k4 + 8 * q4);
                    oa[et] = __builtin_amdgcn_mfma_f32_16x16x32_bf16(sf, qfr[k4], oa[et], 0, 0, 0);
                }
            }
            ss += (oa[et][0] * oa[et][0] + oa[et][1] * oa[et][1]) + (oa[et][2] * oa[et][2] + oa[et][3] * oa[et][3]);
        }
        ss += __shfl_xor(ss, 16); ss += __shfl_xor(ss, 32);
        if (q4 == 0) red[(16 * tb + l15) * 2 + eh] = ss;
        __syncthreads();
        const float tss = red[(16 * tb + l15) * 2] + red[(16 * tb + l15) * 2 + 1];
        const float rstd = rsqrtf(tss * (1.f / 128.f) + EPS);
        const size_t orow = (size_t)b * SEQ + n * 64 + 16 * tb + l15;
#pragma unroll
        for (int et = 0; et < 4; ++et) {
            const int e0 = 64 * eh + 16 * et + 4 * q4;
            const f32x4 gn = *(const f32x4*)(onorm + e0);
            const u32x2 gt = *(const u32x2*)(Gt + orow * 1024 + h * 128 + e0);
            u32x2 o;
            o.x = pk2(oa[et][0] * rstd * gn[0] * bflo(gt.x), oa[et][1] * rstd * gn[1] * bfhi(gt.x));
            o.y = pk2(oa[et][2] * rstd * gn[2] * bflo(gt.y), oa[et][3] * rstd * gn[3] * bfhi(gt.y));
            *(u32x2*)(OH + orow * 1024 + h * 128 + e0) = o;
        }
    }
#undef HO_LOAD
}

__device__ __forceinline__ void mla_finalize(bf16_t* QF, const bf16_t* KN, const float* KR, bf16_t* KF, const int* pos, const float* invf, const float* qg, const float* kg, int gw, int NGW, int lane) {
    const int hd = lane >> 3, sub = lane & 7;
    float gq[16], gk[16], gq1[4], gq2[4], gk1[4], gk2[4], fr[4];
#pragma unroll
    for (int e = 0; e < 16; ++e) { gq[e] = qg[16 * sub + e]; gk[e] = kg[16 * sub + e]; }
#pragma unroll
    for (int j = 0; j < 4; ++j) { gq1[j] = qg[128 + 4 * sub + j]; gq2[j] = qg[160 + 4 * sub + j]; gk1[j] = kg[128 + 4 * sub + j]; gk2[j] = kg[160 + 4 * sub + j]; fr[j] = invf[4 * sub + j]; }
    for (int row = gw; row < M; row += NGW) {
        const float pf = (float)pos[row];
        float cs[4], sn[4];
#pragma unroll
        for (int j = 0; j < 4; ++j) rope_cs(pf * fr[j], cs[j], sn[j]);
        {
            bf16_t* qp = QF + (size_t)row * 1536 + hd * 192;
            const u32x4 a = *(const u32x4*)(qp + 16 * sub), b2 = *(const u32x4*)(qp + 16 * sub + 8);
            const u32x2 r1 = *(const u32x2*)(qp + 128 + 4 * sub), r2 = *(const u32x2*)(qp + 160 + 4 * sub);
            float xn[16], x1[4], x2[4];
            xn[0] = bflo(a.x); xn[1] = bfhi(a.x); xn[2] = bflo(a.y); xn[3] = bfhi(a.y); xn[4] = bflo(a.z); xn[5] = bfhi(a.z); xn[6] = bflo(a.w); xn[7] = bfhi(a.w);
            xn[8] = bflo(b2.x); xn[9] = bfhi(b2.x); xn[10] = bflo(b2.y); xn[11] = bfhi(b2.y); xn[12] = bflo(b2.z); xn[13] = bfhi(b2.z); xn[14] = bflo(b2.w); xn[15] = bfhi(b2.w);
            x1[0] = bflo(r1.x); x1[1] = bfhi(r1.x); x1[2] = bflo(r1.y); x1[3] = bfhi(r1.y);
            x2[0] = bflo(r2.x); x2[1] = bfhi(r2.x); x2[2] = bflo(r2.y); x2[3] = bfhi(r2.y);
            float ss = 0.f;
#pragma unroll
            for (int e = 0; e < 16; ++e) ss += xn[e] * xn[e];
#pragma unroll
            for (int j = 0; j < 4; ++j) ss += x1[j] * x1[j] + x2[j] * x2[j];
            ss += __shfl_xor(ss, 1); ss += __shfl_xor(ss, 2); ss += __shfl_xor(ss, 4);
            const float rs = rsqrtf(ss * (1.f / 192.f) + EPS) * QSCALE;
#pragma unroll
            for (int e = 0; e < 16; ++e) xn[e] *= rs * gq[e];
            float o1[4], o2[4];
#pragma unroll
            for (int j = 0; j < 4; ++j) { const float y1 = x1[j] * rs * gq1[j], y2 = x2[j] * rs * gq2[j]; o1[j] = y1 * cs[j] - y2 * sn[j]; o2[j] = y2 * cs[j] + y1 * sn[j]; }
            u32x4 wa, wb; u32x2 w1, w2;
            wa.x = pk2(xn[0], xn[1]); wa.y = pk2(xn[2], xn[3]); wa.z = pk2(xn[4], xn[5]); wa.w = pk2(xn[6], xn[7]);
            wb.x = pk2(xn[8], xn[9]); wb.y = pk2(xn[10], xn[11]); wb.z = pk2(xn[12], xn[13]); wb.w = pk2(xn[14], xn[15]);
            w1.x = pk2(o1[0], o1[1]); w1.y = pk2(o1[2], o1[3]); w2.x = pk2(o2[0], o2[1]); w2.y = pk2(o2[2], o2[3]);
            *(u32x4*)(qp + 16 * sub) = wa; *(u32x4*)(qp + 16 * sub + 8) = wb; *(u32x2*)(qp + 128 + 4 * sub) = w1; *(u32x2*)(qp + 160 + 4 * sub) = w2;
        }
        {
            const bf16_t* kp = KN + (size_t)row * 1024 + hd * 128;
            const u32x4 a = *(const u32x4*)(kp + 16 * sub), b2 = *(const u32x4*)(kp + 16 * sub + 8);
            const f32x4 r1 = *(const f32x4*)(KR + (size_t)row * 64 + 4 * sub), r2 = *(const f32x4*)(KR + (size_t)row * 64 + 32 + 4 * sub);
            float xn[16];
            xn[0] = bflo(a.x); xn[1] = bfhi(a.x); xn[2] = bflo(a.y); xn[3] = bfhi(a.y); xn[4] = bflo(a.z); xn[5] = bfhi(a.z); xn[6] = bflo(a.w); xn[7] = bfhi(a.w);
            xn[8] = bflo(b2.x); xn[9] = bfhi(b2.x); xn[10] = bflo(b2.y); xn[11] = bfhi(b2.y); xn[12] = bflo(b2.z); xn[13] = bfhi(b2.z); xn[14] = bflo(b2.w); xn[15] = bfhi(b2.w);
            float ss = 0.f;
#pragma unroll
            for (int e = 0; e < 16; ++e) ss += xn[e] * xn[e];
#pragma unroll
            for (int j = 0; j < 4; ++j) ss += r1[j] * r1[j] + r2[j] * r2[j];
            ss += __shfl_xor(ss, 1); ss += __shfl_xor(ss, 2); ss += __shfl_xor(ss, 4);
            const float rs = rsqrtf(ss * (1.f / 192.f) + EPS);
#pragma unroll
            for (int e = 0; e < 16; ++e) xn[e] *= rs * gk[e];
            float o1[4], o2[4];
#pragma unroll
            for (int j = 0; j < 4; ++j) { const float y1 = r1[j] * rs * gk1[j], y2 = r2[j] * rs * gk2[j]; o1[j] = y1 * cs[j] - y2 * sn[j]; o2[j] = y2 * cs[j] + y1 * sn[j]; }
            bf16_t* op = KF + (size_t)row * 1536 + hd * 192;
            u32x4 wa, wb; u32x2 w1, w2;
            wa.x = pk2(xn[0], xn[1]); wa.y = pk2(xn[2], xn[3]); wa.z = pk2(xn[4], xn[5]); wa.w = pk2(xn[6], xn[7]);
            wb.x = pk2(xn[8], xn[9]); wb.y = pk2(xn[10], xn[11]); wb.z = pk2(xn[12], xn[13]); wb.w = pk2(xn[14], xn[15]);
            w1.x = pk2(o1[0], o1[1]); w1.y = pk2(o1[2], o1[3]); w2.x = pk2(o2[0], o2[1]); w2.y = pk2(o2[2], o2[3]);
            *(u32x4*)(op + 16 * sub) = wa; *(u32x4*)(op + 16 * sub + 8) = wb; *(u32x2*)(op + 128 + 4 * sub) = w1; *(u32x2*)(op + 160 + 4 * sub) = w2;
        }
    }
}

__device__ __forceinline__ int crow(int r, int hi) { return (r & 3) + 8 * (r >> 2) + 4 * hi; }

constexpr int ATT_KBUF = 25600, ATT_VBUF = 18432, ATT_VBASE = 2 * ATT_KBUF;
__device__ __forceinline__ void att_dma(unsigned ldsdst, unsigned voff, const char* sbase) {
    unsigned keep;
    asm volatile("s_mov_b32 %0, m0\n\ts_mov_b32 m0, %1\n\ts_nop 0\n\tglobal_load_lds_dwordx4 %2, %3\n\ts_mov_b32 m0, %0" : "=&s"(keep) : "s"(ldsdst), "v"(voff), "s"(sbase) : "memory");
}
__device__ __forceinline__ void att_pv(f32x16 (&o)[4], const bf16x8 (&pf)[4], const LAS bf16_t* Vs, int l31, int hi) {
#pragma unroll
    for (int db = 0; db < 4; ++db)
#pragma unroll
        for (int st = 0; st < 4; ++st) {
            const bf16x8 vf = *(const LAS bf16x8*)(Vs + (32 * db + l31) * 72 + 16 * st + 8 * hi);
            o[db] = __builtin_amdgcn_mfma_f32_32x32x16_bf16(vf, pf[st], o[db], 0, 0, 0);
            if (st == 3) asm volatile("" ::: "memory");
        }
}
__device__ __forceinline__ void attn_unit(LAS unsigned char* lds, const bf16_t* QF, const bf16_t* KF, const bf16_t* VT, bf16_t* O, const int* pos, const float* invf, const float* qg, int b, int h, int qb) {
    int tid = threadIdx.x; asm volatile("" : "+v"(tid));
    const int lane = tid & 63, wid = __builtin_amdgcn_readfirstlane(tid >> 6), l31 = lane & 31, hi = lane >> 5;
    const bool grpB = wid >= 4;
    const unsigned lds_u32 = (unsigned)(__UINTPTR_TYPE__)lds;
    const int q0 = qb * 256, qw = q0 + wid * 32;
    const size_t rowb = (size_t)b * SEQ;
    const int NT = (q0 + 256) / 64;
    unsigned doff[6];
#pragma unroll
    for (int k = 0; k < 6; ++k) {
        const int I = wid + 8 * k;
        if (I < 25) { const int P = 64 * I + lane, r = P / 25, c = P % 25, rs = (r & ~12) | ((r & 4) << 1) | ((r & 8) >> 1);
            doff[k] = (unsigned)(rs * 3072 + (c < 24 ? c : 23) * 16); }
        else { const int P = 64 * (I - 25) + lane, d = P / 9, c = P % 9; doff[k] = (unsigned)(d * (M * 2) + (c < 8 ? c : 7) * 16); }
    }
    const char* kbase = (const char*)(KF + rowb * 1536 + h * 192);
    const char* vbase = (const char*)(VT + (size_t)(h * 128) * M + rowb);
#define ATT_ISSUE(t, kb, vb) do { const char* kb_ = kbase + (size_t)(t) * (64 * 3072); const char* vb_ = vbase + (size_t)(t) * 128; const unsigned lk_ = lds_u32 + (unsigned)(kb) * ATT_KBUF, lv_ = lds_u32 + ATT_VBASE + (unsigned)(vb) * ATT_VBUF; \
        _Pragma("unroll") for (int k = 0; k < 6; ++k) { const int I = wid + 8 * k; if (I < 25) att_dma(lk_ + (unsigned)I * 1024u, doff[k], kb_); else if (I < 43) att_dma(lv_ + (unsigned)(I - 25) * 1024u, doff[k], vb_); } } while (0)
    ATT_ISSUE(0, 0, 0);
    bf16x8 qf[12];
    {
        const bf16_t* qp = QF + (rowb + qw + l31) * 1536 + h * 192 + hi * 8;
#pragma unroll
        for (int ks = 0; ks < 12; ++ks) qf[ks] = *(const bf16x8*)(qp + ks * 16);
        float ss = 0.f;
#pragma unroll
        for (int ks = 0; ks < 12; ++ks) { const u32x4 w = __builtin_bit_cast(u32x4, qf[ks]);
            ss += (bflo(w.x) * bflo(w.x) + bfhi(w.x) * bfhi(w.x)) + (bflo(w.y) * bflo(w.y) + bfhi(w.y) * bfhi(w.y)) + (bflo(w.z) * bflo(w.z) + bfhi(w.z) * bfhi(w.z)) + (bflo(w.w) * bflo(w.w) + bfhi(w.w) * bfhi(w.w)); }
        ss += __shfl_xor(ss, 32);
        const float rstd = rsqrtf(ss * (1.f / 192.f) + EPS) * QSCALE;
#pragma unroll
        for (int ks = 0; ks < 8; ++ks) { const u32x4 w = __builtin_bit_cast(u32x4, qf[ks]); const f32x4 ga = *(const f32x4*)(qg + ks * 16 + hi * 8), gb = *(const f32x4*)(qg + ks * 16 + hi * 8 + 4);
            const f32x4 a = {bflo(w.x) * rstd * ga[0], bfhi(w.x) * rstd * ga[1], bflo(w.y) * rstd * ga[2], bfhi(w.y) * rstd * ga[3]}, bq = {bflo(w.z) * rstd * gb[0], bfhi(w.z) * rstd * gb[1], bflo(w.w) * rstd * gb[2], bfhi(w.w) * rstd * gb[3]};
            qf[ks] = __builtin_bit_cast(bf16x8, pack8(a, bq)); }
        const float pf_ = (float)pos[rowb + qw + l31];
#pragma unroll
        for (int kk = 0; kk < 2; ++kk) {
            const u32x4 w1 = __builtin_bit_cast(u32x4, qf[8 + kk]), w2 = __builtin_bit_cast(u32x4, qf[10 + kk]);
            u32x4 r1, r2;
#define ATT_ROPE2(W1, W2, R1, R2, e) do { const int i_ = 16 * kk + 8 * hi + 2 * (e); \
                const float xa_ = bflo(W1) * rstd * qg[128 + i_], xb_ = bfhi(W1) * rstd * qg[129 + i_], ya_ = bflo(W2) * rstd * qg[160 + i_], yb_ = bfhi(W2) * rstd * qg[161 + i_]; \
                float ca_, sa_, cb_, sb_; rope_cs(pf_ * invf[i_], ca_, sa_); rope_cs(pf_ * invf[i_ + 1], cb_, sb_); \
                R1 = pk2(xa_ * ca_ - ya_ * sa_, xb_ * cb_ - yb_ * sb_); R2 = pk2(ya_ * ca_ + xa_ * sa_, yb_ * cb_ + xb_ * sb_); } while (0)
            ATT_ROPE2(w1.x, w2.x, r1.x, r2.x, 0); ATT_ROPE2(w1.y, w2.y, r1.y, r2.y, 1); ATT_ROPE2(w1.z, w2.z, r1.z, r2.z, 2); ATT_ROPE2(w1.w, w2.w, r1.w, r2.w, 3);
#undef ATT_ROPE2
            qf[8 + kk] = __builtin_bit_cast(bf16x8, r1); qf[10 + kk] = __builtin_bit_cast(bf16x8, r2);
        }
    }
    f32x16 o[4];
#pragma unroll
    for (int i = 0; i < 4; ++i)
#pragma unroll
        for (int r = 0; r < 16; ++r) o[i][r] = 0.f;
    float mrun = -INFINITY, lrun = 0.f;
    bf16x8 pf[4];
#pragma unroll
    for (int i = 0; i < 4; ++i) pf[i] = (bf16x8){0, 0, 0, 0, 0, 0, 0, 0};
    bool pend = false; int vb = 0, vbp = 0;
    asm volatile("s_waitcnt vmcnt(0)\n\ts_barrier" ::: "memory");
    for (int j = 0; j < NT; ++j) {
        const int kv0 = 64 * j;
        const int vbn = (vb == 2) ? 0 : vb + 1;
        if (j + 1 < NT) ATT_ISSUE(j + 1, (j + 1) & 1, vbn);
        const LAS bf16_t* Ks = (const LAS bf16_t*)(lds + (j & 1) * ATT_KBUF);
        if (pend) { att_pv(o, pf, (const LAS bf16_t*)(lds + ATT_VBASE + vbp * ATT_VBUF), l31, hi); pend = false; }
        if (kv0 <= qw + 31) {
            f32x16 p0, p1;
#pragma unroll
            for (int r = 0; r < 16; ++r) { p0[r] = 0.f; p1[r] = 0.f; }
#pragma unroll
            for (int ks = 0; ks < 12; ++ks) {
                const bf16x8 a0 = *(const LAS bf16x8*)(Ks + l31 * 200 + ks * 16 + hi * 8);
                const bf16x8 a1 = *(const LAS bf16x8*)(Ks + (32 + l31) * 200 + ks * 16 + hi * 8);
                p0 = __builtin_amdgcn_mfma_f32_32x32x16_bf16(a0, qf[ks], p0, 0, 0, 0);
                p1 = __builtin_amdgcn_mfma_f32_32x32x16_bf16(a1, qf[ks], p1, 0, 0, 0);
                if (ks & 1) asm volatile("" ::: "memory");
            }
            if (kv0 + 63 > qw) {
                const int q = qw + l31;
#pragma unroll
                for (int r = 0; r < 16; ++r) { const int kv = kv0 + (r & 3) + 4 * ((r >> 2) & 1) + 8 * hi + 16 * (r >> 3); if (kv > q) p0[r] = -INFINITY; if (kv + 32 > q) p1[r] = -INFINITY; }
            }
            float mx = fmaxf(p0[0], p1[0]);
#pragma unroll
            for (int r = 1; r < 16; ++r) mx = fmaxf(mx, fmaxf(p0[r], p1[r]));
            mx = fmaxf(mx, __shfl_xor(mx, 32));
            if (__any(mx > mrun + 8.f)) {
                const float mnew = fmaxf(mrun, mx);
                const float alpha = __builtin_amdgcn_exp2f(mrun - mnew);
                mrun = mnew; lrun *= alpha;
#pragma unroll
                for (int i = 0; i < 4; ++i)
#pragma unroll
                    for (int r = 0; r < 16; ++r) o[i][r] *= alpha;
            }
            float rsum = 0.f;
#pragma unroll
            for (int r = 0; r < 16; ++r) { p0[r] = __builtin_amdgcn_exp2f(p0[r] - mrun); p1[r] = __builtin_amdgcn_exp2f(p1[r] - mrun); rsum += p0[r] + p1[r]; }
            lrun += rsum;
            {
                u32x4 w;
                w.x = pk2(p0[0], p0[1]); w.y = pk2(p0[2], p0[3]); w.z = pk2(p0[4], p0[5]); w.w = pk2(p0[6], p0[7]); pf[0] = __builtin_bit_cast(bf16x8, w);
                w.x = pk2(p0[8], p0[9]); w.y = pk2(p0[10], p0[11]); w.z = pk2(p0[12], p0[13]); w.w = pk2(p0[14], p0[15]); pf[1] = __builtin_bit_cast(bf16x8, w);
                w.x = pk2(p1[0], p1[1]); w.y = pk2(p1[2], p1[3]); w.z = pk2(p1[4], p1[5]); w.w = pk2(p1[6], p1[7]); pf[2] = __builtin_bit_cast(bf16x8, w);
                w.x = pk2(p1[8], p1[9]); w.y = pk2(p1[10], p1[11]); w.z = pk2(p1[12], p1[13]); w.w = pk2(p1[14], p1[15]); pf[3] = __builtin_bit_cast(bf16x8, w);
            }
            if (grpB) { pend = true; vbp = vb; }
            else att_pv(o, pf, (const LAS bf16_t*)(lds + ATT_VBASE + vb * ATT_VBUF), l31, hi);
        }
        vb = vbn;
        asm volatile("s_waitcnt vmcnt(0) lgkmcnt(0)\n\ts_barrier" ::: "memory");
    }
#undef ATT_ISSUE
    if (pend) att_pv(o, pf, (const LAS bf16_t*)(lds + ATT_VBASE + vbp * ATT_VBUF), l31, hi);
    lrun += __shfl_xor(lrun, 32);
    const float inv = 1.f / lrun;
    bf16_t* op = O + (rowb + qw + l31) * 1024 + h * 128 + 4 * hi;
#pragma unroll
    for (int db = 0; db < 4; ++db)
#pragma unroll
        for (int g = 0; g < 4; ++g) {
            u32x2 w; w.x = pk2(o[db][4 * g] * inv, o[db][4 * g + 1] * inv); w.y = pk2(o[db][4 * g + 2] * inv, o[db][4 * g + 3] * inv);
            *(u32x2*)(op + 32 * db + 8 * g) = w;
        }
    asm volatile("s_waitcnt lgkmcnt(0)\n\ts_barrier" ::: "memory");
}

template <class Epi> __device__ __forceinline__ void run_gemm(LAS unsigned char* lds, const bf16_t* A, int arows, const bf16_t* Bt, int nM, int nN, int K, int G, int c, const Epi& E) {
    pg8::Gemm g{A, Bt, nM * 256, nN * 256, K, arows};
    pg8::StaticOrder S; S.init2(nM, nN, G, c);
    pg8::gemm_phase<Epi, pg8::StaticOrder, true, true>(lds, g, S, E);
}

#define XB_TMO      128
#define XB_XCNT(j)  (256  + 64 * (j))
#define XB_XSUB(j)  (1280 + 64 * (j))
#define XB_XGEN(j)  (2304 + 64 * (j))
#define XB_TOP      3328
#define XB_TOPGEN   3392
#define XCD_BAR_WORDS 3456
#define XB_SPIN_CAP (1u << 18)

__device__ __forceinline__ unsigned xb_ld(unsigned* p)              { return __hip_atomic_load(p, __ATOMIC_RELAXED, __HIP_MEMORY_SCOPE_AGENT); }
__device__ __forceinline__ unsigned xb_add(unsigned* p, unsigned v) { return __hip_atomic_fetch_add(p, v, __ATOMIC_RELAXED, __HIP_MEMORY_SCOPE_AGENT); }
__device__ __forceinline__ unsigned xb_xcc_id() { return (unsigned)__builtin_amdgcn_s_getreg((3 << 11) | 20) & 0xFu; }
#define XB_SPIN(cond, bar) do { unsigned _sp = 0; while (cond) { __builtin_amdgcn_s_sleep(1); \
    if ((++_sp & 255u) == 0u) { if (xb_ld(&(bar)[XB_TMO])) break; if (_sp > XB_SPIN_CAP) { atomicAdd(&(bar)[XB_TMO], 1u); break; } } } } while (0)

struct XcdBarrier {
    unsigned* bar; unsigned x;
    volatile LAS unsigned* st;
};

__device__ __forceinline__ XcdBarrier xcd_barrier_post(unsigned* bar, volatile LAS unsigned* st) {
    XcdBarrier b; b.bar = bar; b.x = xb_xcc_id(); b.st = st;
    if (threadIdx.x == 0) (void)xb_add(&bar[XB_XCNT(b.x)], 1u);
    return b;
}
__device__ __forceinline__ void xcd_barrier_complete(unsigned* bar, unsigned x, unsigned& nloc, unsigned& nx) {
    const unsigned G = gridDim.x * gridDim.y * gridDim.z;
    unsigned sum, cnt, mine, sp = 0u;
    for (;;) {
        sum = 0u; cnt = 0u; mine = 0u;
#pragma unroll
        for (unsigned j = 0; j < 16; ++j) { const unsigned c = xb_ld(&bar[XB_XCNT(j)]); sum += c; cnt += (c > 0u) ? 1u : 0u; mine = (j == x) ? c : mine; }
        if (sum == G) break;
        __builtin_amdgcn_s_sleep(1);
        if ((++sp & 255u) == 0u) { if (xb_ld(&bar[XB_TMO])) break; if (sp > XB_SPIN_CAP) { atomicAdd(&bar[XB_TMO], 1u); break; } }
    }
    nloc = mine > 0u ? mine : 1u; nx = cnt > 0u ? cnt : 1u;
}

__device__ __forceinline__ void xcd_barrier(const XcdBarrier& b) {
    asm volatile("s_waitcnt vmcnt(0)" ::: "memory");
    __syncthreads();
    if (threadIdx.x == 0) {
        unsigned* bar = b.bar;
        __builtin_amdgcn_s_waitcnt(0);
        unsigned nloc = b.st[0], nx = b.st[1];
        if (nloc == 0u) { xcd_barrier_complete(bar, b.x, nloc, nx); b.st[0] = nloc; b.st[1] = nx; }
        const unsigned old = xb_add(&bar[XB_XSUB(b.x)], 1u);
        const unsigned gen = old / nloc;
        if (old + 1u == (gen + 1u) * nloc) {
            __builtin_amdgcn_fence(__ATOMIC_RELEASE, "agent");
            asm volatile("s_waitcnt vmcnt(0)" ::: "memory");
            const unsigned og = xb_add(&bar[XB_TOP], 1u);
            const unsigned tg = og / nx;
            if (og + 1u == (tg + 1u) * nx) xb_add(&bar[XB_TOPGEN], 1u);
            else XB_SPIN(xb_ld(&bar[XB_TOPGEN]) == tg, bar);
            __builtin_amdgcn_fence(__ATOMIC_ACQUIRE, "agent");
            xb_add(&bar[XB_XGEN(b.x)], 1u);
            asm volatile("s_waitcnt vmcnt(0)" ::: "memory");
        } else {
            XB_SPIN(xb_ld(&bar[XB_XGEN(b.x)]) == gen, bar);
            __builtin_amdgcn_fence(__ATOMIC_ACQUIRE, "agent");
            asm volatile("s_waitcnt vmcnt(0)" ::: "memory");
        }
    }
    __syncthreads();
}

#define GRID_SYNC() do { asm volatile("s_waitcnt vmcnt(0) lgkmcnt(0)" ::: "memory"); grid.sync(); __builtin_amdgcn_fence(__ATOMIC_ACQUIRE, "agent"); asm volatile("s_waitcnt vmcnt(0)" ::: "memory"); } while (0)
#define XSYNC() xcd_barrier(xbar)
typedef const __attribute__((address_space(4))) Args* KArgs;
#define KA() ({ KArgs k_ = (KArgs)__builtin_amdgcn_kernarg_segment_ptr(); asm volatile("" : "+s"(k_)); k_; })

#ifdef STOP_LAYER
__device__ __forceinline__ void dump_bf16(float* o, const bf16_t* p, size_t n, bool add, int gtid, int gthreads) {
    const size_t per = (n + (size_t)M * DM - 1) / ((size_t)M * DM);
    for (size_t i = gtid; i < (size_t)M * DM; i += gthreads) { float a = add ? o[i] : 0.f; for (size_t k = 0; k < per; ++k) { const size_t q = i * per + k; if (q < n) a += bf2f(p[q]); } o[i] = a; }
}
__device__ __forceinline__ void dump_f32(float* o, const float* p, size_t n, bool add, int gtid, int gthreads) {
    const size_t per = (n + (size_t)M * DM - 1) / ((size_t)M * DM);
    for (size_t i = gtid; i < (size_t)M * DM; i += gthreads) { float a = add ? o[i] : 0.f; for (size_t k = 0; k < per; ++k) { const size_t q = i * per + k; if (q < n) a += p[q]; } o[i] = a; }
}
#define STOP(ph, stmts) do { if (layer == STOP_LAYER && (ph) == STOP_PHASE) { KArgs ka = KA(); unsigned char* ws = ka->ws; float* o = ka->out; int tid_ = threadIdx.x; asm volatile("" : "+v"(tid_)); const int gt = bid * NTHREADS + tid_; (void)ws; (void)o; (void)gt; stmts; return; } } while (0)
#define DBF(ptr, n, add) dump_bf16(o, ptr, n, add, gt, gthreads)
#define DFF_(ptr, n, add) dump_f32(o, ptr, n, add, gt, gthreads)
#else
#define STOP(ph, stmts) do {} while (0)
#endif


#ifdef DIAG_BISECT
__device__ __forceinline__ void dg_bf16(const bf16_t* p, size_t n, unsigned code, unsigned* diag, int gtid, int gthreads, float lim = 1e6f) {
    bool bad = false;
    for (size_t i = (size_t)gtid * 8; i < n; i += (size_t)gthreads * 8) {
        const u32x4 w = *(const u32x4*)(p + i);
        const unsigned ws4[4] = {w.x, w.y, w.z, w.w};
#pragma unroll
        for (int k = 0; k < 4; ++k) { const float a = bflo(ws4[k]), b = bfhi(ws4[k]); if (!(fabsf(a) < lim) || !(fabsf(b) < lim)) bad = true; }
    }
    if (bad) atomicMin(diag, code * 10u);
}
__device__ __forceinline__ void dg_f32(const float* p, size_t n, unsigned code, unsigned* diag, int gtid, int gthreads, float lim = 1e8f) {
    bool bad = false;
    for (size_t i = (size_t)gtid; i < n; i += (size_t)gthreads) { if (!(fabsf(p[i]) < lim)) bad = true; }
    if (bad) atomicMin(diag, code * 10u);
}
__device__ __forceinline__ void dg_pos(const float* p, size_t n, unsigned code, unsigned* diag, int gtid, int gthreads) {
    bool bad = false;
    for (size_t i = (size_t)gtid; i < n; i += (size_t)gthreads) { if (p[i] > 1e-3f) bad = true; }
    if (bad) atomicMin(diag, code * 10u);
}
#define DG(stmts) do { KArgs ka = KA(); unsigned char* ws = ka->ws; unsigned* diag = (unsigned*)(ws + 32768); int tid_ = threadIdx.x; asm volatile("" : "+v"(tid_)); const int gt = bid * NTHREADS + tid_; (void)diag; (void)gt; stmts; } while (0)
#define DB(ptr, n, code) dg_bf16(ptr, n, code, diag, gt, gthreads)
#define DF(ptr, n, code) dg_f32(ptr, n, code, diag, gt, gthreads)
#else
#define DG(stmts) do {} while (0)
#endif

#define INF(k) ((const float*)ka->in[k])
#define WSP(T, off) ((T*)(ws + (off)))

__global__ void __launch_bounds__(NTHREADS, 2) trunk_fwd(Args args) {
    extern __shared__ __attribute__((aligned(16))) unsigned char lds_raw[];
    cg::grid_group grid = cg::this_grid();
    LAS unsigned char* lds = (LAS unsigned char*)lds_raw;
    const int G = gridDim.x, bid = blockIdx.x;
    const int vcu = (G % 8 == 0) ? (bid % 8) * (G / 8) + bid / 8 : bid;
    const int NGW = G * NWAVES, gthreads = G * NTHREADS;
    (void)args;
    volatile LAS unsigned* xmisc = (volatile LAS unsigned*)(lds + XMISC_OFF);
    if (threadIdx.x < 2) xmisc[threadIdx.x] = 0u;
    __syncthreads();
    XcdBarrier xbar;
    { KArgs ka0 = (KArgs)__builtin_amdgcn_kernarg_segment_ptr(); xbar = xcd_barrier_post((unsigned*)(ka0->ws + WS_BAR), xmisc); }

    {
        KArgs ka = KA(); unsigned char* ws = ka->ws;
        int tid = threadIdx.x; asm volatile("" : "+v"(tid));
        const int lane = tid & 63, wave = __builtin_amdgcn_readfirstlane(tid >> 6), gw = vcu * NWAVES + wave, gtid = bid * NTHREADS + tid;
        LAS float* scr = (LAS float*)(lds + wave * 17408);
        float* SSQ = WSP(float, WS_SSQ); float* LBT = WSP(float, WS_LBT); float* INVF = WSP(float, WS_INVF); bf16_t* XB = WSP(bf16_t, WS_XB);
        const float* x_in = INF(0); const float* hgrn_lbs = INF(5);
        for (int i = gtid; i < 2048; i += gthreads) {
            const int c = i & 1023;
            LBT[i] = (i < 1024) ? 0.f : 1.f / (1.f + __expf(hgrn_lbs[c] - hgrn_lbs[1024 + c]));
        }
#ifdef DIAG_BISECT
        if (gtid == 0) *(unsigned*)(ws + 32768) = 990u;
#endif
        if (gtid < 32) INVF[gtid] = exp2f(-(float)gtid * (13.287712379549449f / 32.0f));
        for (int m = gw; m < M; m += NGW) {
            const f32x4* xr = (const f32x4*)(x_in + (size_t)m * 1024) + lane;
            float s = 0.f; f32x4 v[4];
#pragma unroll
            for (int j = 0; j < 4; ++j) { v[j] = xr[64 * j]; s += (v[j][0] * v[j][0] + v[j][1] * v[j][1]) + (v[j][2] * v[j][2] + v[j][3] * v[j][3]); }
            s = wave_sum(s);
            u32x2* o8 = (u32x2*)(XB + (size_t)m * 1024) + lane;
#pragma unroll
            for (int j = 0; j < 4; ++j) { u32x2 w; w.x = pk2(v[j][0], v[j][1]); w.y = pk2(v[j][2], v[j][3]); o8[64 * j] = w; }
            if (lane < 4) SSQ[(size_t)lane * M + m] = (lane == 0) ? s : 0.f;
        }
        int rot = 0;
        for (int j = 0; j < 2; ++j) {
            cvt_job(INF(4) + (size_t)j * 1024 * 4096, 1024, 4096, INF(2) + (2 * j) * 1024, WSP(bf16_t, WS_WHIN) + (size_t)j * 4096 * 1024, 4096, 0, rot, gw, NGW, scr, lane);
            cvt_job(INF(7) + (size_t)j * 1024 * 1024, 1024, 1024, nullptr, WSP(bf16_t, WS_WHOUT) + (size_t)j * 1024 * 1024, 1024, 0, rot, gw, NGW, scr, lane);
            cvt_job(INF(8) + (size_t)j * 1024 * 576, 1024, 576, INF(2) + (2 * j + 1) * 1024, WSP(bf16_t, WS_WMIN) + (size_t)j * 768 * 1024, 576, 0, rot, gw, NGW, scr, lane);
            cvt_job(INF(10) + (size_t)j * 256 * 1536, 256, 1536, INF(9) + j * 256, WSP(bf16_t, WS_WQ) + (size_t)j * 1536 * 256, 1536, 0, rot, gw, NGW, scr, lane);
            cvt_job(INF(12) + (size_t)j * 256 * 2048, 256, 2048, INF(11) + j * 256, WSP(bf16_t, WS_WKN) + (size_t)j * 1024 * 256, 1024, 1, rot, gw, NGW, scr, lane);
            cvt_job(INF(12) + (size_t)j * 256 * 2048, 256, 2048, INF(11) + j * 256, WSP(bf16_t, WS_WV) + (size_t)j * 1024 * 256, 1024, 2, rot, gw, NGW, scr, lane);
            cvt_job(INF(15) + (size_t)j * 1024 * 1024, 1024, 1024, nullptr, WSP(bf16_t, WS_WMOUT) + (size_t)j * 1024 * 1024, 1024, 0, rot, gw, NGW, scr, lane);
        }
    }
    XSYNC();
    if (G == 0x7fffffff) GRID_SYNC();

    for (int layer = 0; layer < 4; ++layer) {
        const int j = layer >> 1;
        const unsigned cb_ = 20u * (unsigned)layer; (void)cb_;
        if (layer == 0) DG(DB(WSP(bf16_t, WS_XB), (size_t)M * 1024, 1); DF(WSP(float, WS_SSQ), (size_t)4 * M, 1); DB(WSP(bf16_t, WS_WHIN), (size_t)4096 * 1024, 1); DB(WSP(bf16_t, WS_WHOUT), (size_t)1024 * 1024, 1));
        if ((layer & 1) == 0) {
#ifndef SKIP_H1
            { KArgs ka = KA(); unsigned char* ws = ka->ws;
              epi::EpiHgrnIn E{WSP(float, WS_SSQ) + (size_t)(2 * layer) * 4 * M, WSP(float, WS_LBT) + j * 1024, WSP(bf16_t, WS_QH), WSP(bf16_t, WS_VH), WSP(bf16_t, WS_GH), WSP(float, WS_LF)};
              run_gemm(lds, WSP(bf16_t, WS_XB), 256, WSP(bf16_t, WS_WHIN) + (size_t)j * 4096 * 1024, 64, 16, 1024, G, bid, E); }
#endif
            XSYNC();
            STOP(1, DBF(WSP(bf16_t, WS_QH), (size_t)M * 1024, false); DBF(WSP(bf16_t, WS_VH), (size_t)M * 1024, true); DBF(WSP(bf16_t, WS_GH), (size_t)M * 1024, true); DFF_(WSP(float, WS_LF), (size_t)M * 1024, true));
            DG(dg_bf16(WSP(bf16_t, WS_QH), (size_t)M * 1024, cb_ + 2, diag, gt, gthreads, 100.f); dg_bf16(WSP(bf16_t, WS_VH), (size_t)M * 1024, cb_ + 2, diag, gt, gthreads, 100.f); dg_bf16(WSP(bf16_t, WS_GH), (size_t)M * 1024, cb_ + 2, diag, gt, gthreads, 100.f); dg_f32(WSP(float, WS_LF), (size_t)M * 1024, cb_ + 2, diag, gt, gthreads, 100.f); dg_pos(WSP(float, WS_LF), (size_t)M * 1024, cb_ + 3, diag, gt, gthreads));
#ifndef SKIP_H2
            { KArgs ka = KA(); unsigned char* ws = ka->ws; hgrn_local(lds, WSP(bf16_t, WS_VH), WSP(float, WS_LF), WSP(bf16_t, WS_ST), WSP(float, WS_DL), G, bid, (unsigned*)(ws + 32768)); }
#endif
            XSYNC();
            STOP(2, DBF(WSP(bf16_t, WS_ST), (size_t)16 * 128 * 16384 - 16384, false); DFF_(WSP(float, WS_DL), (size_t)16 * 128 * 128 - 128, true));
            DG(for (int q_ = 0; q_ < 16; ++q_) DB(WSP(bf16_t, WS_ST) + (size_t)q_ * 128 * 16384, (size_t)127 * 16384, cb_ + 5); DF(WSP(float, WS_DL), (size_t)16 * 128 * 128 - 128, cb_ + 4));
#ifndef SKIP_H3
            { KArgs ka = KA(); unsigned char* ws = ka->ws; int tid = threadIdx.x; asm volatile("" : "+v"(tid)); hgrn_scan(WSP(bf16_t, WS_ST), WSP(float, WS_DL), bid * NTHREADS + tid, gthreads); }
#endif
        } else {
#ifndef SKIP_M1
            { KArgs ka = KA(); unsigned char* ws = ka->ws;
              epi::EpiMlaIn E{WSP(float, WS_SSQ) + (size_t)(2 * layer) * 4 * M, WSP(bf16_t, WS_CQ), WSP(bf16_t, WS_CKV), WSP(float, WS_KR), WSP(float, WS_SSQCQ) + (size_t)j * M, WSP(float, WS_SSQCKV) + (size_t)j * M, WSP(float, WS_SSQKR) + (size_t)j * M, (LAS float*)(lds + HALO_OFF)};
              run_gemm(lds, WSP(bf16_t, WS_XB), 256, WSP(bf16_t, WS_WMIN) + (size_t)j * 768 * 1024, 64, 3, 1024, G, bid, E); }
#endif
            XSYNC();
            STOP(1, DBF(WSP(bf16_t, WS_CQ), (size_t)M * 256, false); DBF(WSP(bf16_t, WS_CKV), (size_t)M * 256, true); DFF_(WSP(float, WS_KR), (size_t)M * 64, true); DFF_(WSP(float, WS_SSQCQ) + (size_t)j * M, (size_t)4 * M, true));
            DG(DB(WSP(bf16_t, WS_CQ), (size_t)M * 256, cb_ + 2); DB(WSP(bf16_t, WS_CKV), (size_t)M * 256, cb_ + 2); DF(WSP(float, WS_KR), (size_t)M * 64, cb_ + 2); DF(WSP(float, WS_SSQCQ) + (size_t)j * M, (size_t)4 * M, cb_ + 2));
#ifndef SKIP_M2A
            { KArgs ka = KA(); unsigned char* ws = ka->ws;
              epi::EpiScale<true> E{WSP(float, WS_SSQCQ) + (size_t)j * M, 1.f / 256.f, WSP(bf16_t, WS_QF), 1536}; run_gemm(lds, WSP(bf16_t, WS_CQ), 256, WSP(bf16_t, WS_WQ) + (size_t)j * 1536 * 256, 64, 6, 256, G, bid, E); }
#endif
#ifndef SKIP_M2B
            { KArgs ka = KA(); unsigned char* ws = ka->ws;
              epi::EpiKFinal E{WSP(float, WS_SSQCKV) + (size_t)j * M, WSP(float, WS_SSQKR) + (size_t)j * M, WSP(float, WS_KR), (const int*)ka->in[1], WSP(float, WS_INVF), INF(14) + j * 192, WSP(bf16_t, WS_KF), (LAS float*)(lds + HALO_OFF)};
              run_gemm(lds, WSP(bf16_t, WS_CKV), 256, WSP(bf16_t, WS_WKN) + (size_t)j * 1024 * 256, 64, 4, 256, G, (bid + 128) % G, E); }
#endif
#ifndef SKIP_M2C
            { KArgs ka = KA(); unsigned char* ws = ka->ws;
              epi::EpiScale<false> E{WSP(float, WS_SSQCKV) + (size_t)j * M, 1.f / 256.f, WSP(bf16_t, WS_VT), M}; run_gemm(lds, WSP(bf16_t, WS_WV) + (size_t)j * 1024 * 256, 256, WSP(bf16_t, WS_CKV), 4, 64, 256, G, (bid + 128) % G, E); }
#endif
        }
        {
            KArgs ka = KA(); unsigned char* ws = ka->ws; int tid = threadIdx.x; asm volatile("" : "+v"(tid));
            const int wave = __builtin_amdgcn_readfirstlane(tid >> 6);
            LAS float* scr = (LAS float*)(lds + wave * 17408);
            __syncthreads();
            int rot = 0;
            cvt_job(INF(16) + (size_t)layer * 1024 * DFF2, 1024, DFF2, INF(3) + layer * 1024, WSP(bf16_t, WS_WUP), DFF2, 3, rot, vcu * NWAVES + wave, NGW, scr, tid & 63);
            cvt_job(INF(19) + (size_t)layer * DFF * 1024, DFF, 1024, nullptr, WSP(bf16_t, WS_WDN), 1024, 0, rot, vcu * NWAVES + wave, NGW, scr, tid & 63);
        }
        XSYNC();
        STOP(3, DBF(WSP(bf16_t, WS_WUP), (size_t)DFF2 * 1024, false); DBF(WSP(bf16_t, WS_WDN), (size_t)DFF * 1024, true); if ((layer & 1) == 0) { DBF(WSP(bf16_t, WS_ST), (size_t)16 * 128 * 16384 - 16384, true); } else { DBF(WSP(bf16_t, WS_QF), (size_t)M * 1536, true); DBF(WSP(bf16_t, WS_KF), (size_t)M * 1536, true); });
        DG(DB(WSP(bf16_t, WS_WUP), (size_t)DFF2 * 1024, cb_ + 6); DB(WSP(bf16_t, WS_WDN), (size_t)DFF * 1024, cb_ + 6);
           if ((layer & 1) == 0) { for (int q_ = 0; q_ < 16; ++q_) DB(WSP(bf16_t, WS_ST) + (size_t)q_ * 128 * 16384, (size_t)127 * 16384, cb_ + 7); } else { DB(WSP(bf16_t, WS_QF), (size_t)M * 1536, cb_ + 7); DB(WSP(bf16_t, WS_KF), (size_t)M * 1536, cb_ + 7); });
        if ((layer & 1) == 0) {
#ifndef SKIP_H4
            { KArgs ka = KA(); unsigned char* ws = ka->ws;
              hgrn_out(lds, WSP(bf16_t, WS_QH), WSP(bf16_t, WS_VH), WSP(bf16_t, WS_GH), WSP(float, WS_LF), WSP(bf16_t, WS_ST), INF(6) + j * 128, WSP(bf16_t, WS_QH), G, bid); }
#endif
            XSYNC();
            STOP(4, DBF(WSP(bf16_t, WS_QH), (size_t)M * 1024, false));
            DG(DB(WSP(bf16_t, WS_QH), (size_t)M * 1024, cb_ + 8));
#ifndef SKIP_H5
            { KArgs ka = KA(); unsigned char* ws = ka->ws;
              epi::EpiResid E{layer == 0 ? INF(0) : (const float*)ka->out, ka->out, WSP(bf16_t, WS_XB), WSP(float, WS_SSQ) + (size_t)(2 * layer + 1) * 4 * M, (LAS float*)(lds + HALO_OFF)};
              run_gemm(lds, WSP(bf16_t, WS_QH), 256, WSP(bf16_t, WS_WHOUT) + (size_t)j * 1024 * 1024, 64, 4, 1024, G, bid, E); }
#endif
        } else {
#ifndef SKIP_M4
            { KArgs ka = KA(); unsigned char* ws = ka->ws;
              for (int pu = vcu; pu < 256; pu += G) {
                  const int bh = pu >> 4, s = pu & 15;
                  attn_unit(lds, WSP(bf16_t, WS_QF), WSP(bf16_t, WS_KF), WSP(bf16_t, WS_VT), WSP(bf16_t, WS_KN), (const int*)ka->in[1], WSP(float, WS_INVF), INF(13) + j * 192, bh >> 3, bh & 7, 31 - s);
                  attn_unit(lds, WSP(bf16_t, WS_QF), WSP(bf16_t, WS_KF), WSP(bf16_t, WS_VT), WSP(bf16_t, WS_KN), (const int*)ka->in[1], WSP(float, WS_INVF), INF(13) + j * 192, bh >> 3, bh & 7, s);
              } }
#endif
            XSYNC();
            STOP(4, DBF(WSP(bf16_t, WS_KN), (size_t)M * 1024, false));
            DG(DB(WSP(bf16_t, WS_KN), (size_t)M * 1024, cb_ + 8));
#ifndef SKIP_M5
            { KArgs ka = KA(); unsigned char* ws = ka->ws;
              epi::EpiResid E{(const float*)ka->out, ka->out, WSP(bf16_t, WS_XB), WSP(float, WS_SSQ) + (size_t)(2 * layer + 1) * 4 * M, (LAS float*)(lds + HALO_OFF)};
              run_gemm(lds, WSP(bf16_t, WS_KN), 256, WSP(bf16_t, WS_WMOUT) + (size_t)j * 1024 * 1024, 64, 4, 1024, G, bid, E); }
#endif
        }
        XSYNC();
        STOP(5, DBF(WSP(bf16_t, WS_XB), (size_t)M * 1024, true); DFF_(WSP(float, WS_SSQ) + (size_t)(2 * layer + 1) * 4 * M, (size_t)4 * M, true));
        DG(DF(ka->out, (size_t)M * 1024, cb_ + 9); DB(WSP(bf16_t, WS_XB), (size_t)M * 1024, cb_ + 9); DF(WSP(float, WS_SSQ) + (size_t)(2 * layer + 1) * 4 * M, (size_t)4 * M, cb_ + 9));
#ifndef SKIP_F1
        { KArgs ka = KA(); unsigned char* ws = ka->ws;
          epi::EpiFfnUp E{WSP(float, WS_SSQ) + (size_t)(2 * layer + 1) * 4 * M, INF(17) + (size_t)layer * 3 * DFF2, INF(18) + (size_t)layer * DFF2, WSP(bf16_t, WS_HF), (LAS float*)(lds + HALO_OFF)};
          run_gemm(lds, WSP(bf16_t, WS_XB) - 2 * 1024, 254, WSP(bf16_t, WS_WUP), 65, 22, 1024, G, bid, E); }
#endif
        XSYNC();
        STOP(6, DBF(WSP(bf16_t, WS_HF), (size_t)M * DFF, false));
        DG(DB(WSP(bf16_t, WS_HF), (size_t)M * DFF, cb_ + 10));
#ifndef SKIP_F2
        { KArgs ka = KA(); unsigned char* ws = ka->ws;
          epi::EpiResid E{(const float*)ka->out, ka->out, (layer < 3) ? WSP(bf16_t, WS_XB) : nullptr, (layer < 3) ? WSP(float, WS_SSQ) + (size_t)(2 * layer + 2) * 4 * M : nullptr, (LAS float*)(lds + HALO_OFF)};
          run_gemm(lds, WSP(bf16_t, WS_HF), 256, WSP(bf16_t, WS_WDN), 64, 4, DFF, G, bid, E); }
#endif
        if (layer < 3) XSYNC();
        STOP(7, (void)0);
    }
#ifdef DIAG_BISECT
    XSYNC();
    DG(DF(ka->out, (size_t)M * 1024, 89));
    XSYNC();
    { KArgs ka = KA(); float* o = ka->out; int tid = threadIdx.x; asm volatile("" : "+v"(tid)); const unsigned dv = *(volatile unsigned*)(ka->ws + 32768);
      for (int i = bid * NTHREADS + tid; i < M * DM; i += gthreads) o[i] = (i == 0) ? 100.f * (float)dv : 0.f; }
#endif
#ifdef DIAG_SANITIZE
    XSYNC();
    { KArgs ka = KA(); float* o = ka->out; int tid = threadIdx.x; asm volatile("" : "+v"(tid));
      for (int i = bid * NTHREADS + tid; i < M * DM; i += gthreads) { const float v = o[i]; if (!(fabsf(v) < 1e30f)) o[i] = 1e30f; } }
#endif
}

extern "C" void kernel_launch(void* const* d_in, const int* in_sizes, int n_in, void* d_out, int out_size, void* d_ws, size_t ws_size, hipStream_t stream) {
    static int grid = 0;
    if (grid == 0) {
        if (n_in != 20 || out_size != M * DM || ws_size < WS_NEED) { fprintf(stderr, "kernel_launch: unexpected problem (n_in %d, out %d, ws %zu, need %zu)\n", n_in, out_size, ws_size, (size_t)WS_NEED); grid = -1; return; }
        int dev = 0, cus = 0, per_cu = 0;
        if (hipGetDevice(&dev) != hipSuccess || hipDeviceGetAttribute(&cus, hipDeviceAttributeMultiprocessorCount, dev) != hipSuccess) { grid = -1; return; }
        if (hipFuncSetAttribute((const void*)trunk_fwd, hipFuncAttributeMaxDynamicSharedMemorySize, LDS_BYTES) != hipSuccess) { fprintf(stderr, "kernel_launch: hipFuncSetAttribute failed\n"); grid = -1; return; }
        if (hipOccupancyMaxActiveBlocksPerMultiprocessor(&per_cu, (const void*)trunk_fwd, NTHREADS, LDS_BYTES) != hipSuccess || per_cu < 1) { fprintf(stderr, "kernel_launch: occupancy query failed (%d)\n", per_cu); (void)hipGetLastError(); per_cu = 1; }
        grid = cus * per_cu;
    }
    if (grid < 0) return;
    if (hipMemsetAsync((char*)d_ws + WS_BAR, 0, WS_BAR_BYTES, stream) != hipSuccess) { fprintf(stderr, "kernel_launch: memset of the barrier words failed\n"); return; }
    Args a{};
    for (int i = 0; i < 20; ++i) a.in[i] = d_in[i];
    a.out = (float*)d_out; a.ws = (unsigned char*)d_ws;
    void* kargs[] = {&a};
    hipError_t e = hipLaunchCooperativeKernel((const void*)trunk_fwd, dim3(grid), dim3(NTHREADS), kargs, LDS_BYTES, stream);
    if (e != hipSuccess) fprintf(stderr, "kernel_launch: cooperative launch failed: %s (grid %d)\n", hipGetErrorString(e), grid);
}
```

```cpp
#include <hip/hip_runtime.h>
#include <hip/hip_cooperative_groups.h>
#include <cstdio>
#include <cstdint>
namespace cg = cooperative_groups;
namespace pg8 {
#define PG8_LAS __attribute__((address_space(3)))
typedef unsigned short bf16_t;
typedef short bf16x8 __attribute__((ext_vector_type(8)));
typedef float f32x4 __attribute__((ext_vector_type(4)));
typedef unsigned u32x4 __attribute__((ext_vector_type(4)));
constexpr int BM = 256, BK = 64, HALF = 128, HTB = HALF * BK * 2  , STAGE_BYTES = 8 * HTB, NXCD = 8, WGM = 8;

__host__ __device__ __forceinline__ int lds_byte(int r, int c) { const int st = (r >> 4) * 2 + (c >> 5), rr = r & 15, cc = c & 31, ob = rr * 64 + cc * 2; return st * 1024 + (ob ^ (((ob >> 9) & 1) << 5)); }
__host__ __device__ __forceinline__ void stage_rc(int b, int& R, int& C) { const int st = b / 1024, sb = b % 1024, swz = sb ^ (((sb >> 9) & 1) << 5); R = (st >> 1) * 16 + swz / 64; C = (st & 1) * 32 + (swz % 64) / 2; }
__host__ __device__ __forceinline__ int perm32(int rho) { const int n = rho >> 4, i = rho & 15; return 8 * (i >> 2) + 4 * n + (i & 3); }

struct Unit { int pm, pn; };
struct Gemm { const bf16_t* A; const bf16_t* Bt; int M, N, K; int arows; };

struct StaticOrder {
    int nM, nN, nwg, G, c;
    __host__ __device__ void init(int M, int N, int G_, int c_) { nM = M / BM; nN = N / BM; nwg = nM * nN; G = G_; c = c_; }
    __host__ __device__ void init2(int nM_, int nN_, int G_, int c_) { nM = nM_; nN = nN_; nwg = nM * nN; G = G_; c = c_; }
    __host__ __device__ bool next(int i, Unit& u) const {
        const long L = (long)i * G + c; if (L >= nwg) return false;
        int wgid = (int)L; { const int q = nwg / NXCD, r = nwg % NXCD, xcd = wgid % NXCD, off = wgid / NXCD; wgid = (xcd < r ? xcd * (q + 1) : r * (q + 1) + (xcd - r) * q) + off; }
        const int nig = WGM * nN, gid = wgid / nig, fm = gid * WGM, gsz = (nM - fm) < WGM ? (nM - fm) : WGM;
        u.pm = fm + ((wgid % nig) % gsz); u.pn = (wgid % nig) / gsz; return true;
    }
    __device__ __forceinline__ void a_ready(const Unit&) const {}
    __device__ __forceinline__ void done(const Unit&) const {}
};

__device__ __forceinline__ unsigned cvt_pk_bf16(float lo, float hi) { unsigned r; asm volatile("v_cvt_pk_bf16_f32 %0, %1, %2" : "=v"(r) : "v"(lo), "v"(hi)); return r; }
typedef float f32x2 __attribute__((ext_vector_type(2)));
__device__ __forceinline__ f32x2 gelu_pk(f32x2 v) {
    const f32x2 av = __builtin_elementwise_abs(v), d = av * 0.2316418882f + 1.0f;
    f32x2 t; t.x = __builtin_amdgcn_rcpf(d.x); t.y = __builtin_amdgcn_rcpf(d.y);
    f32x2 q = t * 0.5307027145f + (-0.7265760135f); q = q * t + 0.7107068705f; q = q * t + (-0.142248368f); q = q * t + 0.127414796f; q = q * t;
    const f32x2 s = (v * v) * (-0.72134752044f);
    f32x2 e; e.x = __builtin_amdgcn_exp2f(s.x); e.y = __builtin_amdgcn_exp2f(s.y);
    const f32x2 m = v * (q * e), r = v - m;
    f32x2 o; o.x = v.x < 0.f ? m.x : r.x; o.y = v.y < 0.f ? m.y : r.y; return o;
}

template <int ACT  > struct EpiBf16 {
    static constexpr bool PERM = true, AFTER_DRAIN = false; static_assert(ACT == 0 || ACT == 1, "EpiBf16: ACT is 0 (none) or 1 (gelu_pk)");
    bf16_t* O; int ldc; const float* bias; int split_cols; size_t split_stride; float scale0;
    __device__ __forceinline__ void operator()(const f32x4 (&acc)[2][2][4][2], const Unit& u, int wr, int wc, int fr, int fq) const {
        const int row0 = u.pm * BM + wr * 64 + fr; int colt = u.pn * BM; bf16_t* base = O;
        float sc = 1.f; if (split_cols) { const int t = colt / split_cols; base += (size_t)t * split_stride; colt -= t * split_cols; if (t == 0) sc = scale0; }
        const int col0 = colt + wc * 32 + 8 * fq, bcol0 = u.pn * BM + wc * 32 + 8 * fq;
        f32x4 bv[2][2];
#pragma unroll
        for (int bj = 0; bj < 2; ++bj)
#pragma unroll
            for (int n = 0; n < 2; ++n) bv[bj][n] = bias ? *(const f32x4*)(bias + bcol0 + bj * HALF + 4 * n) : (f32x4){0.f, 0.f, 0.f, 0.f};
#pragma unroll
        for (int ai = 0; ai < 2; ++ai)
#pragma unroll
            for (int m = 0; m < 4; ++m) { bf16_t* rowp = base + (size_t)(row0 + ai * HALF + m * 16) * ldc + col0;
#pragma unroll
                for (int bj = 0; bj < 2; ++bj) { f32x4 v0 = acc[ai][bj][m][0] + bv[bj][0], v1 = acc[ai][bj][m][1] + bv[bj][1];
                    if (ACT == 1) { f32x2 a = gelu_pk((f32x2){v0[0], v0[1]}), b = gelu_pk((f32x2){v0[2], v0[3]}), c = gelu_pk((f32x2){v1[0], v1[1]}), d = gelu_pk((f32x2){v1[2], v1[3]});
                        v0 = (f32x4){a.x, a.y, b.x, b.y}; v1 = (f32x4){c.x, c.y, d.x, d.y}; }
                    v0 = v0 * sc; v1 = v1 * sc; u32x4 w; w.x = cvt_pk_bf16(v0[0], v0[1]); w.y = cvt_pk_bf16(v0[2], v0[3]); w.z = cvt_pk_bf16(v1[0], v1[1]); w.w = cvt_pk_bf16(v1[2], v1[3]);
                    *(u32x4*)(rowp + bj * HALF) = w; } }
    }
};

struct PanelStats {
    unsigned* xbuf;
    unsigned* cnt;
    unsigned* tmo;
    int ntn; float eps;
    unsigned code;
    __device__ __forceinline__ bool run(const f32x4 (&v)[2][2][4][2], const Unit& u, int wr, int wc, int fr, int fq, PG8_LAS unsigned char* lds, int wid, int lane) const {
        typedef float f32x2v __attribute__((ext_vector_type(2)));
        PG8_LAS f32x2v* P = (PG8_LAS f32x2v*)lds;
        PG8_LAS f32x2v* S = (PG8_LAS f32x2v*)(lds + 8192);
        PG8_LAS unsigned* flag = (PG8_LAS unsigned*)(lds + 8192 + 2048);
#pragma unroll
        for (int ai = 0; ai < 2; ++ai)
#pragma unroll
            for (int m = 0; m < 4; ++m) {
                float s = 0.f;
#pragma unroll
                for (int bj = 0; bj < 2; ++bj)
#pragma unroll
                    for (int n = 0; n < 2; ++n) { const f32x4 x = v[ai][bj][m][n]; s += (x[0] + x[1]) + (x[2] + x[3]); }
                s += __shfl_xor(s, 16); s += __shfl_xor(s, 32);
                const float mw = s * (1.0f / 64.0f); float q = 0.f;
#pragma unroll
                for (int bj = 0; bj < 2; ++bj)
#pragma unroll
                    for (int n = 0; n < 2; ++n) { const f32x4 d = v[ai][bj][m][n] - mw; q += (d[0] * d[0] + d[1] * d[1]) + (d[2] * d[2] + d[3] * d[3]); }
                q += __shfl_xor(q, 16); q += __shfl_xor(q, 32);
                if (fq == 0) P[(ai * HALF + wr * 64 + m * 16 + fr) * 4 + wc] = (f32x2v){mw, q};
            }
        asm volatile("s_waitcnt lgkmcnt(0)" ::: "memory"); __builtin_amdgcn_s_barrier(); asm volatile("" ::: "memory");
#if defined(BROKEN_EXCHANGE_NO_WAIT)
#warning BROKEN CONTROL BUILD: the row-statistics exchange does not wait; results are wrong by design
        if (blockIdx.x >= 64) { const long long t0_ = clock64(); while (clock64() - t0_ < 60000) __builtin_amdgcn_s_sleep(8); }
#endif
        const int row = wid * 32 + (lane & 31);
        if (lane < 32) {
            const f32x2v a = P[row * 4 + 0], b = P[row * 4 + 1], c = P[row * 4 + 2], d = P[row * 4 + 3];
            const float mt = (a.x + b.x + c.x + d.x) * 0.25f;
            const float da = a.x - mt, db = b.x - mt, dc = c.x - mt, dd = d.x - mt;
            const float m2 = (a.y + b.y) + (c.y + d.y) + 64.0f * ((da * da + db * db) + (dc * dc + dd * dd));
            unsigned long long* slot = (unsigned long long*)xbuf + ((size_t)(u.pm * BM + row) * 4 + u.pn);
            __hip_atomic_store(slot, ((unsigned long long)__float_as_uint(m2) << 32) | __float_as_uint(mt), __ATOMIC_RELAXED, __HIP_MEMORY_SCOPE_AGENT);
        }
        asm volatile("s_waitcnt vmcnt(0)" ::: "memory");
        if (lane == 0) __hip_atomic_fetch_add(cnt + 64 * u.pm, 1u, __ATOMIC_RELAXED, __HIP_MEMORY_SCOPE_AGENT);
        if (wid == 0) {
            bool dead = false; const unsigned long long t0 = __builtin_amdgcn_s_memrealtime(); const unsigned want = 8u * (unsigned)ntn;
            for (;;) {
#if defined(BROKEN_EXCHANGE_NO_WAIT)
                break;
#endif
                if ((unsigned)__builtin_amdgcn_readfirstlane(__hip_atomic_load(cnt + 64 * u.pm, __ATOMIC_RELAXED, __HIP_MEMORY_SCOPE_AGENT)) >= want) break;
                if (__builtin_amdgcn_s_memrealtime() - t0 > 2000000ull) {
                    if (lane == 0) { unsigned expect = 0u; __hip_atomic_compare_exchange_strong(tmo + 1, &expect, code | (unsigned)(u.pm & 0xff), __ATOMIC_RELAXED, __ATOMIC_RELAXED, __HIP_MEMORY_SCOPE_AGENT);
                                     __hip_atomic_store(tmo, 1u, __ATOMIC_RELAXED, __HIP_MEMORY_SCOPE_AGENT); }
                    dead = true; break; }
                __builtin_amdgcn_s_sleep(2);
            }
            __builtin_amdgcn_fence(__ATOMIC_ACQUIRE, "agent");
            if (lane == 0) flag[0] = dead ? 1u : 0u;
        }
        asm volatile("s_waitcnt vmcnt(0) lgkmcnt(0)" ::: "memory"); __builtin_amdgcn_s_barrier(); asm volatile("" ::: "memory");
        const bool bad = flag[0] != 0u;
        if (lane < 32) {
            const unsigned long long* slot = (const unsigned long long*)xbuf + (size_t)(u.pm * BM + row) * 4; float mt[4], m2[4]; float ms = 0.f;
#pragma unroll
            for (int t = 0; t < 4; ++t) { if (t < ntn) { const unsigned long long w = __hip_atomic_load(slot + t, __ATOMIC_RELAXED, __HIP_MEMORY_SCOPE_AGENT); mt[t] = __uint_as_float((unsigned)w); m2[t] = __uint_as_float((unsigned)(w >> 32)); } else { mt[t] = 0.f; m2[t] = 0.f; } ms += mt[t]; }
            const float mean = ms / (float)ntn; float q = 0.f;
#pragma unroll
            for (int t = 0; t < 4; ++t) if (t < ntn) { const float dm = mt[t] - mean; q += m2[t] + 256.0f * dm * dm; }
            S[row] = (f32x2v){mean, 1.0f / sqrtf(q / (256.0f * (float)ntn) + eps)};
        }
        asm volatile("s_waitcnt lgkmcnt(0)" ::: "memory"); __builtin_amdgcn_s_barrier(); asm volatile("" ::: "memory");
        return bad;
    }
};
struct EpiLnRes {
    static constexpr bool PERM = false, AFTER_DRAIN = true;
    const float* base; float* out; int ldc; const float* bias; PanelStats st; unsigned poison;
    __device__ __forceinline__ void fused(f32x4 (&acc)[2][2][4][2], const Unit& u, int wr, int wc, int fr, int fq, PG8_LAS unsigned char* lds, int wid, int lane) const {
        typedef float f32x2v __attribute__((ext_vector_type(2)));
        const PG8_LAS f32x2v* S = (const PG8_LAS f32x2v*)(lds + 8192);
        const int col0 = u.pn * BM + wc * 32 + 4 * fq;
#pragma unroll
        for (int bj = 0; bj < 2; ++bj)
#pragma unroll
            for (int n = 0; n < 2; ++n) { const f32x4 bv = bias ? *(const f32x4*)(bias + col0 + bj * HALF + n * 16) : (f32x4){0.f, 0.f, 0.f, 0.f};
#pragma unroll
                for (int ai = 0; ai < 2; ++ai)
#pragma unroll
                    for (int m = 0; m < 4; ++m) acc[ai][bj][m][n] += bv; }
        f32x4 pre[4][2][2];
#pragma unroll
        for (int m = 0; m < 4; ++m) { const size_t off = (size_t)(u.pm * BM + wr * 64 + m * 16 + fr) * ldc + col0;
#pragma unroll
            for (int bj = 0; bj < 2; ++bj)
#pragma unroll
                for (int n = 0; n < 2; ++n) pre[m][bj][n] = *(const f32x4*)(base + off + bj * HALF + n * 16); }
        const bool bad = st.run(acc, u, wr, wc, fr, fq, lds, wid, lane) || poison != 0u;
        const float qnan = __builtin_nanf("");
#pragma unroll
        for (int ai = 0; ai < 2; ++ai)
#pragma unroll
            for (int m = 0; m < 4; ++m) { const int r = ai * HALF + wr * 64 + m * 16 + fr; const f32x2v sr = S[r]; const size_t off = (size_t)(u.pm * BM + r) * ldc + col0;
#pragma unroll
                for (int bj = 0; bj < 2; ++bj)
#pragma unroll
                    for (int n = 0; n < 2; ++n) { const f32x4 bs = ai == 0 ? pre[m][bj][n] : *(const f32x4*)(base + off + bj * HALF + n * 16); f32x4 o = bs + (acc[ai][bj][m][n] - sr.x) * sr.y;
                        if (bad) o = (f32x4){qnan, qnan, qnan, qnan}; *(f32x4*)(out + off + bj * HALF + n * 16) = o; }
                if (m & 1) asm volatile("" ::: "memory"); }
    }
};
struct EpiLnResLn {
    static constexpr bool PERM = false, AFTER_DRAIN = true;
    const float* base; float* out; bf16_t* xn; int ldc; const float* bias; PanelStats st1, st2; unsigned poison;
    __device__ __forceinline__ void fused(f32x4 (&acc)[2][2][4][2], const Unit& u, int wr, int wc, int fr, int fq, PG8_LAS unsigned char* lds, int wid, int lane) const {
        typedef float f32x2v __attribute__((ext_vector_type(2))); typedef unsigned u32x2v __attribute__((ext_vector_type(2)));
        const PG8_LAS f32x2v* S = (const PG8_LAS f32x2v*)(lds + 8192);
        const int col0 = u.pn * BM + wc * 32 + 4 * fq;
#pragma unroll
        for (int bj = 0; bj < 2; ++bj)
#pragma unroll
            for (int n = 0; n < 2; ++n) { const f32x4 bv = bias ? *(const f32x4*)(bias + col0 + bj * HALF + n * 16) : (f32x4){0.f, 0.f, 0.f, 0.f};
#pragma unroll
                for (int ai = 0; ai < 2; ++ai)
#pragma unroll
                    for (int m = 0; m < 4; ++m) acc[ai][bj][m][n] += bv; }
        bool bad = st1.run(acc, u, wr, wc, fr, fq, lds, wid, lane) || poison != 0u;
        const float qnan = __builtin_nanf("");
#pragma unroll
        for (int ai = 0; ai < 2; ++ai)
#pragma unroll
            for (int m = 0; m < 4; ++m) { const int r = ai * HALF + wr * 64 + m * 16 + fr; const f32x2v sr = S[r]; const size_t off = (size_t)(u.pm * BM + r) * ldc + col0;
#pragma unroll
                for (int bj = 0; bj < 2; ++bj)
#pragma unroll
                    for (int n = 0; n < 2; ++n) { const f32x4 bs = *(const f32x4*)(base + off + bj * HALF + n * 16); acc[ai][bj][m][n] = bs + (acc[ai][bj][m][n] - sr.x) * sr.y; }
                asm volatile("" : "+v"(acc[ai][0][m][0]), "+v"(acc[ai][0][m][1]), "+v"(acc[ai][1][m][0]), "+v"(acc[ai][1][m][1]));
                if (m & 1) asm volatile("" ::: "memory"); }
        const bool bad1 = bad;
        bad = st2.run(acc, u, wr, wc, fr, fq, lds, wid, lane) || bad;
#pragma unroll
        for (int ai = 0; ai < 2; ++ai)
#pragma unroll
            for (int m = 0; m < 4; ++m) { const int r = ai * HALF + wr * 64 + m * 16 + fr; const f32x2v sr = S[r]; const size_t off = (size_t)(u.pm * BM + r) * ldc + col0;
#pragma unroll
                for (int bj = 0; bj < 2; ++bj)
#pragma unroll
                    for (int n = 0; n < 2; ++n) { const f32x4 x1 = acc[ai][bj][m][n]; *(f32x4*)(out + off + bj * HALF + n * 16) = bad1 ? (f32x4){qnan, qnan, qnan, qnan} : x1;
                        const f32x4 o = (x1 - sr.x) * sr.y; u32x2v w; w.x = cvt_pk_bf16(o[0], o[1]); w.y = cvt_pk_bf16(o[2], o[3]);
                        if (bad) { w.x = 0x7fc07fc0u; w.y = 0x7fc07fc0u; } *(u32x2v*)(xn + off + bj * HALF + n * 16) = w; }
                asm volatile("" ::: "memory"); }
    }
};

template <class Epi, class Sched, bool ALIGN_EPI = false, bool SP2 = false>
__device__ __forceinline__ void gemm_phase(PG8_LAS unsigned char* lds, const Gemm g, const Sched& S, const Epi& E) {
    int tid = threadIdx.x; asm volatile("" : "+v"(tid));
    const int wid = __builtin_amdgcn_readfirstlane(tid >> 6), lane = tid & 63, wr = wid >> 2, wc = wid & 3, fr = lane & 15, fq = lane >> 4;
    const int K = g.K, nt = K / BK;
    unsigned voffA[2], voffB[2];
#pragma unroll
    for (int i = 0; i < 2; ++i) { int R, C; stage_rc(tid * 16 + i * 8192, R, C); const int Rb = Epi::PERM ? ((R & ~31) + perm32(R & 31)) : R;
        voffA[i] = (unsigned)(R * K + C) * 2u; voffB[i] = (unsigned)(Rb * K + C) * 2u; }
    const size_t kstep = (size_t)(BK * 2);
    const size_t hstep = (size_t)HALF * K * 2;
    const size_t tstep = 2 * hstep;
    const size_t tstepA = (size_t)g.arows * K * 2;
    const unsigned lds_u32 = (unsigned)(__UINTPTR_TYPE__)lds;
    const unsigned ldsw = (unsigned)wid * 1024u;
    const int aoff = lds_byte(wr * 64 + fr, fq * 8), boff = lds_byte(wc * 32 + fr, fq * 8);
#define PG8_SA(b, h) (((b) * 2 + (h)) * HTB)
#define PG8_SB(b, h) ((4 + (b) * 2 + (h)) * HTB)
#define PG8_STAGE(bufoff, gbase, voff) do { _Pragma("unroll") for (int _i = 0; _i < 2; ++_i) { \
        const unsigned _m0 = lds_u32 + (unsigned)(bufoff) + ldsw + (unsigned)_i * 8192u; const char* _gb = (const char*)(gbase); \
        unsigned _keep; asm volatile("s_mov_b32 %0, m0\n\ts_mov_b32 m0, %1\n\ts_nop 0\n\tglobal_load_lds_dwordx4 %2, %3\n\ts_mov_b32 m0, %0" : "=&s"(_keep) : "s"(_m0), "v"((voff)[_i]), "s"(_gb) : "memory"); } } while (0)
#define PG8_LDA(dst, b, h) do { _Pragma("unroll") for (int m = 0; m < 4; ++m) _Pragma("unroll") for (int k = 0; k < 2; ++k) dst[m][k] = *(const PG8_LAS bf16x8*)(lds + PG8_SA(b, h) + aoff + m * 2048 + k * 1024); } while (0)
#define PG8_LDB(dst, b, h) do { _Pragma("unroll") for (int n = 0; n < 2; ++n) _Pragma("unroll") for (int k = 0; k < 2; ++k) dst[n][k] = *(const PG8_LAS bf16x8*)(lds + PG8_SB(b, h) + boff + n * 2048 + k * 1024); } while (0)
#define PG8_MMA(ai, bj, At, Bt) do { __builtin_amdgcn_s_setprio(1); _Pragma("unroll") for (int m = 0; m < 4; ++m) _Pragma("unroll") for (int n = 0; n < 2; ++n) _Pragma("unroll") for (int k = 0; k < 2; ++k) \
        acc[ai][bj][m][n] = __builtin_amdgcn_mfma_f32_16x16x32_bf16(Bt[n][k], At[m][k], acc[ai][bj][m][n], 0, 0, 0); __builtin_amdgcn_s_setprio(0); } while (0)
#define PG8_WAIT_V(n) asm volatile("s_waitcnt vmcnt(" #n ")" ::: "memory")
#define PG8_WAIT_L(n) asm volatile("s_waitcnt lgkmcnt(" #n ")" ::: "memory")
#define PG8_BAR __builtin_amdgcn_s_barrier()
#define PG8_SCHED __builtin_amdgcn_sched_barrier(0)
    Unit cur, nxt; int ui = 0;
    if (!S.next(0, cur)) return;
    f32x4 acc[2][2][4][2];
#pragma unroll
    for (int a = 0; a < 2; ++a)
#pragma unroll
        for (int b = 0; b < 2; ++b)
#pragma unroll
            for (int m = 0; m < 4; ++m)
#pragma unroll
                for (int n = 0; n < 2; ++n) acc[a][b][m][n] = (f32x4){0.f, 0.f, 0.f, 0.f};
    bf16x8 At[4][2], B0[2][2], B1[2][2];
    const char* cA = (const char*)g.A + (size_t)cur.pm * tstepA; const char* cB = (const char*)g.Bt + (size_t)cur.pn * tstep;
    S.a_ready(cur);
    if constexpr (SP2) {
        PG8_STAGE(PG8_SB(0, 0), cB, voffB); PG8_STAGE(PG8_SB(0, 1), cB + hstep, voffB); PG8_STAGE(PG8_SA(0, 0), cA, voffA); PG8_STAGE(PG8_SA(0, 1), cA + hstep, voffA);
        if (wr == 1) PG8_BAR;
        PG8_WAIT_V(2); PG8_BAR;
        PG8_STAGE(PG8_SB(1, 0), cB + kstep, voffB); PG8_STAGE(PG8_SA(1, 0), cA + kstep, voffA); PG8_STAGE(PG8_SB(1, 1), cB + hstep + kstep, voffB);
        PG8_WAIT_V(6); PG8_BAR;
    } else {
        PG8_STAGE(PG8_SB(0, 0), cB, voffB); PG8_STAGE(PG8_SA(0, 0), cA, voffA); PG8_STAGE(PG8_SB(0, 1), cB + hstep, voffB); PG8_STAGE(PG8_SA(0, 1), cA + hstep, voffA);
        if (wr == 1) PG8_BAR;
        PG8_WAIT_V(4); PG8_BAR;
        PG8_STAGE(PG8_SB(1, 0), cB + kstep, voffB); PG8_STAGE(PG8_SA(1, 0), cA + kstep, voffA); PG8_STAGE(PG8_SB(1, 1), cB + hstep + kstep, voffB);
        PG8_WAIT_V(6); PG8_BAR;
    }
    for (;;) {
        const bool has_next = S.next(ui + 1, nxt);
        const char* nA = has_next ? (const char*)g.A + (size_t)nxt.pm * tstepA : cA; const char* nB = has_next ? (const char*)g.Bt + (size_t)nxt.pn * tstep : cB;
        _Pragma("nounroll") for (int t = 0; t < nt; t += 2) {
            const bool last = (t == nt - 2);
            const char* a1 = cA + (size_t)(t + 1) * kstep;
            const char* a2 = last ? nA : cA + (size_t)(t + 2) * kstep; const char* b2 = last ? nB : cB + (size_t)(t + 2) * kstep;
            const char* a3 = a2 + kstep; const char* b3 = b2 + kstep;
            if (last && has_next) S.a_ready(nxt);
            if constexpr (SP2) {
            PG8_LDB(B0, 0, 0); PG8_LDB(B1, 0, 1); PG8_SCHED; PG8_LDA(At, 0, 0); PG8_STAGE(PG8_SA(1, 1), a1 + hstep, voffA);
            PG8_WAIT_V(8); PG8_WAIT_L(0); PG8_BAR; PG8_MMA(0, 0, At, B0); PG8_MMA(0, 1, At, B1); PG8_BAR; PG8_SCHED;
            PG8_LDA(At, 0, 1); PG8_STAGE(PG8_SB(0, 0), b2, voffB); PG8_STAGE(PG8_SB(0, 1), b2 + hstep, voffB); PG8_STAGE(PG8_SA(0, 0), a2, voffA);
            PG8_WAIT_V(8); PG8_WAIT_L(0); PG8_BAR; PG8_MMA(1, 0, At, B0); PG8_MMA(1, 1, At, B1); PG8_BAR; PG8_SCHED;
            PG8_LDB(B0, 1, 0); PG8_LDB(B1, 1, 1); PG8_SCHED; PG8_LDA(At, 1, 0); PG8_STAGE(PG8_SA(0, 1), a2 + hstep, voffA);
            PG8_WAIT_V(8); PG8_WAIT_L(0); PG8_BAR; PG8_MMA(0, 0, At, B0); PG8_MMA(0, 1, At, B1); PG8_BAR; PG8_SCHED;
            PG8_LDA(At, 1, 1); PG8_STAGE(PG8_SB(1, 0), b3, voffB); PG8_STAGE(PG8_SB(1, 1), b3 + hstep, voffB); PG8_STAGE(PG8_SA(1, 0), a3, voffA);
            PG8_WAIT_V(8); PG8_WAIT_L(0); PG8_BAR; PG8_MMA(1, 0, At, B0); PG8_MMA(1, 1, At, B1); PG8_BAR; PG8_SCHED;
            } else {
            PG8_LDB(B0, 0, 0); PG8_SCHED; PG8_LDA(At, 0, 0); PG8_STAGE(PG8_SA(1, 1), a1 + hstep, voffA);
            PG8_WAIT_L(8); PG8_BAR; PG8_WAIT_L(0); PG8_MMA(0, 0, At, B0); PG8_BAR; PG8_SCHED;
            PG8_LDB(B1, 0, 1); PG8_STAGE(PG8_SB(0, 0), b2, voffB);
            PG8_BAR; PG8_WAIT_L(0); PG8_MMA(0, 1, At, B1); PG8_BAR;
            PG8_LDA(At, 0, 1); PG8_STAGE(PG8_SA(0, 0), a2, voffA);
            PG8_BAR; PG8_WAIT_L(0); PG8_MMA(1, 0, At, B0); PG8_BAR; PG8_SCHED;
            PG8_STAGE(PG8_SB(0, 1), b2 + hstep, voffB);
            PG8_WAIT_V(6); PG8_BAR; PG8_MMA(1, 1, At, B1); PG8_BAR;
            PG8_LDB(B0, 1, 0); PG8_SCHED; PG8_LDA(At, 1, 0); PG8_STAGE(PG8_SA(0, 1), a2 + hstep, voffA);
            PG8_WAIT_L(8); PG8_BAR; PG8_WAIT_L(0); PG8_MMA(0, 0, At, B0); PG8_BAR; PG8_SCHED;
            PG8_LDB(B1, 1, 1); PG8_STAGE(PG8_SB(1, 0), b3, voffB);
            PG8_BAR; PG8_WAIT_L(0); PG8_MMA(0, 1, At, B1); PG8_BAR;
            PG8_LDA(At, 1, 1); PG8_STAGE(PG8_SA(1, 0), a3, voffA);
            PG8_BAR; PG8_WAIT_L(0); PG8_MMA(1, 0, At, B0); PG8_BAR; PG8_SCHED;
            PG8_STAGE(PG8_SB(1, 1), b3 + hstep, voffB);
            PG8_WAIT_V(6); PG8_BAR; PG8_MMA(1, 1, At, B1); PG8_BAR;
            }
        }
        if constexpr (ALIGN_EPI) { if (wr == 0) PG8_BAR; }
        if constexpr (!Epi::AFTER_DRAIN) { E(acc, cur, wr, wc, fr, fq); S.done(cur); }
        if (!has_next) break;
#pragma unroll
        for (int a = 0; a < 2; ++a)
#pragma unroll
            for (int b = 0; b < 2; ++b)
#pragma unroll
                for (int m = 0; m < 4; ++m)
#pragma unroll
                    for (int n = 0; n < 2; ++n) acc[a][b][m][n] = (f32x4){0.f, 0.f, 0.f, 0.f};
        cur = nxt; cA = nA; cB = nB; ++ui;
        if constexpr (ALIGN_EPI) { if (wr == 1) PG8_BAR; }
    }
    PG8_WAIT_V(0);
    if constexpr (!ALIGN_EPI) { if (wr == 0) PG8_BAR; }
    PG8_BAR;
    if constexpr (Epi::AFTER_DRAIN) { E.fused(acc, cur, wr, wc, fr, fq, lds, wid, lane); S.done(cur); }
#undef PG8_SA
#undef PG8_SB
#undef PG8_STAGE
#undef PG8_LDA
#undef PG8_LDB
#undef PG8_MMA
#undef PG8_WAIT_V
#undef PG8_WAIT_L
#undef PG8_BAR
#undef PG8_SCHED
}
}

#define LAS __attribute__((address_space(3)))
using pg8::bf16_t; using pg8::f32x4; using pg8::u32x4; using pg8::bf16x8; using pg8::Unit;
typedef float f32x16 __attribute__((ext_vector_type(16)));
typedef unsigned u32x2 __attribute__((ext_vector_type(2)));

constexpr int M = 16384, SEQ = 8192, DM = 1024, DFF = 2816, DFF2 = 5632;
constexpr float EPS = 1e-6f;
constexpr int NTHREADS = 512, NWAVES = 8;
constexpr int LDS_BYTES = 147456;
constexpr int HALO_OFF = 131072;
constexpr int XMISC_OFF = 131072 + 12288;
constexpr float QSCALE = 0.07216878364870323f * 1.4426950408889634f;

constexpr size_t MiB = 1u << 20;
constexpr size_t WS_LBT = 0;
constexpr size_t WS_INVF = 16384;
constexpr size_t WS_BAR = 32768, WS_BAR_BYTES = 16384;
constexpr size_t WS_WHIN = 2 * MiB;
constexpr size_t WS_WHOUT = 18 * MiB;
constexpr size_t WS_WMIN = 22 * MiB;
constexpr size_t WS_WQ = 25 * MiB;
constexpr size_t WS_WKN = 27 * MiB;
constexpr size_t WS_WV = 28 * MiB;
constexpr size_t WS_WMOUT = 29 * MiB;
constexpr size_t WS_WUP = 33 * MiB;
constexpr size_t WS_WDN = 44 * MiB;
constexpr size_t WS_XB = 50 * MiB + 65536;
constexpr size_t WS_R = 83 * MiB;
constexpr size_t WS_QH = WS_R, WS_VH = WS_R + 32 * MiB, WS_GH = WS_R + 64 * MiB, WS_LF = WS_R + 96 * MiB, WS_ST = WS_R + 160 * MiB, WS_DL = WS_R + 224 * MiB;
constexpr size_t WS_CQ = WS_R, WS_CKV = WS_R + 8 * MiB, WS_KR = WS_R + 16 * MiB, WS_QF = WS_R + 20 * MiB, WS_KN = WS_R + 68 * MiB, WS_VT = WS_R + 100 * MiB, WS_KF = WS_R + 132 * MiB;
constexpr size_t WS_HF = WS_R;
constexpr size_t WS_SSQ = WS_R + 226 * MiB;
constexpr size_t WS_SSQCQ = WS_SSQ + 9 * 16 * (size_t)M * 4;
constexpr size_t WS_SSQCKV = WS_SSQCQ + 2 * 4 * (size_t)M * 4;
constexpr size_t WS_SSQKR = WS_SSQCKV + 2 * (size_t)M * 4;
constexpr size_t WS_NEED = WS_R + 238 * MiB;
static_assert(WS_SSQCKV + 2 * 4 * (size_t)M * 4 <= WS_NEED && WS_SSQCKV == WS_SSQCQ + 8 * (size_t)M * 4 && WS_SSQKR == WS_SSQCQ + 10 * (size_t)M * 4, "ws map");

struct Args { const void* in[20]; float* out; unsigned char* ws; };

__device__ __forceinline__ float bf2f(unsigned v) { return __uint_as_float(v << 16); }
__device__ __forceinline__ float bflo(unsigned w) { return __uint_as_float(w << 16); }
__device__ __forceinline__ float bfhi(unsigned w) { return __uint_as_float(w & 0xffff0000u); }
typedef float f32x2_t __attribute__((ext_vector_type(2))); typedef __bf16 bf16x2_t __attribute__((ext_vector_type(2)));
__device__ __forceinline__ unsigned pk2c(float lo, float hi) { f32x2_t v = {lo, hi}; bf16x2_t b = __builtin_convertvector(v, bf16x2_t); return __builtin_bit_cast(unsigned, b); }
__device__ __forceinline__ unsigned pk2(float lo, float hi) { return pk2c(lo, hi); }
__device__ __forceinline__ u32x4 pack8(const f32x4& a, const f32x4& b) { u32x4 w; w.x = pk2(a[0], a[1]); w.y = pk2(a[2], a[3]); w.z = pk2(b[0], b[1]); w.w = pk2(b[2], b[3]); return w; }
__device__ __forceinline__ float sigm_f(float x) { return __builtin_amdgcn_rcpf(1.f + __expf(-x)); }
__device__ __forceinline__ float silu_f(float x) { return x * sigm_f(x); }
__device__ __forceinline__ float wave_sum(float v) {
#pragma unroll
    for (int o = 1; o < 64; o <<= 1) v += __shfl_xor(v, o);
    return v;
}
#define LDS_WAIT() asm volatile("s_waitcnt lgkmcnt(0)" ::: "memory")
template <int NS> __device__ __forceinline__ float ssq_sum(const float* p, int r) {
    float s = 0.f;
#pragma unroll
    for (int k = 0; k < NS; ++k) s += p[(size_t)k * M + r];
    return s;
}

__device__ __forceinline__ void rope_cs(float ang, float& c, float& s) {
    const float n = rintf(ang * 0.15915494309189535f);
    float r = fmaf(-n, 6.2831855f, ang); r = fmaf(-n, -1.7484555e-7f, r);
    c = __cosf(r); s = __sinf(r);
}
namespace epi {
using namespace pg8;

__device__ __forceinline__ void wg_row_ssq(LAS float* part, const float (&ss)[2][4], int wr, int wc, int fr, int fq, float* dst, int rowbase) {
    if (fq == 0) {
#pragma unroll
        for (int ai = 0; ai < 2; ++ai)
#pragma unroll
            for (int m = 0; m < 4; ++m) part[(ai * 128 + wr * 64 + m * 16 + fr) * 4 + wc] = ss[ai][m];
    }
    asm volatile("s_waitcnt lgkmcnt(0)" ::: "memory"); __builtin_amdgcn_s_barrier(); asm volatile("" ::: "memory");
    if (wc == 0 && fq == 0) {
#pragma unroll
        for (int ai = 0; ai < 2; ++ai)
#pragma unroll
            for (int m = 0; m < 4; ++m) { const int row = ai * 128 + wr * 64 + m * 16 + fr; const f32x4 v = *(const LAS f32x4*)(part + row * 4); dst[rowbase + row] = (v[0] + v[1]) + (v[2] + v[3]); }
    }
}

struct EpiResid {
    static constexpr bool PERM = true, AFTER_DRAIN = false;
    const float* xin; float* xout; bf16_t* xb; float* ssq; LAS float* part;
    __device__ __forceinline__ void operator()(f32x4 (&acc)[2][2][4][2], const Unit& u, int wr, int wc, int fr, int fq) const {
        int row0 = u.pm * 256 + wr * 64 + fr, col0 = u.pn * 256 + wc * 32 + 8 * fq;
        asm volatile("" : "+v"(row0), "+v"(col0));
        float ssv[2][4];
#pragma unroll
        for (int ai = 0; ai < 2; ++ai)
#pragma unroll
            for (int m = 0; m < 4; ++m) {
                const int r = row0 + ai * 128 + m * 16; float ss = 0.f;
#pragma unroll
                for (int bj = 0; bj < 2; ++bj) {
                    const size_t off = (size_t)r * 1024 + col0 + bj * 128;
                    f32x4 a = *(const f32x4*)(xin + off), b = *(const f32x4*)(xin + off + 4);
                    a += acc[ai][bj][m][0]; b += acc[ai][bj][m][1];
                    *(f32x4*)(xout + off) = a; *(f32x4*)(xout + off + 4) = b;
                    ss += ((a[0] * a[0] + a[1] * a[1]) + (a[2] * a[2] + a[3] * a[3])) + ((b[0] * b[0] + b[1] * b[1]) + (b[2] * b[2] + b[3] * b[3]));
                    if (xb) *(u32x4*)(xb + off) = pack8(a, b);
                }
                ss += __shfl_xor(ss, 16); ss += __shfl_xor(ss, 32); ssv[ai][m] = ss;
                if (m & 1) asm volatile("" ::: "memory");
            }
        if (ssq) wg_row_ssq(part, ssv, wr, wc, fr, fq, ssq + (size_t)u.pn * M, u.pm * 256);
    }
};

struct EpiHgrnIn {
    static constexpr bool PERM = true, AFTER_DRAIN = false;
    const float* ssq; const float* lb; bf16_t* Q; bf16_t* V; bf16_t* G; float* LF;
    __device__ __forceinline__ void operator()(f32x4 (&acc)[2][2][4][2], const Unit& u, int wr, int wc, int fr, int fq) const {
        const int sec = u.pn >> 2;
        int row0 = u.pm * 256 + wr * 64 + fr, c0 = (u.pn & 3) * 256 + wc * 32 + 8 * fq;
        asm volatile("" : "+v"(row0), "+v"(c0));
        f32x4 l0[2], l1[2];
#pragma unroll
        for (int bj = 0; bj < 2; ++bj) { l0[bj] = *(const f32x4*)(lb + c0 + bj * 128); l1[bj] = *(const f32x4*)(lb + c0 + bj * 128 + 4); }
        float rsv[2][4];
#pragma unroll
        for (int ai = 0; ai < 2; ++ai)
#pragma unroll
            for (int m = 0; m < 4; ++m) rsv[ai][m] = rsqrtf(ssq_sum<4>(ssq, row0 + ai * 128 + m * 16) * (1.f / 1024.f) + EPS);
        asm volatile("" ::: "memory");
#pragma unroll
        for (int ai = 0; ai < 2; ++ai)
#pragma unroll
            for (int m = 0; m < 4; ++m) {
                const int r = row0 + ai * 128 + m * 16; const float rs = rsv[ai][m];
#pragma unroll
                for (int bj = 0; bj < 2; ++bj) {
                    const size_t off = (size_t)r * 1024 + c0 + bj * 128;
                    f32x4 a = acc[ai][bj][m][0] * rs, b = acc[ai][bj][m][1] * rs;
                    if (sec == 1) {
#pragma unroll
                        for (int j = 0; j < 4; ++j) {
                            const float sa = sigm_f(a[j]), sb = sigm_f(b[j]);
                            a[j] = __logf(l0[bj][j] + (1.f - l0[bj][j]) * sa); b[j] = __logf(l1[bj][j] + (1.f - l1[bj][j]) * sb);
                        }
                        *(f32x4*)(LF + off) = a; *(f32x4*)(LF + off + 4) = b;
                    } else if (sec == 2) {
                        *(u32x4*)(V + off) = pack8(a, b);
                    } else {
#pragma unroll
                        for (int j = 0; j < 4; ++j) { a[j] = silu_f(a[j]); b[j] = silu_f(b[j]); }
                        *(u32x4*)((sec == 0 ? Q : G) + off) = pack8(a, b);
                    }
                }
            }
    }
};

struct EpiMlaIn {
    static constexpr bool PERM = true, AFTER_DRAIN = false;
    const float* ssq; bf16_t* CQ; bf16_t* CKV; float* KR; float* ssq_cq; float* ssq_ckv; float* ssq_kr; LAS float* part;
    __device__ __forceinline__ void operator()(f32x4 (&acc)[2][2][4][2], const Unit& u, int wr, int wc, int fr, int fq) const {
        int row0 = u.pm * 256 + wr * 64 + fr, cl = wc * 32 + 8 * fq;
        asm volatile("" : "+v"(row0), "+v"(cl));
        float ssv[2][4], rsv[2][4];
#pragma unroll
        for (int ai = 0; ai < 2; ++ai)
#pragma unroll
            for (int m = 0; m < 4; ++m) rsv[ai][m] = rsqrtf(ssq_sum<4>(ssq, row0 + ai * 128 + m * 16) * (1.f / 1024.f) + EPS);
        asm volatile("" ::: "memory");
#pragma unroll
        for (int ai = 0; ai < 2; ++ai)
#pragma unroll
            for (int m = 0; m < 4; ++m) {
                const int r = row0 + ai * 128 + m * 16; const float rs = rsv[ai][m];
                ssv[ai][m] = 0.f;
                if (u.pn < 2) {
                    bf16_t* dst = u.pn == 0 ? CQ : CKV; float ss = 0.f;
#pragma unroll
                    for (int bj = 0; bj < 2; ++bj) {
                        const f32x4 a = acc[ai][bj][m][0] * rs, b = acc[ai][bj][m][1] * rs;
                        ss += ((a[0] * a[0] + a[1] * a[1]) + (a[2] * a[2] + a[3] * a[3])) + ((b[0] * b[0] + b[1] * b[1]) + (b[2] * b[2] + b[3] * b[3]));
                        *(u32x4*)(dst + (size_t)r * 256 + cl + bj * 128) = pack8(a, b);
                    }
                    ss += __shfl_xor(ss, 16); ss += __shfl_xor(ss, 32); ssv[ai][m] = ss;
                } else if (cl < 64) {
                    const f32x4 a = acc[ai][0][m][0] * rs, b = acc[ai][0][m][1] * rs;
                    *(f32x4*)(KR + (size_t)r * 64 + cl) = a; *(f32x4*)(KR + (size_t)r * 64 + cl + 4) = b;
                    float ss = ((a[0] * a[0] + a[1] * a[1]) + (a[2] * a[2] + a[3] * a[3])) + ((b[0] * b[0] + b[1] * b[1]) + (b[2] * b[2] + b[3] * b[3]));
                    ss += __shfl_xor(ss, 16); ss += __shfl_xor(ss, 32); ssv[ai][m] = ss;
                }
            }
        wg_row_ssq(part, ssv, wr, wc, fr, fq, ssq_cq + (u.pn == 0 ? 0 : (u.pn == 1 ? 8 * M : 10 * M)), u.pm * 256);
    }
};

struct EpiKFinal {
    static constexpr bool PERM = true, AFTER_DRAIN = false;
    const float* ssq_ckv; const float* ssq_kr; const float* KR; const int* pos; const float* invf; const float* kg; bf16_t* KF; LAS float* part;
    __device__ __forceinline__ void operator()(f32x4 (&acc)[2][2][4][2], const Unit& u, int wr, int wc, int fr, int fq) const {
        int row0 = u.pm * 256 + wr * 64 + fr, cl = wc * 32 + 8 * fq;
        asm volatile("" : "+v"(row0), "+v"(cl));
#pragma unroll
        for (int ai = 0; ai < 2; ++ai)
#pragma unroll
            for (int m = 0; m < 4; ++m) {
                const int r = row0 + ai * 128 + m * 16; const float rs = rsqrtf(ssq_ckv[r] * (1.f / 256.f) + EPS);
#pragma unroll
                for (int bj = 0; bj < 2; ++bj) {
                    acc[ai][bj][m][0] *= rs; acc[ai][bj][m][1] *= rs;
                    const f32x4 a = acc[ai][bj][m][0], b = acc[ai][bj][m][1];
                    float ss = ((a[0] * a[0] + a[1] * a[1]) + (a[2] * a[2] + a[3] * a[3])) + ((b[0] * b[0] + b[1] * b[1]) + (b[2] * b[2] + b[3] * b[3]));
                    ss += __shfl_xor(ss, 16); ss += __shfl_xor(ss, 32);
                    if (fq == 0) part[((ai * 128 + wr * 64 + m * 16 + fr) * 2 + bj) * 4 + wc] = ss;
                }
            }
        asm volatile("s_waitcnt lgkmcnt(0)" ::: "memory"); __builtin_amdgcn_s_barrier(); asm volatile("" ::: "memory");
        const int i0 = 2 * (4 * wc + fq);
        const f32x4 g0 = *(const f32x4*)(kg + cl), g1 = *(const f32x4*)(kg + cl + 4);
        const float ga0 = kg[128 + i0], ga1 = kg[129 + i0], gb0 = kg[160 + i0], gb1 = kg[161 + i0], f0 = invf[i0], f1 = invf[i0 + 1];
#pragma unroll
        for (int ai = 0; ai < 2; ++ai)
#pragma unroll
            for (int m = 0; m < 4; ++m) {
                const int rl = ai * 128 + wr * 64 + m * 16 + fr, r = u.pm * 256 + rl;
                const float skr = ssq_kr[r]; const float pf = (float)pos[r];
                const f32x2_t x1 = *(const f32x2_t*)(KR + (size_t)r * 64 + i0), x2 = *(const f32x2_t*)(KR + (size_t)r * 64 + 32 + i0);
                float c0, s0, c1, s1; rope_cs(pf * f0, c0, s0); rope_cs(pf * f1, c1, s1);
#pragma unroll
                for (int bj = 0; bj < 2; ++bj) {
                    const f32x4 v = *(const LAS f32x4*)(part + (rl * 2 + bj) * 4);
                    const float rstd = rsqrtf((((v[0] + v[1]) + (v[2] + v[3])) + skr) * (1.f / 192.f) + EPS);
                    bf16_t* kp = KF + (size_t)r * 1536 + (2 * u.pn + bj) * 192;
                    const f32x4 a = acc[ai][bj][m][0] * rstd * g0, b = acc[ai][bj][m][1] * rstd * g1;
                    *(u32x4*)(kp + cl) = pack8(a, b);
                    const float y10 = x1.x * rstd * ga0, y11 = x1.y * rstd * ga1, y20 = x2.x * rstd * gb0, y21 = x2.y * rstd * gb1;
                    *(unsigned*)(kp + 128 + i0) = pk2(y10 * c0 - y20 * s0, y11 * c1 - y21 * s1);
                    *(unsigned*)(kp + 160 + i0) = pk2(y20 * c0 + y10 * s0, y21 * c1 + y11 * s1);
                }
            }
    }
};

template <bool ROW> struct EpiScale {
    static constexpr bool PERM = true, AFTER_DRAIN = false;
    const float* ssq; float inv_n; bf16_t* O; int ldc;
    __device__ __forceinline__ void operator()(f32x4 (&acc)[2][2][4][2], const Unit& u, int wr, int wc, int fr, int fq) const {
        int row0 = u.pm * 256 + wr * 64 + fr, col0 = u.pn * 256 + wc * 32 + 8 * fq;
        asm volatile("" : "+v"(row0), "+v"(col0));
        f32x4 c0[2], c1[2];
#pragma unroll
        for (int bj = 0; bj < 2; ++bj) {
            if (!ROW) {
                const f32x4 s0 = *(const f32x4*)(ssq + col0 + bj * 128), s1 = *(const f32x4*)(ssq + col0 + bj * 128 + 4);
#pragma unroll
                for (int j = 0; j < 4; ++j) { c0[bj][j] = rsqrtf(s0[j] * inv_n + EPS); c1[bj][j] = rsqrtf(s1[j] * inv_n + EPS); }
            } else { c0[bj] = (f32x4){1.f, 1.f, 1.f, 1.f}; c1[bj] = c0[bj]; }
        }
        float rsv[2][4];
#pragma unroll
        for (int ai = 0; ai < 2; ++ai)
#pragma unroll
            for (int m = 0; m < 4; ++m) rsv[ai][m] = ROW ? rsqrtf(ssq[row0 + ai * 128 + m * 16] * inv_n + EPS) : 1.f;
        asm volatile("" ::: "memory");
#pragma unroll
        for (int ai = 0; ai < 2; ++ai)
#pragma unroll
            for (int m = 0; m < 4; ++m) {
                const int r = row0 + ai * 128 + m * 16; const float rs = rsv[ai][m];
#pragma unroll
                for (int bj = 0; bj < 2; ++bj) {
                    const f32x4 a = acc[ai][bj][m][0] * rs * c0[bj], b = acc[ai][bj][m][1] * rs * c1[bj];
                    *(u32x4*)(O + (size_t)r * ldc + col0 + bj * 128) = pack8(a, b);
                }
            }
    }
};

template <int CTRL> __device__ __forceinline__ float dpp_mov(float old, float src) {
    return __builtin_bit_cast(float, __builtin_amdgcn_update_dpp(__builtin_bit_cast(int, old), __builtin_bit_cast(int, src), CTRL, 0xf, 0xf, false));
}

struct EpiFfnUp {
    static constexpr bool PERM = true, AFTER_DRAIN = false;
    const float* ssq; const float* cw; const float* cb; bf16_t* HF; LAS float* halo;
    __device__ __forceinline__ void operator()(f32x4 (&acc)[2][2][4][2], const Unit& u, int wr, int wc, int fr, int fq) const {
        int gr0 = u.pm * 254 - 2 + wr * 64 + fr;
        int cl = wc * 32 + 8 * fq;
        asm volatile("" : "+v"(gr0), "+v"(cl));
#pragma unroll
        for (int ai = 0; ai < 2; ++ai)
#pragma unroll
            for (int m = 0; m < 4; ++m) {
                const int gr = gr0 + ai * 128 + m * 16;
                const bool vr = (gr >= 0 && gr < M);
                const float rs = rsqrtf(ssq_sum<4>(ssq, vr ? gr : 0) * (1.f / 1024.f) + EPS);
#pragma unroll
                for (int bj = 0; bj < 2; ++bj)
#pragma unroll
                    for (int n = 0; n < 2; ++n) acc[ai][bj][m][n] = vr ? acc[ai][bj][m][n] * rs : (f32x4){0.f, 0.f, 0.f, 0.f};
                asm volatile("" ::: "memory");
            }
        if (fr >= 14) {
#pragma unroll
            for (int ai = 0; ai < 2; ++ai)
#pragma unroll
                for (int bj = 0; bj < 2; ++bj)
#pragma unroll
                    for (int n = 0; n < 2; ++n) *(LAS f32x4*)(halo + (((2 * ai + wr) * 2 + (fr - 14)) * 256 + bj * 128 + cl + 4 * n)) = acc[ai][bj][3][n];
        }
        asm volatile("s_waitcnt lgkmcnt(0)" ::: "memory"); __builtin_amdgcn_s_barrier(); asm volatile("" ::: "memory");
        const int ch = u.pn * 128 + cl;
#pragma unroll
        for (int n = 0; n < 2; ++n) {
            f32x4 w0[2], w1[2], w2[2], bb[2];
#pragma unroll
            for (int bj = 0; bj < 2; ++bj) {
                const int ci = bj * DFF + ch + 4 * n;
                w0[bj] = *(const f32x4*)(cw + ci); w1[bj] = *(const f32x4*)(cw + DFF2 + ci); w2[bj] = *(const f32x4*)(cw + 2 * DFF2 + ci); bb[bj] = *(const f32x4*)(cb + ci);
            }
#pragma unroll
            for (int ai = 0; ai < 2; ++ai) {
                asm volatile("" : "+v"(gr0));
                const int g = 2 * ai + wr;
                f32x4 pm[2];
#pragma unroll
                for (int bj = 0; bj < 2; ++bj) {
                    pm[bj] = (f32x4){0.f, 0.f, 0.f, 0.f};
                    if (g > 0 && fr >= 14) pm[bj] = *(const LAS f32x4*)(halo + ((((g - 1) * 2) + (fr - 14)) * 256 + bj * 128 + cl + 4 * n));
                }
#pragma unroll
                for (int m = 0; m < 4; ++m) {
                    const int gr = gr0 + ai * 128 + m * 16; const int t = gr & (SEQ - 1);
                    const float k1 = (t >= 1) ? 1.f : 0.f, k2 = (t >= 2) ? 1.f : 0.f;
                    f32x4 y[2];
#pragma unroll
                    for (int bj = 0; bj < 2; ++bj)
#pragma unroll
                        for (int j = 0; j < 4; ++j) {
                            const float cur = acc[ai][bj][m][n][j], pv = pm[bj][j];
                            const float p1 = dpp_mov<0x111>(dpp_mov<0x121>(0.f, pv), cur);
                            const float p2 = dpp_mov<0x112>(dpp_mov<0x122>(0.f, pv), cur);
                            y[bj][j] = bb[bj][j] + w0[bj][j] * (k2 != 0.f ? p2 : 0.f) + w1[bj][j] * (k1 != 0.f ? p1 : 0.f) + w2[bj][j] * cur;
                        }
                    f32x4 h0;
#pragma unroll
                    for (int j = 0; j < 4; ++j) h0[j] = silu_f(y[0][j]) * y[1][j];
                    const bool owned = !(ai == 0 && wr == 0 && m == 0 && fr < 2) && gr < M;
                    if (owned) { u32x2 w; w.x = pk2(h0[0], h0[1]); w.y = pk2(h0[2], h0[3]); *(u32x2*)(HF + (size_t)gr * DFF + ch + 4 * n) = w; }
#pragma unroll
                    for (int bj = 0; bj < 2; ++bj) pm[bj] = acc[ai][bj][m][n];
                    if (m & 1) asm volatile("" ::: "memory");
                }
            }
        }
    }
};
}

__device__ __forceinline__ void cvt_item(const float* W, int ldn, int scol0, int k0, const float* gain, bf16_t* WT, int K, int drow0, LAS float* scr, int lane) {
#pragma unroll 8
    for (int i = 0; i < 32; ++i) {
        const int kk = 2 * i + (lane >> 5);
        float v = W[(size_t)(k0 + kk) * ldn + scol0 + (lane & 31)];
        if (gain) v *= gain[k0 + kk];
        scr[kk * 33 + (lane & 31)] = v;
    }
    LDS_WAIT(); asm volatile("" ::: "memory");
    const int c = lane & 7;
#pragma unroll
    for (int j = 0; j < 4; ++j) {
        const int n = (lane >> 3) + 8 * j; const LAS float* s = scr + (8 * c) * 33 + n;
        u32x4 o; o.x = pk2(s[0 * 33], s[1 * 33]); o.y = pk2(s[2 * 33], s[3 * 33]); o.z = pk2(s[4 * 33], s[5 * 33]); o.w = pk2(s[6 * 33], s[7 * 33]);
        *(u32x4*)(WT + (size_t)(drow0 + n) * K + k0 + 8 * c) = o;
    }
    LDS_WAIT(); asm volatile("" ::: "memory");
}
__device__ __forceinline__ int cvt_map(int map, int drow0) {
    if (map == 1) return (drow0 >> 7) * 256 + (drow0 & 127);
    if (map == 2) return (drow0 >> 7) * 256 + 128 + (drow0 & 127);
    if (map == 3) return ((drow0 >> 7) & 1) * DFF + (drow0 >> 8) * 128 + (drow0 & 127);
    return drow0;
}
__device__ __forceinline__ void cvt_item2(const float* W, int ldn, int scolA, int kA, int scolB, int kB, bool hasB, const float* gain, bf16_t* WT, int K, int drowA, int drowB, LAS float* scr, int lane) {
    LAS float* scrB = scr + 64 * 33;
    float va[32], vb[32];
#pragma unroll
    for (int i = 0; i < 32; ++i) { const int kk = 2 * i + (lane >> 5); va[i] = W[(size_t)(kA + kk) * ldn + scolA + (lane & 31)]; }
    if (hasB) {
#pragma unroll
        for (int i = 0; i < 32; ++i) { const int kk = 2 * i + (lane >> 5); vb[i] = W[(size_t)(kB + kk) * ldn + scolB + (lane & 31)]; }
    }
#pragma unroll
    for (int i = 0; i < 32; ++i) { const int kk = 2 * i + (lane >> 5); float v = va[i]; if (gain) v *= gain[kA + kk]; scr[kk * 33 + (lane & 31)] = v; }
    if (hasB) {
#pragma unroll
        for (int i = 0; i < 32; ++i) { const int kk = 2 * i + (lane >> 5); float v = vb[i]; if (gain) v *= gain[kB + kk]; scrB[kk * 33 + (lane & 31)] = v; }
    }
    LDS_WAIT(); asm volatile("" ::: "memory");
    const int c = lane & 7;
#pragma unroll
    for (int j = 0; j < 4; ++j) {
        const int n = (lane >> 3) + 8 * j; const LAS float* s = scr + (8 * c) * 33 + n;
        u32x4 o; o.x = pk2(s[0 * 33], s[1 * 33]); o.y = pk2(s[2 * 33], s[3 * 33]); o.z = pk2(s[4 * 33], s[5 * 33]); o.w = pk2(s[6 * 33], s[7 * 33]);
        *(u32x4*)(WT + (size_t)(drowA + n) * K + kA + 8 * c) = o;
    }
    if (hasB) {
#pragma unroll
        for (int j = 0; j < 4; ++j) {
            const int n = (lane >> 3) + 8 * j; const LAS float* s = scrB + (8 * c) * 33 + n;
            u32x4 o; o.x = pk2(s[0 * 33], s[1 * 33]); o.y = pk2(s[2 * 33], s[3 * 33]); o.z = pk2(s[4 * 33], s[5 * 33]); o.w = pk2(s[6 * 33], s[7 * 33]);
            *(u32x4*)(WT + (size_t)(drowB + n) * K + kB + 8 * c) = o;
        }
    }
    LDS_WAIT(); asm volatile("" ::: "memory");
}
__device__ __forceinline__ void cvt_job(const float* W, int K, int ldn, const float* gain, bf16_t* WT, int nrows, int map, int& rot, int gw, int NGW, LAS float* scr, int lane) {
    const int nb = nrows / 32, nitems = (K / 64) * nb;
    int start = gw - (rot % NGW); if (start < 0) start += NGW;
    for (int it = start; it < nitems; it += 2 * NGW) {
        const int it2 = it + NGW; const bool hasB = it2 < nitems; const int itb = hasB ? it2 : it;
        const int kbA = it / nb, bA = it % nb, kbB = itb / nb, bB = itb % nb;
        cvt_item2(W, ldn, cvt_map(map, 32 * bA), 64 * kbA, cvt_map(map, 32 * bB), 64 * kbB, hasB, gain, WT, K, 32 * bA, 32 * bB, scr, lane);
    }
    rot += nitems;
}

__device__ __forceinline__ void hgrn_local(LAS unsigned char* lds, const bf16_t* V, const float* LF, bf16_t* ST, float* DL, int G, int bid, unsigned* dgp = nullptr) {
    int tid = threadIdx.x; asm volatile("" : "+v"(tid));
    const int lane = tid & 63, wid = __builtin_amdgcn_readfirstlane(tid >> 6);
    LAS bf16_t* KdT = (LAS bf16_t*)lds;
    LAS bf16_t* VT = (LAS bf16_t*)(lds + 18432);
    LAS float* tot = (LAS float*)(lds + 36864);
    const int d = tid & 127, part = tid >> 7, l15 = lane & 15, q4 = lane >> 4;
    for (int unit = bid; unit < 16 * 127; unit += G) {
        const int bh = unit / 127, n = unit % 127, b = bh >> 3, h = bh & 7;
        const size_t row0 = (size_t)b * SEQ + n * 64 + part * 16;
        const float* lfp = LF + row0 * 1024 + h * 128 + d;
        const bf16_t* vp = V + row0 * 1024 + h * 128 + d;
        float g[16], kk[16]; unsigned vv[16];
#pragma unroll
        for (int j = 0; j < 16; ++j) { g[j] = lfp[(size_t)j * 1024]; vv[j] = vp[(size_t)j * 1024]; }
        float run = 0.f;
#pragma unroll
        for (int j = 0; j < 16; ++j) { kk[j] = 1.f - __expf(g[j]); run += g[j]; g[j] = run; }
        tot[part * 128 + d] = run;
        __syncthreads();
        const float t0 = tot[d], t1 = tot[128 + d], t2 = tot[256 + d], t3 = tot[384 + d];
        const float off = part == 0 ? 0.f : (part == 1 ? t0 : (part == 2 ? t0 + t1 : t0 + t1 + t2));
        const float gl = (t0 + t1) + (t2 + t3);
#pragma unroll
        for (int j = 0; j < 16; ++j) kk[j] *= __expf(gl - (off + g[j]));
#ifdef DIAG_SUBCHK
        { bool bk = false, bv = false;
#pragma unroll
          for (int j = 0; j < 16; ++j) { if (!(fabsf(kk[j]) < 1.01f)) bk = true; if (!(fabsf(bf2f(vv[j])) < 100.f)) bv = true; }
          if (bk) atomicMin(dgp, 51u); if (bv) atomicMin(dgp, 52u); }
#endif
        u32x4 w0, w1, x0, x1;
        w0.x = pk2(kk[0], kk[1]); w0.y = pk2(kk[2], kk[3]); w0.z = pk2(kk[4], kk[5]); w0.w = pk2(kk[6], kk[7]);
        w1.x = pk2(kk[8], kk[9]); w1.y = pk2(kk[10], kk[11]); w1.z = pk2(kk[12], kk[13]); w1.w = pk2(kk[14], kk[15]);
        x0.x = vv[0] | (vv[1] << 16); x0.y = vv[2] | (vv[3] << 16); x0.z = vv[4] | (vv[5] << 16); x0.w = vv[6] | (vv[7] << 16);
        x1.x = vv[8] | (vv[9] << 16); x1.y = vv[10] | (vv[11] << 16); x1.z = vv[12] | (vv[13] << 16); x1.w = vv[14] | (vv[15] << 16);
        *(LAS u32x4*)(KdT + d * 72 + part * 16) = w0; *(LAS u32x4*)(KdT + d * 72 + part * 16 + 8) = w1;
        *(LAS u32x4*)(VT + d * 72 + part * 16) = x0; *(LAS u32x4*)(VT + d * 72 + part * 16 + 8) = x1;
        if (part == 0) DL[(size_t)(bh * 128 + n) * 128 + d] = __expf(gl);
        __syncthreads();
        bf16x8 af[2];
#pragma unroll
        for (int ks = 0; ks < 2; ++ks) af[ks] = *(const LAS bf16x8*)(KdT + (16 * wid + l15) * 72 + 32 * ks + 8 * q4);
        bf16_t* dst = ST + (size_t)(bh * 128 + n) * 16384;
#pragma unroll
        for (int et = 0; et < 8; ++et) {
            f32x4 c = {0.f, 0.f, 0.f, 0.f};
#pragma unroll
            for (int ks = 0; ks < 2; ++ks) {
                const bf16x8 bfr = *(const LAS bf16x8*)(VT + (16 * et + l15) * 72 + 32 * ks + 8 * q4);
                c = __builtin_amdgcn_mfma_f32_16x16x32_bf16(af[ks], bfr, c, 0, 0, 0);
            }
#ifdef DIAG_SUBCHK
            { bool bc = false;
#pragma unroll
              for (int r = 0; r < 4; ++r) if (!(fabsf(c[r]) < 1e5f)) bc = true;
              if (bc) atomicMin(dgp, 53u); }
#endif
            u32x2 o; o.x = pk2c(c[0], c[1]); o.y = pk2c(c[2], c[3]);
            *(u32x2*)(dst + (size_t)(16 * et + l15) * 128 + 16 * wid + 4 * q4) = o;
        }
    }
}

__device__ __forceinline__ void hgrn_scan(bf16_t* ST, const float* DL, int gtid, int gthreads) {
    for (int item = gtid; item < 16 * 8192; item += gthreads) {
        const int bh = item >> 13, idx = (item & 8191) * 2, d = idx & 127;
        float s0 = 0.f, s1 = 0.f;
        unsigned* p = (unsigned*)(ST + (size_t)bh * 128 * 16384 + idx);
        const float* dl = DL + (size_t)bh * 128 * 128 + d;
        unsigned w[8], wn[8]; f32x2_t dd[8], dn[8];
#pragma unroll
        for (int i = 0; i < 8; ++i) { w[i] = p[(size_t)i * 8192]; dd[i] = *(const f32x2_t*)(dl + i * 128); }
#pragma unroll 1
        for (int n0 = 0; n0 < 120; n0 += 8) {
            const int m0 = n0 + 8;
#pragma unroll
            for (int i = 0; i < 8; ++i) { const int m = (m0 + i < 127) ? m0 + i : 126; wn[i] = p[(size_t)m * 8192]; dn[i] = *(const f32x2_t*)(dl + m * 128); }
            asm volatile("" ::: "memory");
#pragma unroll
            for (int i = 0; i < 8; ++i) { s0 = s0 * dd[i].x + bflo(w[i]); s1 = s1 * dd[i].y + bfhi(w[i]); p[(size_t)(n0 + i) * 8192] = pk2(s0, s1); }
#pragma unroll
            for (int i = 0; i < 8; ++i) { w[i] = wn[i]; dd[i] = dn[i]; }
        }
#pragma unroll
        for (int i = 0; i < 7; ++i) { s0 = s0 * dd[i].x + bflo(w[i]); s1 = s1 * dd[i].y + bfhi(w[i]); p[(size_t)(120 + i) * 8192] = pk2(s0, s1); }
    }
}

__device__ __forceinline__ void hgrn_out(LAS unsigned char* lds, const bf16_t* Q, const bf16_t* V, const bf16_t* Gt, const float* LF, const bf16_t* ST, const float* onorm, bf16_t* OH, int G, int bid) {
    int tid = threadIdx.x; asm volatile("" : "+v"(tid));
    const int lane = tid & 63, wid = __builtin_amdgcn_readfirstlane(tid >> 6);
    LAS bf16_t* QtS = (LAS bf16_t*)lds;
    LAS bf16_t* KtS = (LAS bf16_t*)(lds + 17408);
    LAS bf16_t* VT = (LAS bf16_t*)(lds + 34816);
    LAS bf16_t* STs = (LAS bf16_t*)(lds + 53248);
    LAS float* tot = (LAS float*)(lds + 88064);
    LAS float* eg = (LAS float*)(lds + 90112);
    LAS float* red = (LAS float*)(lds + 90624);
    const int d = tid & 127, part = tid >> 7, l15 = lane & 15, q4 = lane >> 4;
    const int tb = wid & 3, eh = wid >> 2;
    float rg[16]; unsigned rv[16], rq[16]; u32x4 rs[4];
#define HO_LOAD(unit_) do { const int bh_ = (unit_) >> 7, n_ = (unit_) & 127; const size_t c0_ = ((size_t)(bh_ >> 3) * SEQ + n_ * 64 + part * 16) * 1024 + (bh_ & 7) * 128 + d; \
        _Pragma("unroll") for (int j = 0; j < 16; ++j) { rg[j] = LF[c0_ + (size_t)j * 1024]; rv[j] = V[c0_ + (size_t)j * 1024]; rq[j] = Q[c0_ + (size_t)j * 1024]; } \
        if (n_ > 0) { const bf16_t* stp_ = ST + (size_t)(bh_ * 128 + n_ - 1) * 16384; _Pragma("unroll") for (int i = 0; i < 4; ++i) { const int p_ = tid + 512 * i; rs[i] = *(const u32x4*)(stp_ + (size_t)(p_ >> 4) * 128 + (p_ & 15) * 8); } } } while (0)
    if (bid < 16 * 128) HO_LOAD(bid);
    for (int unit = bid; unit < 16 * 128; unit += G) {
        const int bh = unit >> 7, n = unit & 127, b = bh >> 3, h = bh & 7;
        float g[16], kk[16], qq[16]; unsigned vv[16]; u32x4 sreg[4];
#pragma unroll
        for (int j = 0; j < 16; ++j) { g[j] = rg[j]; vv[j] = rv[j]; qq[j] = bf2f(rq[j]); }
#pragma unroll
        for (int i = 0; i < 4; ++i) sreg[i] = rs[i];
        if (unit + G < 16 * 128) HO_LOAD(unit + G);
        float run = 0.f;
#pragma unroll
        for (int j = 0; j < 16; ++j) { kk[j] = 1.f - __expf(g[j]); run += g[j]; g[j] = run; }
        tot[part * 128 + d] = run;
        __syncthreads();
        const float t0 = tot[d], t1 = tot[128 + d], t2 = tot[256 + d];
        const float off = part == 0 ? 0.f : (part == 1 ? t0 : (part == 2 ? t0 + t1 : t0 + t1 + t2));
        const float gref = t0 + t1;
#pragma unroll
        for (int j = 0; j < 16; ++j) {
            const float gs = off + g[j];
            QtS[(part * 16 + j) * 136 + d] = (bf16_t)(pk2(qq[j] * __expf(gs - gref), 0.f) & 0xffffu);
            KtS[(part * 16 + j) * 136 + d] = (bf16_t)(pk2(kk[j] * __expf(gref - gs), 0.f) & 0xffffu);
        }
        u32x4 x0, x1;
        x0.x = vv[0] | (vv[1] << 16); x0.y = vv[2] | (vv[3] << 16); x0.z = vv[4] | (vv[5] << 16); x0.w = vv[6] | (vv[7] << 16);
        x1.x = vv[8] | (vv[9] << 16); x1.y = vv[10] | (vv[11] << 16); x1.z = vv[12] | (vv[13] << 16); x1.w = vv[14] | (vv[15] << 16);
        *(LAS u32x4*)(VT + d * 72 + part * 16) = x0; *(LAS u32x4*)(VT + d * 72 + part * 16 + 8) = x1;
        if (part == 0) eg[d] = __expf(gref);
        __syncthreads();
        if (n > 0) {
#pragma unroll
            for (int i = 0; i < 4; ++i) {
                const int p = tid + 512 * i, e = p >> 4, c8 = (p & 15) * 8;
                const f32x4 ea = *(const LAS f32x4*)(eg + c8), eb = *(const LAS f32x4*)(eg + c8 + 4);
                u32x4 w = sreg[i], o;
                o.x = pk2(bflo(w.x) * ea[0], bfhi(w.x) * ea[1]); o.y = pk2(bflo(w.y) * ea[2], bfhi(w.y) * ea[3]);
                o.z = pk2(bflo(w.z) * eb[0], bfhi(w.z) * eb[1]); o.w = pk2(bflo(w.w) * eb[2], bfhi(w.w) * eb[3]);
                *(LAS u32x4*)(STs + e * 136 + c8) = o;
            }
        }
        __syncthreads();
        bf16x8 qfr[4];
#pragma unroll
        for (int k4 = 0; k4 < 4; ++k4) qfr[k4] = *(const LAS bf16x8*)(QtS + (16 * tb + l15) * 136 + 32 * k4 + 8 * q4);
        f32x4 sc[4];
#pragma unroll
        for (int si = 0; si < 4; ++si) {
            sc[si] = (f32x4){0.f, 0.f, 0.f, 0.f};
            if (si <= tb) {
#pragma unroll
                for (int k4 = 0; k4 < 4; ++k4) {
                    const bf16x8 kf = *(const LAS bf16x8*)(KtS + (16 * si + l15) * 136 + 32 * k4 + 8 * q4);
                    sc[si] = __builtin_amdgcn_mfma_f32_16x16x32_bf16(kf, qfr[k4], sc[si], 0, 0, 0);
                }
            }
#pragma unroll
            for (int r = 0; r < 4; ++r) if (!(16 * si + 4 * q4 + r <= 16 * tb + l15)) sc[si][r] = 0.f;
        }
        bf16x8 pf[2];
#pragma unroll
        for (int ks = 0; ks < 2; ++ks) {
            u32x4 w; w.x = pk2(sc[2 * ks][0], sc[2 * ks][1]); w.y = pk2(sc[2 * ks][2], sc[2 * ks][3]); w.z = pk2(sc[2 * ks + 1][0], sc[2 * ks + 1][1]); w.w = pk2(sc[2 * ks + 1][2], sc[2 * ks + 1][3]);
            pf[ks] = __builtin_bit_cast(bf16x8, w);
        }
        f32x4 oa[4]; float ss = 0.f;
#pragma unroll
        for (int et = 0; et < 4; ++et) {
            const int erow = 64 * eh + 16 * et + l15;
            oa[et] = (f32x4){0.f, 0.f, 0.f, 0.f};
#pragma unroll
            for (int ks = 0; ks < 2; ++ks) {
                if (ks == 0 || tb >= 2) {
                    const u32x2 lo = *(const LAS u32x2*)(VT + erow * 72 + 32 * ks + 4 * q4), hi = *(const LAS u32x2*)(VT + erow * 72 + 32 * ks + 16 + 4 * q4);
                    const u32x4 w = {lo.x, lo.y, hi.x, hi.y};
                    oa[et] = __builtin_amdgcn_mfma_f32_16x16x32_bf16(__builtin_bit_cast(bf16x8, w), pf[ks], oa[et], 0, 0, 0);
                }
            }
            if (n > 0) {
#pragma unroll
                for (int k4 = 0; k4 < 4; ++k4) {
                    const bf16x8 sf = *(const LAS bf16x8*)(STs + erow * 136 + 32 * k4 + 8 * q4);
                    oa[et] = __builtin_amdgcn_mfma_f32_16x16x32_bf16(sf, qfr[k4], oa[et], 0, 0, 0);
                }
            }
            ss += (oa[et][0] * oa[et][0] + oa[et][1] * oa[et][1]) + (oa[et][2] * oa[et][2] + oa[et][3] * oa[et][3]);
        }
        ss += __shfl_xor(ss, 16); ss += __shfl_xor(ss, 32);
        if (q4 == 0) red[(16 * tb + l15) * 2 + eh] = ss;
        __syncthreads();
        const float tss = red[(16 * tb + l15) * 2] + red[(16 * tb + l15) * 2 + 1];
        const float rstd = rsqrtf(tss * (1.f / 128.f) + EPS);
        const size_t orow = (size_t)b * SEQ + n * 64 + 16 * tb + l15;
#pragma unroll
        for (int et = 0; et < 4; ++et) {
            const int e0 = 64 * eh + 16 * et + 4 * q4;
            const f32x4 gn = *(const f32x4*)(onorm + e0);
            const u32x2 gt = *(const u32x2*)(Gt + orow * 1024 + h * 128 + e0);
            u32x2 o;
            o.x = pk2(oa[et][0] * rstd * gn[0] * bflo(gt.x), oa[et][1] * rstd * gn[1] * bfhi(gt.x));
            o.y = pk2(oa[et][2] * rstd * gn[2] * bflo(gt.y), oa[et][3] * rstd * gn[3] * bfhi(gt.y));
            *(u32x2*)(OH + orow * 1024 + h * 128 + e0) = o;
        }
    }
#undef HO_LOAD
}

__device__ __forceinline__ void mla_finalize(bf16_t* QF, const bf16_t* KN, const float* KR, bf16_t* KF, const int* pos, const float* invf, const float* qg, const float* kg, int gw, int NGW, int lane) {
    const int hd = lane >> 3, sub = lane & 7;
    float gq[16], gk[16], gq1[4], gq2[4], gk1[4], gk2[4], fr[4];
#pragma unroll
    for (int e = 0; e < 16; ++e) { gq[e] = qg[16 * sub + e]; gk[e] = kg[16 * sub + e]; }
#pragma unroll
    for (int j = 0; j < 4; ++j) { gq1[j] = qg[128 + 4 * sub + j]; gq2[j] = qg[160 + 4 * sub + j]; gk1[j] = kg[128 + 4 * sub + j]; gk2[j] = kg[160 + 4 * sub + j]; fr[j] = invf[4 * sub + j]; }
    for (int row = gw; row < M; row += NGW) {
        const float pf = (float)pos[row];
        float cs[4], sn[4];
#pragma unroll
        for (int j = 0; j < 4; ++j) rope_cs(pf * fr[j], cs[j], sn[j]);
        {
            bf16_t* qp = QF + (size_t)row * 1536 + hd * 192;
            const u32x4 a = *(const u32x4*)(qp + 16 * sub), b2 = *(const u32x4*)(qp + 16 * sub + 8);
            const u32x2 r1 = *(const u32x2*)(qp + 128 + 4 * sub), r2 = *(const u32x2*)(qp + 160 + 4 * sub);
            float xn[16], x1[4], x2[4];
            xn[0] = bflo(a.x); xn[1] = bfhi(a.x); xn[2] = bflo(a.y); xn[3] = bfhi(a.y); xn[4] = bflo(a.z); xn[5] = bfhi(a.z); xn[6] = bflo(a.w); xn[7] = bfhi(a.w);
            xn[8] = bflo(b2.x); xn[9] = bfhi(b2.x); xn[10] = bflo(b2.y); xn[11] = bfhi(b2.y); xn[12] = bflo(b2.z); xn[13] = bfhi(b2.z); xn[14] = bflo(b2.w); xn[15] = bfhi(b2.w);
            x1[0] = bflo(r1.x); x1[1] = bfhi(r1.x); x1[2] = bflo(r1.y); x1[3] = bfhi(r1.y);
            x2[0] = bflo(r2.x); x2[1] = bfhi(r2.x); x2[2] = bflo(r2.y); x2[3] = bfhi(r2.y);
            float ss = 0.f;
#pragma unroll
            for (int e = 0; e < 16; ++e) ss += xn[e] * xn[e];
#pragma unroll
            for (int j = 0; j < 4; ++j) ss += x1[j] * x1[j] + x2[j] * x2[j];
            ss += __shfl_xor(ss, 1); ss += __shfl_xor(ss, 2); ss += __shfl_xor(ss, 4);
            const float rs = rsqrtf(ss * (1.f / 192.f) + EPS) * QSCALE;
#pragma unroll
            for (int e = 0; e < 16; ++e) xn[e] *= rs * gq[e];
            float o1[4], o2[4];
#pragma unroll
            for (int j = 0; j < 4; ++j) { const float y1 = x1[j] * rs * gq1[j], y2 = x2[j] * rs * gq2[j]; o1[j] = y1 * cs[j] - y2 * sn[j]; o2[j] = y2 * cs[j] + y1 * sn[j]; }
            u32x4 wa, wb; u32x2 w1, w2;
            wa.x = pk2(xn[0], xn[1]); wa.y = pk2(xn[2], xn[3]); wa.z = pk2(xn[4], xn[5]); wa.w = pk2(xn[6], xn[7]);
            wb.x = pk2(xn[8], xn[9]); wb.y = pk2(xn[10], xn[11]); wb.z = pk2(xn[12], xn[13]); wb.w = pk2(xn[14], xn[15]);
            w1.x = pk2(o1[0], o1[1]); w1.y = pk2(o1[2], o1[3]); w2.x = pk2(o2[0], o2[1]); w2.y = pk2(o2[2], o2[3]);
            *(u32x4*)(qp + 16 * sub) = wa; *(u32x4*)(qp + 16 * sub + 8) = wb; *(u32x2*)(qp + 128 + 4 * sub) = w1; *(u32x2*)(qp + 160 + 4 * sub) = w2;
        }
        {
            const bf16_t* kp = KN + (size_t)row * 1024 + hd * 128;
            const u32x4 a = *(const u32x4*)(kp + 16 * sub), b2 = *(const u32x4*)(kp + 16 * sub + 8);
            const f32x4 r1 = *(const f32x4*)(KR + (size_t)row * 64 + 4 * sub), r2 = *(const f32x4*)(KR + (size_t)row * 64 + 32 + 4 * sub);
            float xn[16];
            xn[0] = bflo(a.x); xn[1] = bfhi(a.x); xn[2] = bflo(a.y); xn[3] = bfhi(a.y); xn[4] = bflo(a.z); xn[5] = bfhi(a.z); xn[6] = bflo(a.w); xn[7] = bfhi(a.w);
            xn[8] = bflo(b2.x); xn[9] = bfhi(b2.x); xn[10] = bflo(b2.y); xn[11] = bfhi(b2.y); xn[12] = bflo(b2.z); xn[13] = bfhi(b2.z); xn[14] = bflo(b2.w); xn[15] = bfhi(b2.w);
            float ss = 0.f;
#pragma unroll
            for (int e = 0; e < 16; ++e) ss += xn[e] * xn[e];
#pragma unroll
            for (int j = 0; j < 4; ++j) ss += r1[j] * r1[j] + r2[j] * r2[j];
            ss += __shfl_xor(ss, 1); ss += __shfl_xor(ss, 2); ss += __shfl_xor(ss, 4);
            const float rs = rsqrtf(ss * (1.f / 192.f) + EPS);
#pragma unroll
            for (int e = 0; e < 16; ++e) xn[e] *= rs * gk[e];
            float o1[4], o2[4];
#pragma unroll
            for (int j = 0; j < 4; ++j) { const float y1 = r1[j] * rs * gk1[j], y2 = r2[j] * rs * gk2[j]; o1[j] = y1 * cs[j] - y2 * sn[j]; o2[j] = y2 * cs[j] + y1 * sn[j]; }
            bf16_t* op = KF + (size_t)row * 1536 + hd * 192;
            u32x4 wa, wb; u32x2 w1, w2;
            wa.x = pk2(xn[0], xn[1]); wa.y = pk2(xn[2], xn[3]); wa.z = pk2(xn[4], xn[5]); wa.w = pk2(xn[6], xn[7]);
            wb.x = pk2(xn[8], xn[9]); wb.y = pk2(xn[10], xn[11]); wb.z = pk2(xn[12], xn[13]); wb.w = pk2(xn[14], xn[15]);
            w1.x = pk2(o1[0], o1[1]); w1.y = pk2(o1[2], o1[3]); w2.x = pk2(o2[0], o2[1]); w2.y = pk2(o2[2], o2[3]);
            *(u32x4*)(op + 16 * sub) = wa; *(u32x4*)(op + 16 * sub + 8) = wb; *(u32x2*)(op + 128 + 4 * sub) = w1; *(u32x2*)(op + 160 + 4 * sub) = w2;
        }
    }
}

__device__ __forceinline__ int crow(int r, int hi) { return (r & 3) + 8 * (r >> 2) + 4 * hi; }

constexpr int ATT_KBUF = 25600, ATT_VBUF = 18432, ATT_VBASE = 2 * ATT_KBUF;
__device__ __forceinline__ void att_dma(unsigned ldsdst, unsigned voff, const char* sbase) {
    unsigned keep;
    asm volatile("s_mov_b32 %0, m0\n\ts_mov_b32 m0, %1\n\ts_nop 0\n\tglobal_load_lds_dwordx4 %2, %3\n\ts_mov_b32 m0, %0" : "=&s"(keep) : "s"(ldsdst), "v"(voff), "s"(sbase) : "memory");
}
__device__ __forceinline__ void att_pv(f32x16 (&o)[4], const bf16x8 (&pf)[4], const LAS bf16_t* Vs, int l31, int hi) {
#pragma unroll
    for (int db = 0; db < 4; ++db)
#pragma unroll
        for (int st = 0; st < 4; ++st) {
            const bf16x8 vf = *(const LAS bf16x8*)(Vs + (32 * db + l31) * 72 + 16 * st + 8 * hi);
            o[db] = __builtin_amdgcn_mfma_f32_32x32x16_bf16(vf, pf[st], o[db], 0, 0, 0);
            if (st == 3) asm volatile("" ::: "memory");
        }
}
__device__ __forceinline__ void attn_unit(LAS unsigned char* lds, const bf16_t* QF, const bf16_t* KF, const bf16_t* VT, bf16_t* O, const int* pos, const float* invf, const float* qg, int b, int h, int qb) {
    int tid = threadIdx.x; asm volatile("" : "+v"(tid));
    const int lane = tid & 63, wid = __builtin_amdgcn_readfirstlane(tid >> 6), l31 = lane & 31, hi = lane >> 5;
    const bool grpB = wid >= 4;
    const unsigned lds_u32 = (unsigned)(__UINTPTR_TYPE__)lds;
    const int q0 = qb * 256, qw = q0 + wid * 32;
    const size_t rowb = (size_t)b * SEQ;
    const int NT = (q0 + 256) / 64;
    unsigned doff[6];
#pragma unroll
    for (int k = 0; k < 6; ++k) {
        const int I = wid + 8 * k;
        if (I < 25) { const int P = 64 * I + lane, r = P / 25, c = P % 25, rs = (r & ~12) | ((r & 4) << 1) | ((r & 8) >> 1);
            doff[k] = (unsigned)(rs * 3072 + (c < 24 ? c : 23) * 16); }
        else { const int P = 64 * (I - 25) + lane, d = P / 9, c = P % 9; doff[k] = (unsigned)(d * (M * 2) + (c < 8 ? c : 7) * 16); }
    }
    const char* kbase = (const char*)(KF + rowb * 1536 + h * 192);
    const char* vbase = (const char*)(VT + (size_t)(h * 128) * M + rowb);
#define ATT_ISSUE(t, kb, vb) do { const char* kb_ = kbase + (size_t)(t) * (64 * 3072); const char* vb_ = vbase + (size_t)(t) * 128; const unsigned lk_ = lds_u32 + (unsigned)(kb) * ATT_KBUF, lv_ = lds_u32 + ATT_VBASE + (unsigned)(vb) * ATT_VBUF; \
        _Pragma("unroll") for (int k = 0; k < 6; ++k) { const int I = wid + 8 * k; if (I < 25) att_dma(lk_ + (unsigned)I * 1024u, doff[k], kb_); else if (I < 43) att_dma(lv_ + (unsigned)(I - 25) * 1024u, doff[k], vb_); } } while (0)
    ATT_ISSUE(0, 0, 0);
    bf16x8 qf[12];
    {
        const bf16_t* qp = QF + (rowb + qw + l31) * 1536 + h * 192 + hi * 8;
#pragma unroll
        for (int ks = 0; ks < 12; ++ks) qf[ks] = *(const bf16x8*)(qp + ks * 16);
        float ss = 0.f;
#pragma unroll
        for (int ks = 0; ks < 12; ++ks) { const u32x4 w = __builtin_bit_cast(u32x4, qf[ks]);
            ss += (bflo(w.x) * bflo(w.x) + bfhi(w.x) * bfhi(w.x)) + (bflo(w.y) * bflo(w.y) + bfhi(w.y) * bfhi(w.y)) + (bflo(w.z) * bflo(w.z) + bfhi(w.z) * bfhi(w.z)) + (bflo(w.w) * bflo(w.w) + bfhi(w.w) * bfhi(w.w)); }
        ss += __shfl_xor(ss, 32);
        const float rstd = rsqrtf(ss * (1.f / 192.f) + EPS) * QSCALE;
#pragma unroll
        for (int ks = 0; ks < 8; ++ks) { const u32x4 w = __builtin_bit_cast(u32x4, qf[ks]); const f32x4 ga = *(const f32x4*)(qg + ks * 16 + hi * 8), gb = *(const f32x4*)(qg + ks * 16 + hi * 8 + 4);
            const f32x4 a = {bflo(w.x) * rstd * ga[0], bfhi(w.x) * rstd * ga[1], bflo(w.y) * rstd * ga[2], bfhi(w.y) * rstd * ga[3]}, bq = {bflo(w.z) * rstd * gb[0], bfhi(w.z) * rstd * gb[1], bflo(w.w) * rstd * gb[2], bfhi(w.w) * rstd * gb[3]};
            qf[ks] = __builtin_bit_cast(bf16x8, pack8(a, bq)); }
        const float pf_ = (float)pos[rowb + qw + l31];
#pragma unroll
        for (int kk = 0; kk < 2; ++kk) {
            const u32x4 w1 = __builtin_bit_cast(u32x4, qf[8 + kk]), w2 = __builtin_bit_cast(u32x4, qf[10 + kk]);
            u32x4 r1, r2;
#define ATT_ROPE2(W1, W2, R1, R2, e) do { const int i_ = 16 * kk + 8 * hi + 2 * (e); \
                const float xa_ = bflo(W1) * rstd * qg[128 + i_], xb_ = bfhi(W1) * rstd * qg[129 + i_], ya_ = bflo(W2) * rstd * qg[160 + i_], yb_ = bfhi(W2) * rstd * qg[161 + i_]; \
                float ca_, sa_, cb_, sb_; rope_cs(pf_ * invf[i_], ca_, sa_); rope_cs(pf_ * invf[i_ + 1], cb_, sb_); \
                R1 = pk2(xa_ * ca_ - ya_ * sa_, xb_ * cb_ - yb_ * sb_); R2 = pk2(ya_ * ca_ + xa_ * sa_, yb_ * cb_ + xb_ * sb_); } while (0)
            ATT_ROPE2(w1.x, w2.x, r1.x, r2.x, 0); ATT_ROPE2(w1.y, w2.y, r1.y, r2.y, 1); ATT_ROPE2(w1.z, w2.z, r1.z, r2.z, 2); ATT_ROPE2(w1.w, w2.w, r1.w, r2.w, 3);
#undef ATT_ROPE2
            qf[8 + kk] = __builtin_bit_cast(bf16x8, r1); qf[10 + kk] = __builtin_bit_cast(bf16x8, r2);
        }
    }
    f32x16 o[4];
#pragma unroll
    for (int i = 0; i < 4; ++i)
#pragma unroll
        for (int r = 0; r < 16; ++r) o[i][r] = 0.f;
    float mrun = -INFINITY, lrun = 0.f;
    bf16x8 pf[4];
#pragma unroll
    for (int i = 0; i < 4; ++i) pf[i] = (bf16x8){0, 0, 0, 0, 0, 0, 0, 0};
    bool pend = false; int vb = 0, vbp = 0;
    asm volatile("s_waitcnt vmcnt(0)\n\ts_barrier" ::: "memory");
    for (int j = 0; j < NT; ++j) {
        const int kv0 = 64 * j;
        const int vbn = (vb == 2) ? 0 : vb + 1;
        if (j + 1 < NT) ATT_ISSUE(j + 1, (j + 1) & 1, vbn);
        const LAS bf16_t* Ks = (const LAS bf16_t*)(lds + (j & 1) * ATT_KBUF);
        if (pend) { att_pv(o, pf, (const LAS bf16_t*)(lds + ATT_VBASE + vbp * ATT_VBUF), l31, hi); pend = false; }
        if (kv0 <= qw + 31) {
            f32x16 p0, p1;
#pragma unroll
            for (int r = 0; r < 16; ++r) { p0[r] = 0.f; p1[r] = 0.f; }
#pragma unroll
            for (int ks = 0; ks < 12; ++ks) {
                const bf16x8 a0 = *(const LAS bf16x8*)(Ks + l31 * 200 + ks * 16 + hi * 8);
                const bf16x8 a1 = *(const LAS bf16x8*)(Ks + (32 + l31) * 200 + ks * 16 + hi * 8);
                p0 = __builtin_amdgcn_mfma_f32_32x32x16_bf16(a0, qf[ks], p0, 0, 0, 0);
                p1 = __builtin_amdgcn_mfma_f32_32x32x16_bf16(a1, qf[ks], p1, 0, 0, 0);
                if (ks & 1) asm volatile("" ::: "memory");
            }
            if (kv0 + 63 > qw) {
                const int q = qw + l31;
#pragma unroll
                for (int r = 0; r < 16; ++r) { const int kv = kv0 + (r & 3) + 4 * ((r >> 2) & 1) + 8 * hi + 16 * (r >> 3); if (kv > q) p0[r] = -INFINITY; if (kv + 32 > q) p1[r] = -INFINITY; }
            }
            float mx = fmaxf(p0[0], p1[0]);
#pragma unroll
            for (int r = 1; r < 16; ++r) mx = fmaxf(mx, fmaxf(p0[r], p1[r]));
            mx = fmaxf(mx, __shfl_xor(mx, 32));
            if (__any(mx > mrun + 8.f)) {
                const float mnew = fmaxf(mrun, mx);
                const float alpha = __builtin_amdgcn_exp2f(mrun - mnew);
                mrun = mnew; lrun *= alpha;
#pragma unroll
                for (int i = 0; i < 4; ++i)
#pragma unroll
                    for (int r = 0; r < 16; ++r) o[i][r] *= alpha;
            }
            float rsum = 0.f;
#pragma unroll
            for (int r = 0; r < 16; ++r) { p0[r] = __builtin_amdgcn_exp2f(p0[r] - mrun); p1[r] = __builtin_amdgcn_exp2f(p1[r] - mrun); rsum += p0[r] + p1[r]; }
            lrun += rsum;
            {
                u32x4 w;
                w.x = pk2(p0[0], p0[1]); w.y = pk2(p0[2], p0[3]); w.z = pk2(p0[4], p0[5]); w.w = pk2(p0[6], p0[7]); pf[0] = __builtin_bit_cast(bf16x8, w);
                w.x = pk2(p0[8], p0[9]); w.y = pk2(p0[10], p0[11]); w.z = pk2(p0[12], p0[13]); w.w = pk2(p0[14], p0[15]); pf[1] = __builtin_bit_cast(bf16x8, w);
                w.x = pk2(p1[0], p1[1]); w.y = pk2(p1[2], p1[3]); w.z = pk2(p1[4], p1[5]); w.w = pk2(p1[6], p1[7]); pf[2] = __builtin_bit_cast(bf16x8, w);
                w.x = pk2(p1[8], p1[9]); w.y = pk2(p1[10], p1[11]); w.z = pk2(p1[12], p1[13]); w.w = pk2(p1[14], p1[15]); pf[3] = __builtin_bit_cast(bf16x8, w);
            }
            if (grpB) { pend = true; vbp = vb; }
            else att_pv(o, pf, (const LAS bf16_t*)(lds + ATT_VBASE + vb * ATT_VBUF), l31, hi);
        }
        vb = vbn;
        asm volatile("s_waitcnt vmcnt(0) lgkmcnt(0)\n\ts_barrier" ::: "memory");
    }
#undef ATT_ISSUE
    if (pend) att_pv(o, pf, (const LAS bf16_t*)(lds + ATT_VBASE + vbp * ATT_VBUF), l31, hi);
    lrun += __shfl_xor(lrun, 32);
    const float inv = 1.f / lrun;
    bf16_t* op = O + (rowb + qw + l31) * 1024 + h * 128 + 4 * hi;
#pragma unroll
    for (int db = 0; db < 4; ++db)
#pragma unroll
        for (int g = 0; g < 4; ++g) {
            u32x2 w; w.x = pk2(o[db][4 * g] * inv, o[db][4 * g + 1] * inv); w.y = pk2(o[db][4 * g + 2] * inv, o[db][4 * g + 3] * inv);
            *(u32x2*)(op + 32 * db + 8 * g) = w;
        }
    asm volatile("s_waitcnt lgkmcnt(0)\n\ts_barrier" ::: "memory");
}

template <class Epi> __device__ __forceinline__ void run_gemm(LAS unsigned char* lds, const bf16_t* A, int arows, const bf16_t* Bt, int nM, int nN, int K, int G, int c, const Epi& E) {
    pg8::Gemm g{A, Bt, nM * 256, nN * 256, K, arows};
    pg8::StaticOrder S; S.init2(nM, nN, G, c);
    pg8::gemm_phase<Epi, pg8::StaticOrder, true, true>(lds, g, S, E);
}

#define XB_TMO      128
#define XB_XCNT(j)  (256  + 64 * (j))
#define XB_XSUB(j)  (1280 + 64 * (j))
#define XB_XGEN(j)  (2304 + 64 * (j))
#define XB_TOP      3328
#define XB_TOPGEN   3392
#define XCD_BAR_WORDS 3456
#define XB_SPIN_CAP (1u << 18)

__device__ __forceinline__ unsigned xb_ld(unsigned* p)              { return __hip_atomic_load(p, __ATOMIC_RELAXED, __HIP_MEMORY_SCOPE_AGENT); }
__device__ __forceinline__ unsigned xb_add(unsigned* p, unsigned v) { return __hip_atomic_fetch_add(p, v, __ATOMIC_RELAXED, __HIP_MEMORY_SCOPE_AGENT); }
__device__ __forceinline__ unsigned xb_xcc_id() { return (unsigned)__builtin_amdgcn_s_getreg((3 << 11) | 20) & 0xFu; }
#define XB_SPIN(cond, bar) do { unsigned _sp = 0; while (cond) { __builtin_amdgcn_s_sleep(1); \
    if ((++_sp & 255u) == 0u) { if (xb_ld(&(bar)[XB_TMO])) break; if (_sp > XB_SPIN_CAP) { atomicAdd(&(bar)[XB_TMO], 1u); break; } } } } while (0)

struct XcdBarrier {
    unsigned* bar; unsigned x;
    volatile LAS unsigned* st;
};

__device__ __forceinline__ XcdBarrier xcd_barrier_post(unsigned* bar, volatile LAS unsigned* st) {
    XcdBarrier b; b.bar = bar; b.x = xb_xcc_id(); b.st = st;
    if (threadIdx.x == 0) (void)xb_add(&bar[XB_XCNT(b.x)], 1u);
    return b;
}
__device__ __forceinline__ void xcd_barrier_complete(unsigned* bar, unsigned x, unsigned& nloc, unsigned& nx) {
    const unsigned G = gridDim.x * gridDim.y * gridDim.z;
    unsigned sum, cnt, mine, sp = 0u;
    for (;;) {
        sum = 0u; cnt = 0u; mine = 0u;
#pragma unroll
        for (unsigned j = 0; j < 16; ++j) { const unsigned c = xb_ld(&bar[XB_XCNT(j)]); sum += c; cnt += (c > 0u) ? 1u : 0u; mine = (j == x) ? c : mine; }
        if (sum == G) break;
        __builtin_amdgcn_s_sleep(1);
        if ((++sp & 255u) == 0u) { if (xb_ld(&bar[XB_TMO])) break; if (sp > XB_SPIN_CAP) { atomicAdd(&bar[XB_TMO], 1u); break; } }
    }
    nloc = mine > 0u ? mine : 1u; nx = cnt > 0u ? cnt : 1u;
}

__device__ __forceinline__ void xcd_barrier(const XcdBarrier& b) {
    asm volatile("s_waitcnt vmcnt(0)" ::: "memory");
    __syncthreads();
    if (threadIdx.x == 0) {
        unsigned* bar = b.bar;
        __builtin_amdgcn_s_waitcnt(0);
        unsigned nloc = b.st[0], nx = b.st[1];
        if (nloc == 0u) { xcd_barrier_complete(bar, b.x, nloc, nx); b.st[0] = nloc; b.st[1] = nx; }
        const unsigned old = xb_add(&bar[XB_XSUB(b.x)], 1u);
        const unsigned gen = old / nloc;
        if (old + 1u == (gen + 1u) * nloc) {
            __builtin_amdgcn_fence(__ATOMIC_RELEASE, "agent");
            asm volatile("s_waitcnt vmcnt(0)" ::: "memory");
            const unsigned og = xb_add(&bar[XB_TOP], 1u);
            const unsigned tg = og / nx;
            if (og + 1u == (tg + 1u) * nx) xb_add(&bar[XB_TOPGEN], 1u);
            else XB_SPIN(xb_ld(&bar[XB_TOPGEN]) == tg, bar);
            __builtin_amdgcn_fence(__ATOMIC_ACQUIRE, "agent");
            xb_add(&bar[XB_XGEN(b.x)], 1u);
            asm volatile("s_waitcnt vmcnt(0)" ::: "memory");
        } else {
            XB_SPIN(xb_ld(&bar[XB_XGEN(b.x)]) == gen, bar);
            __builtin_amdgcn_fence(__ATOMIC_ACQUIRE, "agent");
            asm volatile("s_waitcnt vmcnt(0)" ::: "memory");
        }
    }
    __syncthreads();
}

#define GRID_SYNC() do { asm volatile("s_waitcnt vmcnt(0) lgkmcnt(0)" ::: "memory"); grid.sync(); __builtin_amdgcn_fence(__ATOMIC_ACQUIRE, "agent"); asm volatile("s_waitcnt vmcnt(0)" ::: "memory"); } while (0)
#define XSYNC() xcd_barrier(xbar)
typedef const __attribute__((address_space(4))) Args* KArgs;
#define KA() ({ KArgs k_ = (KArgs)__builtin_amdgcn_kernarg_segment_ptr(); asm volatile("" : "+s"(k_)); k_; })

#ifdef STOP_LAYER
__device__ __forceinline__ void dump_bf16(float* o, const bf16_t* p, size_t n, bool add, int gtid, int gthreads) {
    const size_t per = (n + (size_t)M * DM - 1) / ((size_t)M * DM);
    for (size_t i = gtid; i < (size_t)M * DM; i += gthreads) { float a = add ? o[i] : 0.f; for (size_t k = 0; k < per; ++k) { const size_t q = i * per + k; if (q < n) a += bf2f(p[q]); } o[i] = a; }
}
__device__ __forceinline__ void dump_f32(float* o, const float* p, size_t n, bool add, int gtid, int gthreads) {
    const size_t per = (n + (size_t)M * DM - 1) / ((size_t)M * DM);
    for (size_t i = gtid; i < (size_t)M * DM; i += gthreads) { float a = add ? o[i] : 0.f; for (size_t k = 0; k < per; ++k) { const size_t q = i * per + k; if (q < n) a += p[q]; } o[i] = a; }
}
#define STOP(ph, stmts) do { if (layer == STOP_LAYER && (ph) == STOP_PHASE) { KArgs ka = KA(); unsigned char* ws = ka->ws; float* o = ka->out; int tid_ = threadIdx.x; asm volatile("" : "+v"(tid_)); const int gt = bid * NTHREADS + tid_; (void)ws; (void)o; (void)gt; stmts; return; } } while (0)
#define DBF(ptr, n, add) dump_bf16(o, ptr, n, add, gt, gthreads)
#define DFF_(ptr, n, add) dump_f32(o, ptr, n, add, gt, gthreads)
#else
#define STOP(ph, stmts) do {} while (0)
#endif


#ifdef DIAG_BISECT
__device__ __forceinline__ void dg_bf16(const bf16_t* p, size_t n, unsigned code, unsigned* diag, int gtid, int gthreads, float lim = 1e6f) {
    bool bad = false;
    for (size_t i = (size_t)gtid * 8; i < n; i += (size_t)gthreads * 8) {
        const u32x4 w = *(const u32x4*)(p + i);
        const unsigned ws4[4] = {w.x, w.y, w.z, w.w};
#pragma unroll
        for (int k = 0; k < 4; ++k) { const float a = bflo(ws4[k]), b = bfhi(ws4[k]); if (!(fabsf(a) < lim) || !(fabsf(b) < lim)) bad = true; }
    }
    if (bad) atomicMin(diag, code * 10u);
}
__device__ __forceinline__ void dg_f32(const float* p, size_t n, unsigned code, unsigned* diag, int gtid, int gthreads, float lim = 1e8f) {
    bool bad = false;
    for (size_t i = (size_t)gtid; i < n; i += (size_t)gthreads) { if (!(fabsf(p[i]) < lim)) bad = true; }
    if (bad) atomicMin(diag, code * 10u);
}
__device__ __forceinline__ void dg_pos(const float* p, size_t n, unsigned code, unsigned* diag, int gtid, int gthreads) {
    bool bad = false;
    for (size_t i = (size_t)gtid; i < n; i += (size_t)gthreads) { if (p[i] > 1e-3f) bad = true; }
    if (bad) atomicMin(diag, code * 10u);
}
#define DG(stmts) do { KArgs ka = KA(); unsigned char* ws = ka->ws; unsigned* diag = (unsigned*)(ws + 32768); int tid_ = threadIdx.x; asm volatile("" : "+v"(tid_)); const int gt = bid * NTHREADS + tid_; (void)diag; (void)gt; stmts; } while (0)
#define DB(ptr, n, code) dg_bf16(ptr, n, code, diag, gt, gthreads)
#define DF(ptr, n, code) dg_f32(ptr, n, code, diag, gt, gthreads)
#else
#define DG(stmts) do {} while (0)
#endif

#define INF(k) ((const float*)ka->in[k])
#define WSP(T, off) ((T*)(ws + (off)))

__global__ void __launch_bounds__(NTHREADS, 2) trunk_fwd(Args args) {
    extern __shared__ __attribute__((aligned(16))) unsigned char lds_raw[];
    cg::grid_group grid = cg::this_grid();
    LAS unsigned char* lds = (LAS unsigned char*)lds_raw;
    const int G = gridDim.x, bid = blockIdx.x;
    const int vcu = (G % 8 == 0) ? (bid % 8) * (G / 8) + bid / 8 : bid;
    const int NGW = G * NWAVES, gthreads = G * NTHREADS;
    (void)args;
    volatile LAS unsigned* xmisc = (volatile LAS unsigned*)(lds + XMISC_OFF);
    if (threadIdx.x < 2) xmisc[threadIdx.x] = 0u;
    __syncthreads();
    XcdBarrier xbar;
    { KArgs ka0 = (KArgs)__builtin_amdgcn_kernarg_segment_ptr(); xbar = xcd_barrier_post((unsigned*)(ka0->ws + WS_BAR), xmisc); }

    {
        KArgs ka = KA(); unsigned char* ws = ka->ws;
        int tid = threadIdx.x; asm volatile("" : "+v"(tid));
        const int lane = tid & 63, wave = __builtin_amdgcn_readfirstlane(tid >> 6), gw = vcu * NWAVES + wave, gtid = bid * NTHREADS + tid;
        LAS float* scr = (LAS float*)(lds + wave * 17408);
        float* SSQ = WSP(float, WS_SSQ); float* LBT = WSP(float, WS_LBT); float* INVF = WSP(float, WS_INVF); bf16_t* XB = WSP(bf16_t, WS_XB);
        const float* x_in = INF(0); const float* hgrn_lbs = INF(5);
        for (int i = gtid; i < 2048; i += gthreads) {
            const int c = i & 1023;
            LBT[i] = (i < 1024) ? 0.f : 1.f / (1.f + __expf(hgrn_lbs[c] - hgrn_lbs[1024 + c]));
        }
#ifdef DIAG_BISECT
        if (gtid == 0) *(unsigned*)(ws + 32768) = 990u;
#endif
        if (gtid < 32) INVF[gtid] = exp2f(-(float)gtid * (13.287712379549449f / 32.0f));
        for (int m = gw; m < M; m += NGW) {
            const f32x4* xr = (const f32x4*)(x_in + (size_t)m * 1024) + lane;
            float s = 0.f; f32x4 v[4];
#pragma unroll
            for (int j = 0; j < 4; ++j) { v[j] = xr[64 * j]; s += (v[j][0] * v[j][0] + v[j][1] * v[j][1]) + (v[j][2] * v[j][2] + v[j][3] * v[j][3]); }
            s = wave_sum(s);
            u32x2* o8 = (u32x2*)(XB + (size_t)m * 1024) + lane;
#pragma unroll
            for (int j = 0; j < 4; ++j) { u32x2 w; w.x = pk2(v[j][0], v[j][1]); w.y = pk2(v[j][2], v[j][3]); o8[64 * j] = w; }
            if (lane < 4) SSQ[(size_t)lane * M + m] = (lane == 0) ? s : 0.f;
        }
        int rot = 0;
        for (int j = 0; j < 2; ++j) {
            cvt_job(INF(4) + (size_t)j * 1024 * 4096, 1024, 4096, INF(2) + (2 * j) * 1024, WSP(bf16_t, WS_WHIN) + (size_t)j * 4096 * 1024, 4096, 0, rot, gw, NGW, scr, lane);
            cvt_job(INF(7) + (size_t)j * 1024 * 1024, 1024, 1024, nullptr, WSP(bf16_t, WS_WHOUT) + (size_t)j * 1024 * 1024, 1024, 0, rot, gw, NGW, scr, lane);
            cvt_job(INF(8) + (size_t)j * 1024 * 576, 1024, 576, INF(2) + (2 * j + 1) * 1024, WSP(bf16_t, WS_WMIN) + (size_t)j * 768 * 1024, 576, 0, rot, gw, NGW, scr, lane);
            cvt_job(INF(10) + (size_t)j * 256 * 1536, 256, 1536, INF(9) + j * 256, WSP(bf16_t, WS_WQ) + (size_t)j * 1536 * 256, 1536, 0, rot, gw, NGW, scr, lane);
            cvt_job(INF(12) + (size_t)j * 256 * 2048, 256, 2048, INF(11) + j * 256, WSP(bf16_t, WS_WKN) + (size_t)j * 1024 * 256, 1024, 1, rot, gw, NGW, scr, lane);
            cvt_job(INF(12) + (size_t)j * 256 * 2048, 256, 2048, INF(11) + j * 256, WSP(bf16_t, WS_WV) + (size_t)j * 1024 * 256, 1024, 2, rot, gw, NGW, scr, lane);
            cvt_job(INF(15) + (size_t)j * 1024 * 1024, 1024, 1024, nullptr, WSP(bf16_t, WS_WMOUT) + (size_t)j * 1024 * 1024, 1024, 0, rot, gw, NGW, scr, lane);
        }
    }
    XSYNC();
    if (G == 0x7fffffff) GRID_SYNC();

    for (int layer = 0; layer < 4; ++layer) {
        const int j = layer >> 1;
        const unsigned cb_ = 20u * (unsigned)layer; (void)cb_;
        if (layer == 0) DG(DB(WSP(bf16_t, WS_XB), (size_t)M * 1024, 1); DF(WSP(float, WS_SSQ), (size_t)4 * M, 1); DB(WSP(bf16_t, WS_WHIN), (size_t)4096 * 1024, 1); DB(WSP(bf16_t, WS_WHOUT), (size_t)1024 * 1024, 1));
        if ((layer & 1) == 0) {
#ifndef SKIP_H1
            { KArgs ka = KA(); unsigned char* ws = ka->ws;
              epi::EpiHgrnIn E{WSP(float, WS_SSQ) + (size_t)(2 * layer) * 4 * M, WSP(float, WS_LBT) + j * 1024, WSP(bf16_t, WS_QH), WSP(bf16_t, WS_VH), WSP(bf16_t, WS_GH), WSP(float, WS_LF)};
              run_gemm(lds, WSP(bf16_t, WS_XB), 256, WSP(bf16_t, WS_WHIN) + (size_t)j * 4096 * 1024, 64, 16, 1024, G, bid, E); }
#endif
            XSYNC();
            STOP(1, DBF(WSP(bf16_t, WS_QH), (size_t)M * 1024, false); DBF(WSP(bf16_t, WS_VH), (size_t)M * 1024, true); DBF(WSP(bf16_t, WS_GH), (size_t)M * 1024, true); DFF_(WSP(float, WS_LF), (size_t)M * 1024, true));
            DG(dg_bf16(WSP(bf16_t, WS_QH), (size_t)M * 1024, cb_ + 2, diag, gt, gthreads, 100.f); dg_bf16(WSP(bf16_t, WS_VH), (size_t)M * 1024, cb_ + 2, diag, gt, gthreads, 100.f); dg_bf16(WSP(bf16_t, WS_GH), (size_t)M * 1024, cb_ + 2, diag, gt, gthreads, 100.f); dg_f32(WSP(float, WS_LF), (size_t)M * 1024, cb_ + 2, diag, gt, gthreads, 100.f); dg_pos(WSP(float, WS_LF), (size_t)M * 1024, cb_ + 3, diag, gt, gthreads));
#ifndef SKIP_H2
            { KArgs ka = KA(); unsigned char* ws = ka->ws; hgrn_local(lds, WSP(bf16_t, WS_VH), WSP(float, WS_LF), WSP(bf16_t, WS_ST), WSP(float, WS_DL), G, bid, (unsigned*)(ws + 32768)); }
#endif
            XSYNC();
            STOP(2, DBF(WSP(bf16_t, WS_ST), (size_t)16 * 128 * 16384 - 16384, false); DFF_(WSP(float, WS_DL), (size_t)16 * 128 * 128 - 128, true));
            DG(for (int q_ = 0; q_ < 16; ++q_) DB(WSP(bf16_t, WS_ST) + (size_t)q_ * 128 * 16384, (size_t)127 * 16384, cb_ + 5); DF(WSP(float, WS_DL), (size_t)16 * 128 * 128 - 128, cb_ + 4));
#ifndef SKIP_H3
            { KArgs ka = KA(); unsigned char* ws = ka->ws; int tid = threadIdx.x; asm volatile("" : "+v"(tid)); hgrn_scan(WSP(bf16_t, WS_ST), WSP(float, WS_DL), bid * NTHREADS + tid, gthreads); }
#endif
        } else {
#ifndef SKIP_M1
            { KArgs ka = KA(); unsigned char* ws = ka->ws;
              epi::EpiMlaIn E{WSP(float, WS_SSQ) + (size_t)(2 * layer) * 4 * M, WSP(bf16_t, WS_CQ), WSP(bf16_t, WS_CKV), WSP(float, WS_KR), WSP(float, WS_SSQCQ) + (size_t)j * M, WSP(float, WS_SSQCKV) + (size_t)j * M, WSP(float, WS_SSQKR) + (size_t)j * M, (LAS float*)(lds + HALO_OFF)};
              run_gemm(lds, WSP(bf16_t, WS_XB), 256, WSP(bf16_t, WS_WMIN) + (size_t)j * 768 * 1024, 64, 3, 1024, G, bid, E); }
#endif
            XSYNC();
            STOP(1, DBF(WSP(bf16_t, WS_CQ), (size_t)M * 256, false); DBF(WSP(bf16_t, WS_CKV), (size_t)M * 256, true); DFF_(WSP(float, WS_KR), (size_t)M * 64, true); DFF_(WSP(float, WS_SSQCQ) + (size_t)j * M, (size_t)4 * M, true));
            DG(DB(WSP(bf16_t, WS_CQ), (size_t)M * 256, cb_ + 2); DB(WSP(bf16_t, WS_CKV), (size_t)M * 256, cb_ + 2); DF(WSP(float, WS_KR), (size_t)M * 64, cb_ + 2); DF(WSP(float, WS_SSQCQ) + (size_t)j * M, (size_t)4 * M, cb_ + 2));
#ifndef SKIP_M2A
            { KArgs ka = KA(); unsigned char* ws = ka->ws;
              epi::EpiScale<true> E{WSP(float, WS_SSQCQ) + (size_t)j * M, 1.f / 256.f, WSP(bf16_t, WS_QF), 1536}; run_gemm(lds, WSP(bf16_t, WS_CQ), 256, WSP(bf16_t, WS_WQ) + (size_t)j * 1536 * 256, 64, 6, 256, G, bid, E); }
#endif
#ifndef SKIP_M2B
            { KArgs ka = KA(); unsigned char* ws = ka->ws;
              epi::EpiKFinal E{WSP(float, WS_SSQCKV) + (size_t)j * M, WSP(float, WS_SSQKR) + (size_t)j * M, WSP(float, WS_KR), (const int*)ka->in[1], WSP(float, WS_INVF), INF(14) + j * 192, WSP(bf16_t, WS_KF), (LAS float*)(lds + HALO_OFF)};
              run_gemm(lds, WSP(bf16_t, WS_CKV), 256, WSP(bf16_t, WS_WKN) + (size_t)j * 1024 * 256, 64, 4, 256, G, (bid + 128) % G, E); }
#endif
#ifndef SKIP_M2C
            { KArgs ka = KA(); unsigned char* ws = ka->ws;
              epi::EpiScale<false> E{WSP(float, WS_SSQCKV) + (size_t)j * M, 1.f / 256.f, WSP(bf16_t, WS_VT), M}; run_gemm(lds, WSP(bf16_t, WS_WV) + (size_t)j * 1024 * 256, 256, WSP(bf16_t, WS_CKV), 4, 64, 256, G, (bid + 128) % G, E); }
#endif
        }
        {
            KArgs ka = KA(); unsigned char* ws = ka->ws; int tid = threadIdx.x; asm volatile("" : "+v"(tid));
            const int wave = __builtin_amdgcn_readfirstlane(tid >> 6);
            LAS float* scr = (LAS float*)(lds + wave * 17408);
            __syncthreads();
            int rot = 0;
            cvt_job(INF(16) + (size_t)layer * 1024 * DFF2, 1024, DFF2, INF(3) + layer * 1024, WSP(bf16_t, WS_WUP), DFF2, 3, rot, vcu * NWAVES + wave, NGW, scr, tid & 63);
            cvt_job(INF(19) + (size_t)layer * DFF * 1024, DFF, 1024, nullptr, WSP(bf16_t, WS_WDN), 1024, 0, rot, vcu * NWAVES + wave, NGW, scr, tid & 63);
        }
        XSYNC();
        STOP(3, DBF(WSP(bf16_t, WS_WUP), (size_t)DFF2 * 1024, false); DBF(WSP(bf16_t, WS_WDN), (size_t)DFF * 1024, true); if ((layer & 1) == 0) { DBF(WSP(bf16_t, WS_ST), (size_t)16 * 128 * 16384 - 16384, true); } else { DBF(WSP(bf16_t, WS_QF), (size_t)M * 1536, true); DBF(WSP(bf16_t, WS_KF), (size_t)M * 1536, true); });
        DG(DB(WSP(bf16_t, WS_WUP), (size_t)DFF2 * 1024, cb_ + 6); DB(WSP(bf16_t, WS_WDN), (size_t)DFF * 1024, cb_ + 6);
           if ((layer & 1) == 0) { for (int q_ = 0; q_ < 16; ++q_) DB(WSP(bf16_t, WS_ST) + (size_t)q_ * 128 * 16384, (size_t)127 * 16384, cb_ + 7); } else { DB(WSP(bf16_t, WS_QF), (size_t)M * 1536, cb_ + 7); DB(WSP(bf16_t, WS_KF), (size_t)M * 1536, cb_ + 7); });
        if ((layer & 1) == 0) {
#ifndef SKIP_H4
            { KArgs ka = KA(); unsigned char* ws = ka->ws;
              hgrn_out(lds, WSP(bf16_t, WS_QH), WSP(bf16_t, WS_VH), WSP(bf16_t, WS_GH), WSP(float, WS_LF), WSP(bf16_t, WS_ST), INF(6) + j * 128, WSP(bf16_t, WS_QH), G, bid); }
#endif
            XSYNC();
            STOP(4, DBF(WSP(bf16_t, WS_QH), (size_t)M * 1024, false));
            DG(DB(WSP(bf16_t, WS_QH), (size_t)M * 1024, cb_ + 8));
#ifndef SKIP_H5
            { KArgs ka = KA(); unsigned char* ws = ka->ws;
              epi::EpiResid E{layer == 0 ? INF(0) : (const float*)ka->out, ka->out, WSP(bf16_t, WS_XB), WSP(float, WS_SSQ) + (size_t)(2 * layer + 1) * 4 * M, (LAS float*)(lds + HALO_OFF)};
              run_gemm(lds, WSP(bf16_t, WS_QH), 256, WSP(bf16_t, WS_WHOUT) + (size_t)j * 1024 * 1024, 64, 4, 1024, G, bid, E); }
#endif
        } else {
#ifndef SKIP_M4
            { KArgs ka = KA(); unsigned char* ws = ka->ws;
              for (int pu = vcu; pu < 256; pu += G) {
                  const int bh = pu >> 4, s = pu & 15;
                  attn_unit(lds, WSP(bf16_t, WS_QF), WSP(bf16_t, WS_KF), WSP(bf16_t, WS_VT), WSP(bf16_t, WS_KN), (const int*)ka->in[1], WSP(float, WS_INVF), INF(13) + j * 192, bh >> 3, bh & 7, 31 - s);
                  attn_unit(lds, WSP(bf16_t, WS_QF), WSP(bf16_t, WS_KF), WSP(bf16_t, WS_VT), WSP(bf16_t, WS_KN), (const int*)ka->in[1], WSP(float, WS_INVF), INF(13) + j * 192, bh >> 3, bh & 7, s);
              } }
#endif
            XSYNC();
            STOP(4, DBF(WSP(bf16_t, WS_KN), (size_t)M * 1024, false));
            DG(DB(WSP(bf16_t, WS_KN), (size_t)M * 1024, cb_ + 8));
#ifndef SKIP_M5
            { KArgs ka = KA(); unsigned char* ws = ka->ws;
              epi::EpiResid E{(const float*)ka->out, ka->out, WSP(bf16_t, WS_XB), WSP(float, WS_SSQ) + (size_t)(2 * layer + 1) * 4 * M, (LAS float*)(lds + HALO_OFF)};
              run_gemm(lds, WSP(bf16_t, WS_KN), 256, WSP(bf16_t, WS_WMOUT) + (size_t)j * 1024 * 1024, 64, 4, 1024, G, bid, E); }
#endif
        }
        XSYNC();
        STOP(5, DBF(WSP(bf16_t, WS_XB), (size_t)M * 1024, true); DFF_(WSP(float, WS_SSQ) + (size_t)(2 * layer + 1) * 4 * M, (size_t)4 * M, true));
        DG(DF(ka->out, (size_t)M * 1024, cb_ + 9); DB(WSP(bf16_t, WS_XB), (size_t)M * 1024, cb_ + 9); DF(WSP(float, WS_SSQ) + (size_t)(2 * layer + 1) * 4 * M, (size_t)4 * M, cb_ + 9));
#ifndef SKIP_F1
        { KArgs ka = KA(); unsigned char* ws = ka->ws;
          epi::EpiFfnUp E{WSP(float, WS_SSQ) + (size_t)(2 * layer + 1) * 4 * M, INF(17) + (size_t)layer * 3 * DFF2, INF(18) + (size_t)layer * DFF2, WSP(bf16_t, WS_HF), (LAS float*)(lds + HALO_OFF)};
          run_gemm(lds, WSP(bf16_t, WS_XB) - 2 * 1024, 254, WSP(bf16_t, WS_WUP), 65, 22, 1024, G, bid, E); }
#endif
        XSYNC();
        STOP(6, DBF(WSP(bf16_t, WS_HF), (size_t)M * DFF, false));
        DG(DB(WSP(bf16_t, WS_HF), (size_t)M * DFF, cb_ + 10));
#ifndef SKIP_F2
        { KArgs ka = KA(); unsigned char* ws = ka->ws;
          epi::EpiResid E{(const float*)ka->out, ka->out, (layer < 3) ? WSP(bf16_t, WS_XB) : nullptr, (layer < 3) ? WSP(float, WS_SSQ) + (size_t)(2 * layer + 2) * 4 * M : nullptr, (LAS float*)(lds + HALO_OFF)};
          run_gemm(lds, WSP(bf16_t, WS_HF), 256, WSP(bf16_t, WS_WDN), 64, 4, DFF, G, bid, E); }
#endif
        if (layer < 3) XSYNC();
        STOP(7, (void)0);
    }
#ifdef DIAG_BISECT
    XSYNC();
    DG(DF(ka->out, (size_t)M * 1024, 89));
    XSYNC();
    { KArgs ka = KA(); float* o = ka->out; int tid = threadIdx.x; asm volatile("" : "+v"(tid)); const unsigned dv = *(volatile unsigned*)(ka->ws + 32768);
      for (int i = bid * NTHREADS + tid; i < M * DM; i += gthreads) o[i] = (i == 0) ? 100.f * (float)dv : 0.f; }
#endif
#ifdef DIAG_SANITIZE
    XSYNC();
    { KArgs ka = KA(); float* o = ka->out; int tid = threadIdx.x; asm volatile("" : "+v"(tid));
      for (int i = bid * NTHREADS + tid; i < M * DM; i += gthreads) { const float v = o[i]; if (!(fabsf(v) < 1e30f)) o[i] = 1e30f; } }
#endif
}

extern "C" void kernel_launch(void* const* d_in, const int* in_sizes, int n_in, void* d_out, int out_size, void* d_ws, size_t ws_size, hipStream_t stream) {
    static int grid = 0;
    if (grid == 0) {
        if (n_in != 20 || out_size != M * DM || ws_size < WS_NEED) { fprintf(stderr, "kernel_launch: unexpected problem (n_in %d, out %d, ws %zu, need %zu)\n", n_in, out_size, ws_size, (size_t)WS_NEED); grid = -1; return; }
        int dev = 0, cus = 0, per_cu = 0;
        if (hipGetDevice(&dev) != hipSuccess || hipDeviceGetAttribute(&cus, hipDeviceAttributeMultiprocessorCount, dev) != hipSuccess) { grid = -1; return; }
        if (hipFuncSetAttribute((const void*)trunk_fwd, hipFuncAttributeMaxDynamicSharedMemorySize, LDS_BYTES) != hipSuccess) { fprintf(stderr, "kernel_launch: hipFuncSetAttribute failed\n"); grid = -1; return; }
        if (hipOccupancyMaxActiveBlocksPerMultiprocessor(&per_cu, (const void*)trunk_fwd, NTHREADS, LDS_BYTES) != hipSuccess || per_cu < 1) { fprintf(stderr, "kernel_launch: occupancy query failed (%d)\n", per_cu); (void)hipGetLastError(); per_cu = 1; }
        grid = cus * per_cu;
    }
    if (grid < 0) return;
    if (hipMemsetAsync((char*)d_ws + WS_BAR, 0, WS_BAR_BYTES, stream) != hipSuccess) { fprintf(stderr, "kernel_launch: memset of the barrier words failed\n"); return; }
    Args a{};
    for (int i = 0; i < 20; ++i) a.in[i] = d_in[i];
    a.out = (float*)d_out; a.ws = (unsigned char*)d_ws;
    void* kargs[] = {&a};
    hipError_t e = hipLaunchCooperativeKernel((const void*)trunk_fwd, dim3(grid), dim3(NTHREADS), kargs, LDS_BYTES, stream);
    if (e != hipSuccess) fprintf(stderr, "kernel_launch: cooperative launch failed: %s (grid %d)\n", hipGetErrorString(e), grid);
}
```
